# Optimizing an MI355X kernel written in HIP

```python
import math
import jax, jax.numpy as jnp
from jax import lax
import numpy as np

D_MODEL = 1024
BATCH = 8
SEQ = 4096
DEPTH = 2

HEAD_DIM = 64
H_A = 4
H_B = 4
H_C = 4
KV_C = 2
H_D = 4
N_MIXERS = 4
D_MIX = HEAD_DIM * (H_A + H_B + H_C + H_D)
N_IN = 3 * HEAD_DIM * H_A + 3 * HEAD_DIM * H_B + HEAD_DIM * (H_C + 2 * KV_C) + 3 * HEAD_DIM * H_D + H_D
DILATED_GROUPS = ((128, 1), (512, 4), (2048, 16))
BAND_BLOCK = 128
MOBA_BLOCK = 256
MOBA_TOPK = 3
MOBA_Q_CHUNK = 128
SWA_WINDOW = 128
FOX_Q_BLOCK = 128
N_BUCKETS = 32
T5_MAX_DISTANCE = 2048
N_BIAS_HEADS = H_A + H_B + H_C
D_FF = -(-(8 * D_MODEL) // (3 * 256)) * 256
EPS = 1e-6
NEG = -1e30
SCALE = HEAD_DIM ** -0.5

kernel_name = 'hybrid_parallel_heads_dilated_moba_swa_fox'


def rmsnorm(x, g):
    xf = x.astype(jnp.float32)
    y = xf * lax.rsqrt(jnp.mean(xf * xf, axis=-1, keepdims=True) + EPS)
    return (y * g.astype(jnp.float32)).astype(x.dtype)


def group_rmsnorm(y, g):
    B, S, _ = y.shape
    yg = y.reshape(B, S, N_MIXERS, D_MIX // N_MIXERS)
    return rmsnorm(yg, g.reshape(N_MIXERS, D_MIX // N_MIXERS)).reshape(B, S, D_MIX)


def t5_bucket(dist):
    n = jnp.maximum(dist, 0)
    max_exact = N_BUCKETS // 2
    nf = jnp.maximum(n, 1).astype(jnp.float32)
    large = max_exact + (jnp.log(nf / max_exact) / math.log(T5_MAX_DISTANCE / max_exact)
                         * (N_BUCKETS - max_exact)).astype(jnp.int32)
    large = jnp.minimum(large, N_BUCKETS - 1)
    return jnp.where(n < max_exact, n, large)


def band_bias(table, step):
    i = jnp.arange(BAND_BLOCK)[:, None]
    j = jnp.arange(2 * BAND_BLOCK)[None, :]
    b = t5_bucket((i + BAND_BLOCK - j) * step)
    return jnp.transpose(table[b], (2, 0, 1))


def to_heads(t, h):
    B, S, _ = t.shape
    return t.reshape(B, S, h, HEAD_DIM).transpose(0, 2, 1, 3)


def from_heads(o):
    B, H, S, D = o.shape
    return o.transpose(0, 2, 1, 3).reshape(B, S, H * D)


def banded_attn(q, k, v, max_dist, bias, sink):
    B, G, R, L, D = q.shape
    n = -(-L // BAND_BLOCK)
    pad = n * BAND_BLOCK - L
    q = jnp.pad(q, ((0, 0), (0, 0), (0, 0), (0, pad), (0, 0)))
    k = jnp.pad(k, ((0, 0), (0, 0), (0, pad), (0, 0)))
    v = jnp.pad(v, ((0, 0), (0, 0), (0, pad), (0, 0)))
    qb = q.reshape(B, G, R, n, BAND_BLOCK, D)
    kb = k.reshape(B, G, n, BAND_BLOCK, D)
    vb = v.reshape(B, G, n, BAND_BLOCK, D)
    shift = ((0, 0), (0, 0), (1, 0), (0, 0), (0, 0))
    kw = jnp.concatenate([jnp.pad(kb, shift)[:, :, :n], kb], axis=3)
    vw = jnp.concatenate([jnp.pad(vb, shift)[:, :, :n], vb], axis=3)
    s = jnp.einsum('bgrnqd,bgnkd->bgrnqk', qb, kw).astype(jnp.float32) * SCALE
    s = s + bias[:, :, None].astype(jnp.float32)
    i = jnp.arange(BAND_BLOCK)[:, None]
    j = jnp.arange(2 * BAND_BLOCK)[None, :]
    dist = i + BAND_BLOCK - j
    in_band = (dist >= 0) & (dist <= max_dist)
    has_prev = (jnp.arange(n)[:, None, None] > 0) | (j >= BAND_BLOCK)[None]
    s = jnp.where(in_band[None] & has_prev, s, NEG)
    if sink is not None:
        sk = jnp.broadcast_to(sink.astype(jnp.float32)[None, :, :, None, None, None], s.shape[:-1] + (1,))
        s = jnp.concatenate([s, sk], axis=-1)
    lse = jax.nn.logsumexp(s, axis=-1, keepdims=True)
    p = jnp.exp(s - lse)[..., :2 * BAND_BLOCK]
    o = jnp.einsum('bgrnqk,bgnkd->bgrnqd', p.astype(v.dtype), vw)
    o = o.reshape(B, G, R, n * BAND_BLOCK, D)[:, :, :, :L]
    lse = lse[..., 0].reshape(B, G, R, n * BAND_BLOCK)[:, :, :, :L]
    return o, lse


def dilated_mixture(q, k, v, table):
    B, H, S, D = q.shape
    outs, lses = [], []
    for window, dil in DILATED_GROUPS:
        L = S // dil

        def fold(t):
            return t.reshape(B, H, L, dil, D).transpose(0, 3, 1, 2, 4).reshape(B * dil, H, L, D)

        bias = band_bias(table, dil)[:, None]
        o, lse = banded_attn(fold(q)[:, :, None], fold(k), fold(v), window // dil, bias, None)
        outs.append(o[:, :, 0].reshape(B, dil, H, L, D).transpose(0, 2, 3, 1, 4).reshape(B, H, S, D))
        lses.append(lse[:, :, 0].reshape(B, dil, H, L).transpose(0, 2, 3, 1).reshape(B, H, S))
    w = jax.nn.softmax(jnp.stack(lses), axis=0)
    return jnp.einsum('gbhs,gbhsd->bhsd', w.astype(q.dtype), jnp.stack(outs))


def moba_attn(q, k, v, table):
    B, H, S, D = q.shape
    nb = -(-S // MOBA_BLOCK)
    Sp = nb * MOBA_BLOCK
    padw = ((0, 0), (0, 0), (0, Sp - S), (0, 0))
    q, k, v = jnp.pad(q, padw), jnp.pad(k, padw), jnp.pad(v, padw)
    kb = k.reshape(B, H, nb, MOBA_BLOCK, D)
    vb = v.reshape(B, H, nb, MOBA_BLOCK, D)
    k_mean = jnp.mean(kb.astype(jnp.float32), axis=3)
    topk = min(MOBA_TOPK, nb)
    table_t = table.T
    bi = jnp.arange(B)[:, None, None, None]
    hi = jnp.arange(H)[None, :, None, None]
    blk_ids = jnp.arange(nb)
    in_blk = jnp.arange(MOBA_BLOCK)
    Q = MOBA_Q_CHUNK

    def chunk(c):
        start = c * Q
        t = start + jnp.arange(Q)
        own = start // MOBA_BLOCK
        qc = lax.dynamic_slice_in_dim(q, start, Q, axis=2)
        gate = jnp.einsum('bhqd,bhnd->bhqn', qc.astype(jnp.float32), k_mean)
        gate = jnp.where(blk_ids < own, gate, -jnp.inf)
        _, idx = lax.top_k(gate, topk)
        valid = jnp.arange(topk) < own
        k_sel = kb[bi, hi, idx]
        v_sel = vb[bi, hi, idx]
        dist_sel = t[:, None, None] - (idx[..., None] * MOBA_BLOCK + in_blk)
        bias_sel = table_t[hi[..., None], t5_bucket(dist_sel)]
        s_sel = jnp.einsum('bhqd,bhqnkd->bhqnk', qc, k_sel).astype(jnp.float32) * SCALE
        s_sel = jnp.where(valid[:, None], s_sel + bias_sel.astype(jnp.float32), NEG)
        k_own = lax.dynamic_index_in_dim(kb, own, axis=2, keepdims=False)
        v_own = lax.dynamic_index_in_dim(vb, own, axis=2, keepdims=False)
        dist_own = t[:, None] - (own * MOBA_BLOCK + in_blk)[None, :]
        s_own = jnp.einsum('bhqd,bhkd->bhqk', qc, k_own).astype(jnp.float32) * SCALE
        s_own = s_own + table_t[:, t5_bucket(dist_own)].astype(jnp.float32)
        s_own = jnp.where(dist_own >= 0, s_own, NEG)
        s = jnp.concatenate([s_sel.reshape(B, H, Q, topk * MOBA_BLOCK), s_own], axis=-1)
        p = jax.nn.softmax(s, axis=-1).astype(v.dtype)
        p_sel = p[..., :topk * MOBA_BLOCK].reshape(B, H, Q, topk, MOBA_BLOCK)
        return (jnp.einsum('bhqnk,bhqnkd->bhqd', p_sel, v_sel)
                + jnp.einsum('bhqk,bhkd->bhqd', p[..., topk * MOBA_BLOCK:], v_own))

    o = lax.map(chunk, jnp.arange(Sp // Q))
    return o.transpose(1, 2, 0, 3, 4).reshape(B, H, Sp, D)[:, :, :S]


def forgetting_attn(q, k, v, log_f):
    B, H, S, D = q.shape
    n = -(-S // FOX_Q_BLOCK)
    Sp = n * FOX_Q_BLOCK
    padw = ((0, 0), (0, 0), (0, Sp - S), (0, 0))
    q, k, v = jnp.pad(q, padw), jnp.pad(k, padw), jnp.pad(v, padw)
    c = lax.cumsum(jnp.pad(log_f, ((0, 0), (0, 0), (0, Sp - S))), axis=2)
    kpos = jnp.arange(Sp)

    def blk(i):
        start = i * FOX_Q_BLOCK
        qi = lax.dynamic_slice_in_dim(q, start, FOX_Q_BLOCK, axis=2)
        ci = lax.dynamic_slice_in_dim(c, start, FOX_Q_BLOCK, axis=2)
        s = jnp.einsum('bhqd,bhkd->bhqk', qi, k).astype(jnp.float32) * SCALE
        s = s + ci[..., None] - c[:, :, None, :]
        causal = (start + jnp.arange(FOX_Q_BLOCK))[:, None] >= kpos[None, :]
        p = jax.nn.softmax(jnp.where(causal, s, NEG), axis=-1)
        return jnp.einsum('bhqk,bhkd->bhqd', p.astype(v.dtype), v)

    o = lax.map(blk, jnp.arange(n))
    return o.transpose(1, 2, 0, 3, 4).reshape(B, H, Sp, D)[:, :, :S]


def setup_inputs(seed: int = 0) -> dict:
    key = jax.random.key(seed)
    ks = jax.random.split(key, 13)
    nrm = jax.random.normal
    return {
        'x': nrm(ks[0], (BATCH, SEQ, D_MODEL), jnp.float32),
        'norm1_g': 1.0 + 0.1 * nrm(ks[1], (DEPTH, D_MODEL), jnp.float32),
        'w_in': nrm(ks[2], (DEPTH, D_MODEL, N_IN), jnp.float32) * D_MODEL ** -0.5,
        'f_bias': 2.0 + 0.5 * nrm(ks[3], (DEPTH, H_D), jnp.float32),
        'sinks': 0.5 * nrm(ks[4], (DEPTH, H_C), jnp.float32),
        'mix_norm_g': 1.0 + 0.1 * nrm(ks[5], (DEPTH, D_MIX), jnp.float32),
        'w_out': nrm(ks[6], (DEPTH, D_MIX, D_MODEL), jnp.float32) * D_MIX ** -0.5,
        'norm2_g': 1.0 + 0.1 * nrm(ks[7], (DEPTH, D_MODEL), jnp.float32),
        'w_gate': nrm(ks[8], (DEPTH, D_MODEL, D_FF), jnp.float32) * D_MODEL ** -0.5,
        'w_up': nrm(ks[9], (DEPTH, D_MODEL, D_FF), jnp.float32) * D_MODEL ** -0.5,
        'w_down': nrm(ks[10], (DEPTH, D_FF, D_MODEL), jnp.float32) * D_FF ** -0.5,
        'rel_bias': 0.5 * nrm(ks[11], (N_BUCKETS, N_BIAS_HEADS), jnp.float32),
        'final_g': 1.0 + 0.1 * nrm(ks[12], (D_MODEL,), jnp.float32),
    }


def reference(x, norm1_g, w_in, f_bias, sinks, mix_norm_g, w_out, norm2_g, w_gate, w_up, w_down, rel_bias, final_g):
    B, S, _ = x.shape
    table_a = rel_bias[:, :H_A]
    table_b = rel_bias[:, H_A:H_A + H_B]
    table_c = rel_bias[:, H_A + H_B:]
    rep_c = H_C // KV_C
    bias_c = band_bias(table_c, 1).reshape(KV_C, rep_c, BAND_BLOCK, 2 * BAND_BLOCK)
    hd = HEAD_DIM
    sizes = [hd * H_A] * 3 + [hd * H_B] * 3 + [hd * H_C, hd * KV_C, hd * KV_C] + [hd * H_D] * 3 + [H_D]
    offsets = np.cumsum(sizes)[:-1].tolist()
    for l in range(DEPTH):
        h = rmsnorm(x, norm1_g[l])
        qa, ka, va, qb, kb, vb, qc, kc, vc, qd, kd, vd, fd = jnp.split(h @ w_in[l], offsets, axis=-1)
        o_a = dilated_mixture(to_heads(qa, H_A), to_heads(ka, H_A), to_heads(va, H_A), table_a)
        o_b = moba_attn(to_heads(qb, H_B), to_heads(kb, H_B), to_heads(vb, H_B), table_b)
        q_c = to_heads(qc, H_C).reshape(B, KV_C, rep_c, S, HEAD_DIM)
        o_c, _ = banded_attn(q_c, to_heads(kc, KV_C), to_heads(vc, KV_C), SWA_WINDOW - 1,
                             bias_c, sinks[l].reshape(KV_C, rep_c))
        o_c = o_c.reshape(B, H_C, S, HEAD_DIM)
        log_f = jax.nn.log_sigmoid((fd + f_bias[l]).astype(jnp.float32)).transpose(0, 2, 1)
        o_d = forgetting_attn(to_heads(qd, H_D), to_heads(kd, H_D), to_heads(vd, H_D), log_f)
        mix = jnp.concatenate([from_heads(o_a), from_heads(o_b), from_heads(o_c), from_heads(o_d)], axis=-1)
        x = x + group_rmsnorm(mix, mix_norm_g[l]) @ w_out[l]
        h = rmsnorm(x, norm2_g[l])
        x = x + (jax.nn.silu(h @ w_gate[l]) * (h @ w_up[l])) @ w_down[l]
    return rmsnorm(x, final_g)
```

```cpp
#include <hip/hip_runtime.h>
#include <cstdio>
#include <cstdint>
#ifndef MK_N_LAUNCHES
#define MK_N_LAUNCHES 1
#endif
#define EX2(x) __builtin_amdgcn_exp2f(x)
#ifndef ATT_MFMA_MASK
#define ATT_MFMA_MASK 15
#endif
#ifndef DUP_MASK
#define DUP_MASK 0
#endif
#define DUPN(k) ((((DUP_MASK) >> (k)) & 1) + 1)
#ifndef ATT_DUP_TYPES
#define ATT_DUP_TYPES 0
#endif
#define ADUP(t) ((((ATT_DUP_TYPES) >> (t)) & 1) + 1)
#ifndef PROBE_PHASE
#define PROBE_PHASE -1
#endif
#ifndef ATT2_MASK
#define ATT2_MASK 10
#endif
#ifndef ATT3_ON
#define ATT3_ON 1
#endif
namespace pg8 {
#define PG8_LAS __attribute__((address_space(3)))
typedef unsigned short bf16_t;
typedef short bf16x8 __attribute__((ext_vector_type(8)));
typedef float f32x4 __attribute__((ext_vector_type(4)));
typedef unsigned u32x4 __attribute__((ext_vector_type(4)));
typedef int i32x4_t __attribute__((ext_vector_type(4)));
typedef int i32x8_t __attribute__((ext_vector_type(8)));
constexpr int BM = 256, BK = 64, HALF = 128, HTB = HALF * BK * 2  , STAGE_BYTES = 8 * HTB, NXCD = 8, WGM = 8;

__host__ __device__ __forceinline__ int lds_byte(int r, int c) { const int st = (r >> 4) * 2 + (c >> 5), rr = r & 15, cc = c & 31, ob = rr * 64 + cc * 2; return st * 1024 + (ob ^ (((ob >> 9) & 1) << 5)); }
__host__ __device__ __forceinline__ void stage_rc(int b, int& R, int& C) { const int st = b / 1024, sb = b % 1024, swz = sb ^ (((sb >> 9) & 1) << 5); R = (st >> 1) * 16 + swz / 64; C = (st & 1) * 32 + (swz % 64) / 2; }
__host__ __device__ __forceinline__ int perm32(int rho) { const int n = rho >> 4, i = rho & 15; return 8 * (i >> 2) + 4 * n + (i & 3); }

struct Unit { int pm, pn, ui; };
struct Gemm { const bf16_t* A; const bf16_t* Bt; int M, N, K; };

struct StaticOrder {
    int nM, nN, nwg, G, c;
    __host__ __device__ void init(int M, int N, int G_, int c_) { nM = M / BM; nN = N / BM; nwg = nM * nN; G = G_; c = c_; }
    __host__ __device__ bool next(int i, Unit& u) const {
        const long L = (long)i * G + c; if (L >= nwg) return false;
        int wgid = (int)L; { const int q = nwg / NXCD, r = nwg % NXCD, xcd = wgid % NXCD, off = wgid / NXCD; wgid = (xcd < r ? xcd * (q + 1) : r * (q + 1) + (xcd - r) * q) + off; }
        const int nig = WGM * nN, gid = wgid / nig, fm = gid * WGM, gsz = (nM - fm) < WGM ? (nM - fm) : WGM;
        u.pm = fm + ((wgid % nig) % gsz); u.pn = (wgid % nig) / gsz; u.ui = i; return true;
    }
    __device__ __forceinline__ void a_ready(const Unit&) const {}
    __device__ __forceinline__ void done(const Unit&) const {}
};

__device__ __forceinline__ unsigned cvt_pk_bf16(float lo, float hi) { unsigned r; asm volatile("v_cvt_pk_bf16_f32 %0, %1, %2" : "=v"(r) : "v"(lo), "v"(hi)); return r; }

__device__ __forceinline__ unsigned pk4_fp8(float a, float b, float c, float d) {
    a = __builtin_amdgcn_fmed3f(a, -448.f, 448.f); b = __builtin_amdgcn_fmed3f(b, -448.f, 448.f); c = __builtin_amdgcn_fmed3f(c, -448.f, 448.f); d = __builtin_amdgcn_fmed3f(d, -448.f, 448.f);
    unsigned w = __builtin_amdgcn_cvt_pk_fp8_f32(a, b, 0u, false); return __builtin_amdgcn_cvt_pk_fp8_f32(c, d, w, true);
}
__device__ __forceinline__ float rstd_from_slots(const float* ss, int r) {
    const f32x4* p = (const f32x4*)(ss + (size_t)r * 16); const f32x4 a = p[0], b = p[1], c = p[2], d = p[3];
    const float s = ((a[0] + a[1]) + (a[2] + a[3])) + ((b[0] + b[1]) + (b[2] + b[3])) + ((c[0] + c[1]) + (c[2] + c[3])) + ((d[0] + d[1]) + (d[2] + d[3]));
    return 1.0f / sqrtf(s * (1.0f / 1024.0f) + 1e-6f);
}

template <class Sched> __device__ __forceinline__ void rstd_table(PG8_LAS float* tbl, const float* ss, const Sched& S) {
    Unit u;
    for (int i = 0; S.next(i, u); ++i) { if (threadIdx.x < 256) tbl[i * 256 + threadIdx.x] = rstd_from_slots(ss, u.pm * BM + (int)threadIdx.x); }
    __syncthreads();
}
struct EpiQKV {
    static constexpr bool PERM = true, AFTER_DRAIN = false;
    bf16_t* O; int ldc; const float* rstd; float qscale; PG8_LAS float* rsl;
    float* kmean; unsigned* nrm;
    __device__ __forceinline__ void operator()(const f32x4 (&acc)[2][2][4][2], const Unit& u, int wr, int wc, int fr, int fq) const {
        const int row0 = u.pm * BM + wr * 64 + fr, col0 = u.pn * BM + wc * 32 + 8 * fq;
        const float ts = (u.pn == 0 || u.pn == 3 || u.pn == 6 || u.pn == 8) ? qscale : 1.0f;
        const PG8_LAS float* sc = rsl + u.ui * 256 + wr * 64;
        const bool do_km = (u.pn == 4);
        const bool do_nrm = (u.pn == 8 || u.pn == 9);
        float cs[2][8]; float nmx[2] = {0.f, 0.f};
#pragma unroll
        for (int bj = 0; bj < 2; ++bj)
#pragma unroll
            for (int j = 0; j < 8; ++j) cs[bj][j] = 0.f;
#pragma unroll
        for (int ai = 0; ai < 2; ++ai)
#pragma unroll
            for (int m = 0; m < 4; ++m) { const int r = row0 + ai * HALF + m * 16; const float s = sc[ai * HALF + m * 16 + fr] * ts; bf16_t* rowp = O + (size_t)r * ldc + col0;
#pragma unroll
                for (int bj = 0; bj < 2; ++bj) { const f32x4 v0 = acc[ai][bj][m][0] * s, v1 = acc[ai][bj][m][1] * s;
                    u32x4 w; w.x = cvt_pk_bf16(v0[0], v0[1]); w.y = cvt_pk_bf16(v0[2], v0[3]); w.z = cvt_pk_bf16(v1[0], v1[1]); w.w = cvt_pk_bf16(v1[2], v1[3]);
                    *(u32x4*)(rowp + bj * HALF) = w;
                    if (do_km) {
#pragma unroll
                        for (int i = 0; i < 4; ++i) { cs[bj][i] += v0[i]; cs[bj][4 + i] += v1[i]; } }
                    if (do_nrm) { float q = (v0[0] * v0[0] + v0[1] * v0[1]) + (v0[2] * v0[2] + v0[3] * v0[3]) + (v1[0] * v1[0] + v1[1] * v1[1]) + (v1[2] * v1[2] + v1[3] * v1[3]);
                        q += __shfl_xor(q, 16); q += __shfl_xor(q, 32); nmx[bj] = __builtin_fmaxf(nmx[bj], q); } } }
        if (do_km) {
#pragma unroll
            for (int bj = 0; bj < 2; ++bj)
#pragma unroll
                for (int j = 0; j < 8; ++j) { float v = cs[bj][j]; v += __shfl_xor(v, 1); v += __shfl_xor(v, 2); v += __shfl_xor(v, 4); v += __shfl_xor(v, 8);
                    if (fr == 0) { const int cg = bj * HALF + wc * 32 + 8 * fq + j; atomicAdd(kmean + ((size_t)((u.pm >> 4) * 4 + (cg >> 6)) * 16 + (u.pm & 15)) * 64 + (cg & 63), v * (1.0f / 256.0f)); } }
        }
        if (do_nrm) {
#pragma unroll
            for (int bj = 0; bj < 2; ++bj) { float v = nmx[bj]; v = __builtin_fmaxf(v, __shfl_xor(v, 1)); v = __builtin_fmaxf(v, __shfl_xor(v, 2)); v = __builtin_fmaxf(v, __shfl_xor(v, 4)); v = __builtin_fmaxf(v, __shfl_xor(v, 8));
                if (fr == 0 && fq == 0) atomicMax(nrm + ((u.pm >> 4) * 4 + 2 * bj + (wc >> 1)) * 4 + (u.pn == 9 ? 2 : 0) + (wc & 1), __float_as_uint(v)); }
        }
    }
};
struct EpiResid {
    static constexpr bool PERM = false, AFTER_DRAIN = false;
    const float* base; float* out; int ldc;
    __device__ __forceinline__ void operator()(const f32x4 (&acc)[2][2][4][2], const Unit& u, int wr, int wc, int fr, int fq) const {
        const int row0 = u.pm * BM + wr * 64 + fr, col0 = u.pn * BM + wc * 32 + 4 * fq;
#pragma unroll
        for (int ai = 0; ai < 2; ++ai)
#pragma unroll
            for (int m = 0; m < 4; ++m) { const size_t off = (size_t)(row0 + ai * HALF + m * 16) * ldc + col0;
#pragma unroll
                for (int bj = 0; bj < 2; ++bj)
#pragma unroll
                    for (int n = 0; n < 2; ++n) { const f32x4 b = *(const f32x4*)(base + off + bj * HALF + n * 16); *(f32x4*)(out + off + bj * HALF + n * 16) = b + acc[ai][bj][m][n]; } }
    }
};
struct EpiResidX {
    static constexpr bool PERM = true, AFTER_DRAIN = false;
    bf16_t* xb; float* ss; const float* wfd; float* fdp; int ldc; float ascale; unsigned char* x8;
    __device__ __forceinline__ void operator()(const f32x4 (&acc)[2][2][4][2], const Unit& u, int wr, int wc, int fr, int fq) const {
        const int row0 = u.pm * BM + wr * 64 + fr, col0 = u.pn * BM + wc * 32 + 8 * fq; const int slot = u.pn * 4 + wc;
#pragma unroll
        for (int ai = 0; ai < 2; ++ai)
#pragma unroll
            for (int m = 0; m < 4; ++m) { const int r = row0 + ai * HALF + m * 16; bf16_t* rowp = xb + (size_t)r * ldc + col0;
                float s2 = 0.f, f0 = 0.f, f1 = 0.f, f2 = 0.f, f3 = 0.f;
#pragma unroll
                for (int bj = 0; bj < 2; ++bj) { const u32x4 xw = *(const u32x4*)(rowp + bj * HALF);
                    float v[8];
                    v[0] = fmaf(acc[ai][bj][m][0][0], ascale, __builtin_bit_cast(float, xw.x << 16)); v[1] = fmaf(acc[ai][bj][m][0][1], ascale, __builtin_bit_cast(float, xw.x & 0xffff0000u));
                    v[2] = fmaf(acc[ai][bj][m][0][2], ascale, __builtin_bit_cast(float, xw.y << 16)); v[3] = fmaf(acc[ai][bj][m][0][3], ascale, __builtin_bit_cast(float, xw.y & 0xffff0000u));
                    v[4] = fmaf(acc[ai][bj][m][1][0], ascale, __builtin_bit_cast(float, xw.z << 16)); v[5] = fmaf(acc[ai][bj][m][1][1], ascale, __builtin_bit_cast(float, xw.z & 0xffff0000u));
                    v[6] = fmaf(acc[ai][bj][m][1][2], ascale, __builtin_bit_cast(float, xw.w << 16)); v[7] = fmaf(acc[ai][bj][m][1][3], ascale, __builtin_bit_cast(float, xw.w & 0xffff0000u));
                    u32x4 w; w.x = cvt_pk_bf16(v[0], v[1]); w.y = cvt_pk_bf16(v[2], v[3]); w.z = cvt_pk_bf16(v[4], v[5]); w.w = cvt_pk_bf16(v[6], v[7]);
                    *(u32x4*)(rowp + bj * HALF) = w;
                    if (x8) { typedef unsigned u32x2 __attribute__((ext_vector_type(2))); u32x2 q; q.x = pk4_fp8(v[0], v[1], v[2], v[3]); q.y = pk4_fp8(v[4], v[5], v[6], v[7]); *(u32x2*)(x8 + (size_t)r * ldc + col0 + bj * HALF) = q; }
#pragma unroll
                    for (int i = 0; i < 8; ++i) s2 = fmaf(v[i], v[i], s2);
                    if (wfd) {
#pragma unroll
                        for (int i = 0; i < 8; ++i) { const f32x4 wv = *(const f32x4*)(wfd + (size_t)(col0 + bj * HALF + i) * 4); f0 += v[i] * wv[0]; f1 += v[i] * wv[1]; f2 += v[i] * wv[2]; f3 += v[i] * wv[3]; } } }
                s2 += __shfl_xor(s2, 16); s2 += __shfl_xor(s2, 32);
                if (wfd) { f0 += __shfl_xor(f0, 16); f0 += __shfl_xor(f0, 32); f1 += __shfl_xor(f1, 16); f1 += __shfl_xor(f1, 32); f2 += __shfl_xor(f2, 16); f2 += __shfl_xor(f2, 32); f3 += __shfl_xor(f3, 16); f3 += __shfl_xor(f3, 32); }
                if (fq == 0) { ss[(size_t)r * 16 + slot] = s2; if (wfd) { float* fp = fdp + (size_t)r * 64 + slot; fp[0] = f0; fp[16] = f1; fp[32] = f2; fp[48] = f3; } } }
    }
};
struct EpiSwiGLU {
    static constexpr bool PERM = true, AFTER_DRAIN = false;
    unsigned char* O; int ldc; const float* rstd; PG8_LAS float* rsl; float ascale, oscale;
    __device__ __forceinline__ void operator()(const f32x4 (&acc)[2][2][4][2], const Unit& u, int wr, int wc, int fr, int fq) const {
        const int row0 = u.pm * BM + wr * 64 + fr, col0 = u.pn * HALF + wc * 32 + 8 * fq;
        const PG8_LAS float* sc = rsl + u.ui * 256 + wr * 64;
#pragma unroll
        for (int ai = 0; ai < 2; ++ai)
#pragma unroll
            for (int m = 0; m < 4; ++m) { const int r = row0 + ai * HALF + m * 16; const float s = sc[ai * HALF + m * 16 + fr] * ascale; unsigned char* rowp = O + (size_t)r * ldc + col0;
                const float sn = -1.4426950408889634f * s, su = s * oscale;
                float a[8];
#pragma unroll
                for (int n = 0; n < 2; ++n)
#pragma unroll
                    for (int i = 0; i < 4; ++i) { const float ag = acc[ai][0][m][n][i], au = acc[ai][1][m][n][i];
                        const float sg = __builtin_amdgcn_rcpf(1.0f + __builtin_amdgcn_exp2f(ag * sn)); a[4 * n + i] = (ag * s) * sg * (au * su); }
                typedef unsigned u32x2 __attribute__((ext_vector_type(2))); u32x2 w; w.x = pk4_fp8(a[0], a[1], a[2], a[3]); w.y = pk4_fp8(a[4], a[5], a[6], a[7]);
                *(u32x2*)rowp = w; }
    }
};

template <class Epi, class Sched, bool ALIGN_EPI = false, bool SP2 = false, bool F8 = false>
__device__ __forceinline__ void gemm_phase(PG8_LAS unsigned char* lds, const Gemm g, const Sched& S, const Epi& E) {
    const int tid = threadIdx.x, wid = __builtin_amdgcn_readfirstlane(tid >> 6), lane = tid & 63, wr = wid >> 2, wc = wid & 3, fr = lane & 15, fq = lane >> 4;
    const int KB = F8 ? g.K : 2 * g.K, nt = KB / (BK * 2);
    unsigned voffA[2], voffB[2];
#pragma unroll
    for (int i = 0; i < 2; ++i) { int R, C; stage_rc(tid * 16 + i * 8192, R, C); const int Rb = Epi::PERM ? ((R & ~31) + perm32(R & 31)) : R;
        voffA[i] = (unsigned)(R * KB + C * 2); voffB[i] = (unsigned)(Rb * KB + C * 2); }
    const size_t kstep = (size_t)(BK * 2);
    const size_t hstep = (size_t)HALF * KB;
    const size_t tstep = 2 * hstep;
    const unsigned ldsw = (unsigned)wid * 1024u;
    int aoffk[2], boffk[2];
#pragma unroll
    for (int k = 0; k < 2; ++k) { const int c = F8 ? 16 * fq + 8 * k : fq * 8 + 32 * k; aoffk[k] = lds_byte(wr * 64 + fr, c); boffk[k] = lds_byte(wc * 32 + fr, c); }
#define PG8_SA(b, h) (((b) * 2 + (h)) * HTB)
#define PG8_SB(b, h) ((4 + (b) * 2 + (h)) * HTB)
#define PG8_STAGE(bufoff, gbase, voff) do { _Pragma("unroll") for (int _i = 0; _i < 2; ++_i) \
        __builtin_amdgcn_global_load_lds((const unsigned*)((const char*)(gbase) + (voff)[_i]), (PG8_LAS unsigned*)(lds + (bufoff) + ldsw + _i * 8192), 16, 0, 0); } while (0)
#define PG8_LDA(dst, b, h) do { _Pragma("unroll") for (int m = 0; m < 4; ++m) _Pragma("unroll") for (int k = 0; k < 2; ++k) dst[m][k] = *(const PG8_LAS bf16x8*)(lds + PG8_SA(b, h) + aoffk[k] + m * 2048); } while (0)
#define PG8_LDA8(dst, b, h) do { _Pragma("unroll") for (int m = 0; m < 4; ++m) { const i32x4_t lo_ = *(const PG8_LAS i32x4_t*)(lds + PG8_SA(b, h) + aoffk[0] + m * 2048), hi_ = *(const PG8_LAS i32x4_t*)(lds + PG8_SA(b, h) + aoffk[1] + m * 2048); dst[m] = __builtin_shufflevector(lo_, hi_, 0, 1, 2, 3, 4, 5, 6, 7); } } while (0)
#define PG8_LDB(dst, b, h) do { _Pragma("unroll") for (int n = 0; n < 2; ++n) _Pragma("unroll") for (int k = 0; k < 2; ++k) dst[n][k] = *(const PG8_LAS bf16x8*)(lds + PG8_SB(b, h) + boffk[k] + n * 2048); } while (0)
#define PG8_LDB8(dst, b, h) do { _Pragma("unroll") for (int n = 0; n < 2; ++n) { const i32x4_t lo_ = *(const PG8_LAS i32x4_t*)(lds + PG8_SB(b, h) + boffk[0] + n * 2048), hi_ = *(const PG8_LAS i32x4_t*)(lds + PG8_SB(b, h) + boffk[1] + n * 2048); dst[n] = __builtin_shufflevector(lo_, hi_, 0, 1, 2, 3, 4, 5, 6, 7); } } while (0)
#define PG8_MMA(ai, bj, At, Bt) do { __builtin_amdgcn_s_setprio(1); _Pragma("unroll") for (int m = 0; m < 4; ++m) _Pragma("unroll") for (int n = 0; n < 2; ++n) _Pragma("unroll") for (int k = 0; k < 2; ++k) \
        acc[ai][bj][m][n] = __builtin_amdgcn_mfma_f32_16x16x32_bf16(Bt[n][k], At[m][k], acc[ai][bj][m][n], 0, 0, 0); __builtin_amdgcn_s_setprio(0); } while (0)
#define PG8_MMA8(ai, bj, At, Bt) do { __builtin_amdgcn_sched_barrier(0); __builtin_amdgcn_s_setprio(1); _Pragma("unroll") for (int m = 0; m < 4; ++m) _Pragma("unroll") for (int n = 0; n < 2; ++n) \
        acc[ai][bj][m][n] = __builtin_amdgcn_mfma_scale_f32_16x16x128_f8f6f4(Bt[n], At[m], acc[ai][bj][m][n], 0, 0, 0, 0x7f7f7f7f, 0, 0x7f7f7f7f); __builtin_amdgcn_s_setprio(0); \
        asm volatile("" : "+v"(acc[ai][bj][0][0]), "+v"(acc[ai][bj][0][1]), "+v"(acc[ai][bj][1][0]), "+v"(acc[ai][bj][1][1]), "+v"(acc[ai][bj][2][0]), "+v"(acc[ai][bj][2][1]), "+v"(acc[ai][bj][3][0]), "+v"(acc[ai][bj][3][1])); \
        __builtin_amdgcn_sched_barrier(0); } while (0)
#define PG8_LDAx(b, h) do { if constexpr (F8) PG8_LDA8(At8, b, h); else PG8_LDA(At, b, h); } while (0)
#define PG8_LDBx(w, b, h) do { if constexpr (F8) { if ((w) == 0) PG8_LDB8(B08, b, h); else PG8_LDB8(B18, b, h); } else { if ((w) == 0) PG8_LDB(B0, b, h); else PG8_LDB(B1, b, h); } } while (0)
#define PG8_MMAx(ai, bj, w) do { if constexpr (F8) { if ((w) == 0) PG8_MMA8(ai, bj, At8, B08); else PG8_MMA8(ai, bj, At8, B18); } else { if ((w) == 0) PG8_MMA(ai, bj, At, B0); else PG8_MMA(ai, bj, At, B1); } } while (0)
#define PG8_WAIT_V(n) asm volatile("s_waitcnt vmcnt(" #n ")" ::: "memory")
#define PG8_WAIT_L(n) asm volatile("s_waitcnt lgkmcnt(" #n ")" ::: "memory")
#define PG8_BAR __builtin_amdgcn_s_barrier()
#define PG8_SCHED __builtin_amdgcn_sched_barrier(0)
    Unit cur, nxt; int ui = 0;
    if (!S.next(0, cur)) return;
    f32x4 acc[2][2][4][2];
#pragma unroll
    for (int a = 0; a < 2; ++a)
#pragma unroll
        for (int b = 0; b < 2; ++b)
#pragma unroll
            for (int m = 0; m < 4; ++m)
#pragma unroll
                for (int n = 0; n < 2; ++n) acc[a][b][m][n] = (f32x4){0.f, 0.f, 0.f, 0.f};
    bf16x8 At[4][2], B0[2][2], B1[2][2]; i32x8_t At8[4], B08[2], B18[2];
    const char* cA = (const char*)g.A + (size_t)cur.pm * tstep; const char* cB = (const char*)g.Bt + (size_t)cur.pn * tstep;
    S.a_ready(cur);
    if constexpr (SP2) {
        PG8_STAGE(PG8_SB(0, 0), cB, voffB); PG8_STAGE(PG8_SB(0, 1), cB + hstep, voffB); PG8_STAGE(PG8_SA(0, 0), cA, voffA); PG8_STAGE(PG8_SA(0, 1), cA + hstep, voffA);
        if (wr == 1) PG8_BAR;
        PG8_WAIT_V(2); PG8_BAR;
        PG8_STAGE(PG8_SB(1, 0), cB + kstep, voffB); PG8_STAGE(PG8_SA(1, 0), cA + kstep, voffA); PG8_STAGE(PG8_SB(1, 1), cB + hstep + kstep, voffB);
        PG8_WAIT_V(6); PG8_BAR;
    } else {
        PG8_STAGE(PG8_SB(0, 0), cB, voffB); PG8_STAGE(PG8_SA(0, 0), cA, voffA); PG8_STAGE(PG8_SB(0, 1), cB + hstep, voffB); PG8_STAGE(PG8_SA(0, 1), cA + hstep, voffA);
        if (wr == 1) PG8_BAR;
        PG8_WAIT_V(4); PG8_BAR;
        PG8_STAGE(PG8_SB(1, 0), cB + kstep, voffB); PG8_STAGE(PG8_SA(1, 0), cA + kstep, voffA); PG8_STAGE(PG8_SB(1, 1), cB + hstep + kstep, voffB);
        PG8_WAIT_V(6); PG8_BAR;
    }
    for (;;) {
        const bool has_next = S.next(ui + 1, nxt);
        const char* nA = has_next ? (const char*)g.A + (size_t)nxt.pm * tstep : cA; const char* nB = has_next ? (const char*)g.Bt + (size_t)nxt.pn * tstep : cB;
        for (int t = 0; t < nt; t += 2) {
            const bool last = (t == nt - 2);
            const char* a1 = cA + (size_t)(t + 1) * kstep;
            const char* a2 = last ? nA : cA + (size_t)(t + 2) * kstep; const char* b2 = last ? nB : cB + (size_t)(t + 2) * kstep;
            const char* a3 = a2 + kstep; const char* b3 = b2 + kstep;
            if (last && has_next) S.a_ready(nxt);
            if constexpr (SP2) {
            PG8_LDBx(0, 0, 0); PG8_LDBx(1, 0, 1); PG8_SCHED; PG8_LDAx(0, 0); PG8_STAGE(PG8_SA(1, 1), a1 + hstep, voffA);
            PG8_WAIT_V(8); PG8_WAIT_L(0); PG8_BAR; PG8_MMAx(0, 0, 0); PG8_MMAx(0, 1, 1); PG8_BAR; PG8_SCHED;
            PG8_LDAx(0, 1); PG8_STAGE(PG8_SB(0, 0), b2, voffB); PG8_STAGE(PG8_SB(0, 1), b2 + hstep, voffB); PG8_STAGE(PG8_SA(0, 0), a2, voffA);
            PG8_WAIT_V(8); PG8_WAIT_L(0); PG8_BAR; PG8_MMAx(1, 0, 0); PG8_MMAx(1, 1, 1); PG8_BAR; PG8_SCHED;
            PG8_LDBx(0, 1, 0); PG8_LDBx(1, 1, 1); PG8_SCHED; PG8_LDAx(1, 0); PG8_STAGE(PG8_SA(0, 1), a2 + hstep, voffA);
            PG8_WAIT_V(8); PG8_WAIT_L(0); PG8_BAR; PG8_MMAx(0, 0, 0); PG8_MMAx(0, 1, 1); PG8_BAR; PG8_SCHED;
            PG8_LDAx(1, 1); PG8_STAGE(PG8_SB(1, 0), b3, voffB); PG8_STAGE(PG8_SB(1, 1), b3 + hstep, voffB); PG8_STAGE(PG8_SA(1, 0), a3, voffA);
            PG8_WAIT_V(8); PG8_WAIT_L(0); PG8_BAR; PG8_MMAx(1, 0, 0); PG8_MMAx(1, 1, 1); PG8_BAR; PG8_SCHED;
            } else {
            PG8_LDBx(0, 0, 0); PG8_SCHED; PG8_LDAx(0, 0); PG8_STAGE(PG8_SA(1, 1), a1 + hstep, voffA);
            PG8_WAIT_L(8); PG8_BAR; PG8_WAIT_L(0); PG8_MMAx(0, 0, 0); PG8_BAR; PG8_SCHED;
            PG8_LDBx(1, 0, 1); PG8_STAGE(PG8_SB(0, 0), b2, voffB);
            PG8_BAR; PG8_WAIT_L(0); PG8_MMAx(0, 1, 1); PG8_BAR;
            PG8_LDAx(0, 1); PG8_STAGE(PG8_SA(0, 0), a2, voffA);
            PG8_BAR; PG8_WAIT_L(0); PG8_MMAx(1, 0, 0); PG8_BAR; PG8_SCHED;
            PG8_STAGE(PG8_SB(0, 1), b2 + hstep, voffB);
            PG8_WAIT_V(6); PG8_BAR; PG8_MMAx(1, 1, 1); PG8_BAR;
            PG8_LDBx(0, 1, 0); PG8_SCHED; PG8_LDAx(1, 0); PG8_STAGE(PG8_SA(0, 1), a2 + hstep, voffA);
            PG8_WAIT_L(8); PG8_BAR; PG8_WAIT_L(0); PG8_MMAx(0, 0, 0); PG8_BAR; PG8_SCHED;
            PG8_LDBx(1, 1, 1); PG8_STAGE(PG8_SB(1, 0), b3, voffB);
            PG8_BAR; PG8_WAIT_L(0); PG8_MMAx(0, 1, 1); PG8_BAR;
            PG8_LDAx(1, 1); PG8_STAGE(PG8_SA(1, 0), a3, voffA);
            PG8_BAR; PG8_WAIT_L(0); PG8_MMAx(1, 0, 0); PG8_BAR; PG8_SCHED;
            PG8_STAGE(PG8_SB(1, 1), b3 + hstep, voffB);
            PG8_WAIT_V(6); PG8_BAR; PG8_MMAx(1, 1, 1); PG8_BAR;
            }
        }
        if constexpr (ALIGN_EPI) { if (wr == 0) PG8_BAR; }
        if constexpr (!Epi::AFTER_DRAIN) { E(acc, cur, wr, wc, fr, fq); S.done(cur); }
        if (!has_next) break;
#pragma unroll
        for (int a = 0; a < 2; ++a)
#pragma unroll
            for (int b = 0; b < 2; ++b)
#pragma unroll
                for (int m = 0; m < 4; ++m)
#pragma unroll
                    for (int n = 0; n < 2; ++n) acc[a][b][m][n] = (f32x4){0.f, 0.f, 0.f, 0.f};
        cur = nxt; cA = nA; cB = nB; ++ui;
        if constexpr (ALIGN_EPI) { if (wr == 1) PG8_BAR; }
    }
    PG8_WAIT_V(0);
    if constexpr (!ALIGN_EPI) { if (wr == 0) PG8_BAR; }
    PG8_BAR;
    if constexpr (Epi::AFTER_DRAIN) { E.fused(acc, cur, wr, wc, fr, fq, lds, wid, lane); S.done(cur); }
#undef PG8_SA
#undef PG8_SB
#undef PG8_STAGE
#undef PG8_LDA
#undef PG8_LDB
#undef PG8_MMA
#undef PG8_MMA8
#undef PG8_LDAx
#undef PG8_LDBx
#undef PG8_MMAx
#undef PG8_LDA8
#undef PG8_LDB8
#undef PG8_WAIT_V
#undef PG8_WAIT_L
#undef PG8_BAR
#undef PG8_SCHED
}
}
namespace att {
#define ATT_LAS __attribute__((address_space(3)))
typedef short bf16x8 __attribute__((ext_vector_type(8)));
typedef short s16x4 __attribute__((ext_vector_type(4)));
typedef float f32x16 __attribute__((ext_vector_type(16)));
typedef float f32x4 __attribute__((ext_vector_type(4)));
typedef unsigned u32x4 __attribute__((ext_vector_type(4)));
typedef unsigned short bf16;
enum { T_A = 0, T_B = 1, T_C = 2, T_D = 3 };
constexpr int S = 4096, QP = 2816;
constexpr int SLOTB = 8192;
constexpr int NSLOT = 4;
constexpr int L_K = 0, L_V = NSLOT * SLOTB, L_KB = 2 * NSLOT * SLOTB, L_WS = L_KB + NSLOT * 256 + 256, L_TAB = L_WS + 2048, TAB_N = 5600, L_KM = L_TAB + TAB_N * 4, L_OST = L_KM + 4096, L_END = L_OST + 8 * 4096;
static_assert(L_TAB % 16 == 0 && L_KM % 16 == 0 && L_OST % 16 == 0 && L_END <= 131072, "attention LDS map");
constexpr float THR = 8.0f;
__device__ __forceinline__ constexpr int offr(int r) { return (r & 3) + 8 * (r >> 2); }
__device__ __forceinline__ unsigned cvtpk(float lo, float hi) { typedef float f2 __attribute__((ext_vector_type(2))); typedef __bf16 b2 __attribute__((ext_vector_type(2))); f2 v = {lo, hi}; b2 b = __builtin_convertvector(v, b2); return __builtin_bit_cast(unsigned, b); }
__device__ __forceinline__ s16x4 vtr(const ATT_LAS char* p) { typedef short v4i16_t __attribute__((ext_vector_type(4))); return __builtin_bit_cast(s16x4, __builtin_amdgcn_ds_read_tr16_b64_v4i16((ATT_LAS v4i16_t*)p)); }
__device__ __forceinline__ float xhalf_max(float v) { auto rr = __builtin_amdgcn_permlane32_swap(__float_as_uint(v), __float_as_uint(v), false, false); return fmaxf(__uint_as_float(rr[0]), __uint_as_float(rr[1])); }
__device__ __forceinline__ float xhalf_sum(float v) { auto rr = __builtin_amdgcn_permlane32_swap(__float_as_uint(v), __float_as_uint(v), false, false); return __uint_as_float(rr[0]) + __uint_as_float(rr[1]); }

__device__ __forceinline__ void glds16(const void* gsrc, unsigned lds_dst) { unsigned keep;
    asm volatile("s_mov_b32 %0, m0\n\ts_mov_b32 m0, %2\n\ts_nop 0\n\tglobal_load_lds_dwordx4 %1, off\n\ts_mov_b32 m0, %0" : "=&s"(keep) : "v"(gsrc), "s"(lds_dst) : "memory"); }
__device__ __forceinline__ void glds4(const void* gsrc, unsigned lds_dst) { unsigned keep;
    asm volatile("s_mov_b32 %0, m0\n\ts_mov_b32 m0, %2\n\ts_nop 0\n\tglobal_load_lds_dword %1, off\n\ts_mov_b32 m0, %0" : "=&s"(keep) : "v"(gsrc), "s"(lds_dst) : "memory"); }

template <int TYPE>
__device__ __forceinline__ void attn_item(ATT_LAS unsigned char* lds, const bf16* qkv, int b, int h, int qb, int res, int dil_rt, int W_rt, int qcol_rt, int kcol_rt, int vcol_rt, const float* tabg, int tab_id, int& cur_tab, const float* c2bh, const unsigned* nrm, const float* kmbh, float sink2,
                                          bf16* outp, int ldo, float* lse_out) {
    const int tid = threadIdx.x, lane = tid & 63, r32 = lane & 31, hi = lane >> 5; const int wid = __builtin_amdgcn_readfirstlane(tid >> 6);
    constexpr bool BAND = (TYPE == T_A);
    const int W = W_rt; const int DIL = BAND ? dil_rt : 1;
    const int qcol = BAND ? qcol_rt : (TYPE == T_B ? 768 : 2048) + 64 * h;
    const int kcol = BAND ? kcol_rt : (TYPE == T_B ? 1024 : 2304) + 64 * h;
    const int vcol = BAND ? vcol_rt : (TYPE == T_B ? 1280 : 2560) + 64 * h;
    const size_t rowbase = (size_t)b * S + res;
    const int qf0 = 256 * qb, qfw = qf0 + 32 * wid;
    const int kf0 = BAND ? qf0 - 128 : 0, NT = BAND ? 6 : 4 * (qb + 1);
    int tlo = (BAND && qb == 0) ? 2 : 0;
    if (TYPE == T_D) {
        const float qm = __uint_as_float(nrm[0]) + __uint_as_float(nrm[1]), kmx = __uint_as_float(nrm[2]) + __uint_as_float(nrm[3]);
        const float bound = 2.0f * sqrtf(qm * kmx) * 1.01f + 42.0f;
        const float c0 = c2bh[qf0];
        const bool skip = (lane < 4 * qb) && (c0 - c2bh[64 * (lane < 4 * qb ? lane : 0) + 63] < -bound);
        tlo = __builtin_popcountll(__ballot(skip));
    }
    ATT_LAS float* tab = (ATT_LAS float*)(lds + L_TAB);
    ATT_LAS float* km = (ATT_LAS float*)(lds + L_KM);
    ATT_LAS float* wsf = (ATT_LAS float*)(lds + L_WS) + wid * 64;
    const unsigned lds0 = (unsigned)(uintptr_t)lds;
#define ATT_ISSUE(t) do { const int k0_ = kf0 + 64 * (t); const int sl_ = ((t) - tlo) % NSLOT; int kk_ = k0_ + lane; kk_ = kk_ < 0 ? 0 : kk_; \
        glds16(qkv + (rowbase + (size_t)kk_ * DIL) * QP + kcol + wid * 8, (unsigned)__builtin_amdgcn_readfirstlane(lds0 + L_K + sl_ * SLOTB + wid * 1024)); \
        int kv_ = k0_ + 16 * (wid & 3) + (lane >> 2); kv_ = kv_ < 0 ? 0 : kv_; \
        glds16(qkv + (rowbase + (size_t)kv_ * DIL) * QP + vcol + (wid >> 2) * 32 + (lane & 3) * 8, (unsigned)__builtin_amdgcn_readfirstlane(lds0 + L_V + sl_ * SLOTB + wid * 1024)); \
        if (TYPE == T_D) glds4(c2bh + k0_ + lane, (unsigned)__builtin_amdgcn_readfirstlane(lds0 + L_KB + sl_ * 256)); } while (0)
    if (TYPE != T_D) { if (tab_id != cur_tab) { cur_tab = tab_id;
            for (int i = tid; i < TAB_N; i += 512) tab[i] = (i < 4096) ? tabg[4095 - i] : 0.f; } }
    if (TYPE == T_B) { for (int i = tid; i < 16 * 64; i += 512) km[i] = kmbh[i]; }
    bf16x8 qr[4];
    { const bf16* qrow = qkv + (rowbase + (size_t)(qfw + r32) * DIL) * QP + qcol;
#pragma unroll
      for (int d0 = 0; d0 < 4; ++d0) qr[d0] = *(const bf16x8*)(qrow + 16 * d0 + 8 * hi); }
    const float cq = (TYPE == T_D) ? c2bh[qfw + r32] : 0.f;
    ATT_ISSUE(tlo); if (tlo + 1 < NT) ATT_ISSUE(tlo + 1); if (tlo + 2 < NT) ATT_ISSUE(tlo + 2);
    asm volatile("s_waitcnt vmcnt(0)" ::: "memory");
    __syncthreads();
    unsigned sel = 0u;
    if (TYPE == T_B) {
        float g[16];
#pragma unroll
        for (int n = 0; n < 16; ++n) { g[n] = -INFINITY; if (n < qb) { float s = 0.f;
#pragma unroll
                for (int d0 = 0; d0 < 4; ++d0) { const f32x4 a = *(const ATT_LAS f32x4*)(km + n * 64 + 16 * d0 + 8 * hi), c = *(const ATT_LAS f32x4*)(km + n * 64 + 16 * d0 + 8 * hi + 4);
                    const bf16x8 qv = qr[d0];
                    s = fmaf(__builtin_bit_cast(float, (unsigned)(unsigned short)qv[0] << 16), a[0], s); s = fmaf(__builtin_bit_cast(float, (unsigned)(unsigned short)qv[1] << 16), a[1], s);
                    s = fmaf(__builtin_bit_cast(float, (unsigned)(unsigned short)qv[2] << 16), a[2], s); s = fmaf(__builtin_bit_cast(float, (unsigned)(unsigned short)qv[3] << 16), a[3], s);
                    s = fmaf(__builtin_bit_cast(float, (unsigned)(unsigned short)qv[4] << 16), c[0], s); s = fmaf(__builtin_bit_cast(float, (unsigned)(unsigned short)qv[5] << 16), c[1], s);
                    s = fmaf(__builtin_bit_cast(float, (unsigned)(unsigned short)qv[6] << 16), c[2], s); s = fmaf(__builtin_bit_cast(float, (unsigned)(unsigned short)qv[7] << 16), c[3], s); }
                g[n] = xhalf_sum(s); } }
#pragma unroll
        for (int r = 0; r < 3; ++r) { float best = -INFINITY; int bi = -1;
#pragma unroll
            for (int n = 0; n < 16; ++n) if (n < qb && !((sel >> n) & 1u) && g[n] > best) { best = g[n]; bi = n; }
            if (bi >= 0) sel |= 1u << bi; }
    }
    float m = 0.f, l = 0.f; f32x16 o[2]; o[0] = f32x16{}; o[1] = f32x16{};
    const int vpo = ((lane >> 4) & 1) * 32 + (lane & 3) * 8 + (4 * hi + ((lane & 15) >> 2)) * 64;
    f32x16 p0 = f32x16{}, p1 = f32x16{}; u32x4 pw[4] = {u32x4{}, u32x4{}, u32x4{}, u32x4{}};
    const int hb = wid >> 2;
#define ATT_BAR(N) asm volatile("s_waitcnt vmcnt(" #N ") lgkmcnt(0)\n\ts_barrier" ::: "memory")
#define ATT_ACTIVE(T, ACT, PICK) do { const int k0_ = kf0 + 64 * (T); PICK = true; \
        if (BAND) ACT = (k0_ <= qfw + 31) && (k0_ + 63 >= qfw - W); \
        else if (TYPE == T_B) { const bool past_ = k0_ < qf0; PICK = past_ ? ((sel >> (k0_ >> 8)) & 1u) : true; ACT = past_ ? (__ballot(PICK) != 0ull) : (k0_ <= qfw + 31); } \
        else ACT = (k0_ <= qfw + 31); } while (0)
#define ATT_LDK(T, KF) do { const int sl_ = ((T) - tlo) % NSLOT; const ATT_LAS char* kb_ = (const ATT_LAS char*)(lds + L_K + sl_ * SLOTB) + hi * 1024 + r32 * 16; \
        _Pragma("unroll") for (int d0 = 0; d0 < 4; ++d0) { KF[2 * d0] = *(const ATT_LAS bf16x8*)(kb_ + d0 * 2048); KF[2 * d0 + 1] = *(const ATT_LAS bf16x8*)(kb_ + d0 * 2048 + 512); } } while (0)
#define ATT_LDV(T, D0, VF) do { const int sl_ = ((T) - tlo) % NSLOT; const ATT_LAS char* vp = (const ATT_LAS char*)(lds + L_V + sl_ * SLOTB) + vpo; \
        _Pragma("unroll") for (int ks = 0; ks < 4; ++ks) { const s16x4 lo = vtr(vp + (D0) * 4096 + ks * 1024), hh = vtr(vp + (D0) * 4096 + ks * 1024 + 512); \
            VF[ks] = (bf16x8){lo[0], lo[1], lo[2], lo[3], hh[0], hh[1], hh[2], hh[3]}; } } while (0)
#define ATT_QK(KF, P0, P1, PICK) do { \
        f32x16 ci_; { const float c_ = (TYPE == T_B && !(PICK)) ? -INFINITY : cq - m; _Pragma("unroll") for (int r = 0; r < 16; ++r) ci_[r] = c_; } \
        _Pragma("unroll") for (int d0 = 0; d0 < 4; ++d0) { \
            if (d0 == 0) { P0 = __builtin_amdgcn_mfma_f32_32x32x16_bf16(KF[0], qr[0], ci_, 0, 0, 0); P1 = __builtin_amdgcn_mfma_f32_32x32x16_bf16(KF[1], qr[0], ci_, 0, 0, 0); } \
            else { P0 = __builtin_amdgcn_mfma_f32_32x32x16_bf16(KF[2 * d0], qr[d0], P0, 0, 0, 0); P1 = __builtin_amdgcn_mfma_f32_32x32x16_bf16(KF[2 * d0 + 1], qr[d0], P1, 0, 0, 0); } } } while (0)
#define ATT_MOD(T, P0, P1) do { const int sl_ = ((T) - tlo) % NSLOT; const int k0 = kf0 + 64 * (T); \
        const int d0l = qfw + r32 - k0 - 4 * hi; \
        if (TYPE != T_D) { \
            if (TYPE == T_B && qfw - k0 - 63 >= 1513) { const float bfar = tab[0]; \
                _Pragma("unroll") for (int r = 0; r < 16; ++r) { P0[r] += bfar; P1[r] += bfar; } \
            } else { const ATT_LAS float* tb = tab + (4095 - DIL * d0l); \
                _Pragma("unroll") for (int r = 0; r < 16; ++r) { P0[r] += tb[DIL * offr(r)]; P1[r] += tb[DIL * (offr(r) + 32)]; } } \
        } else { const ATT_LAS float* cb = (const ATT_LAS float*)(lds + L_KB + sl_ * 256) + 4 * hi; \
            _Pragma("unroll") for (int i = 0; i < 4; ++i) { const f32x4 c0 = *(const ATT_LAS f32x4*)(cb + 8 * i), c1 = *(const ATT_LAS f32x4*)(cb + 8 * i + 32); \
                _Pragma("unroll") for (int j = 0; j < 4; ++j) { P0[4 * i + j] -= c0[j]; P1[4 * i + j] -= c1[j]; } } } \
        if (k0 + 63 > qfw) { _Pragma("unroll") for (int r = 0; r < 16; ++r) { if (d0l - offr(r) < 0) P0[r] = -INFINITY; if (d0l - offr(r) - 32 < 0) P1[r] = -INFINITY; } } \
        if (BAND) { if (qfw + 31 - k0 > W) { _Pragma("unroll") for (int r = 0; r < 16; ++r) { if (d0l - offr(r) > W) P0[r] = -INFINITY; if (d0l - offr(r) - 32 > W) P1[r] = -INFINITY; } } } \
        float rm = fmaxf(P0[0], P1[0]), rm2 = fmaxf(P0[1], P1[1]); \
        _Pragma("unroll") for (int r = 2; r < 16; r += 2) { rm = fmaxf(fmaxf(rm, P0[r]), P1[r]); rm2 = fmaxf(fmaxf(rm2, P0[r + 1]), P1[r + 1]); } \
        rm = xhalf_max(fmaxf(rm, rm2)); \
        if (__ballot(rm > THR) != 0ull) { const float dl = fmaxf(rm, 0.f); m += dl; \
            _Pragma("unroll") for (int r = 0; r < 16; ++r) { P0[r] -= dl; P1[r] -= dl; } \
            const float f = EX2(-dl); l *= f; \
            if (hi == 0) wsf[r32] = f; \
            asm volatile("s_waitcnt lgkmcnt(0)" ::: "memory"); \
            _Pragma("unroll") for (int i = 0; i < 4; ++i) { const f32x4 fr = *(const ATT_LAS f32x4*)(wsf + 8 * i + 4 * hi); \
                _Pragma("unroll") for (int j = 0; j < 4; ++j) { o[0][4 * i + j] *= fr[j]; o[1][4 * i + j] *= fr[j]; } } } } while (0)
#define ATT_EXP(P0, P1, PW) do { float sacc = 0.f; \
        _Pragma("unroll") for (int r = 0; r < 16; ++r) { P0[r] = EX2(P0[r]); P1[r] = EX2(P1[r]); sacc += P0[r] + P1[r]; } \
        l += sacc; \
        _Pragma("unroll") for (int i = 0; i < 4; ++i) { PW[0][i] = cvtpk(P0[2 * i], P0[2 * i + 1]); PW[1][i] = cvtpk(P0[8 + 2 * i], P0[9 + 2 * i]); PW[2][i] = cvtpk(P1[2 * i], P1[2 * i + 1]); PW[3][i] = cvtpk(P1[8 + 2 * i], P1[9 + 2 * i]); } } while (0)
#define ATT_PV(D0, VF, PW) do { \
        _Pragma("unroll") for (int ks = 0; ks < 4; ++ks) o[D0] = __builtin_amdgcn_mfma_f32_32x32x16_bf16(__builtin_bit_cast(bf16x8, PW[ks]), VF[ks], o[D0], 0, 0, 0); } while (0)
    bool actC, pick0; ATT_ACTIVE(tlo, actC, pick0);
    if (actC) { bf16x8 kf0_[8]; ATT_LDK(tlo, kf0_); ATT_QK(kf0_, p0, p1, pick0); ATT_MOD(tlo, p0, p1); if (hb == 1) ATT_EXP(p0, p1, pw); }
    for (int t = tlo; t < NT; ++t) {
        const bool more1 = t + 1 < NT, more3 = t + 3 < NT;
        if (more3) ATT_ISSUE(t + 3);
        bool actN = false, pickN = true; if (more1) ATT_ACTIVE(t + 1, actN, pickN);
        bf16x8 kf[8], vf[4], vg[4];
        if (actC) ATT_LDV(t, 0, vf);
        __builtin_amdgcn_sched_barrier(0);
        if (hb == 0) { if (actC) ATT_EXP(p0, p1, pw); }
        if (actN) { ATT_LDK(t + 1, kf); ATT_QK(kf, p0, p1, pickN); }
        if (actC) { ATT_LDV(t, 1, vg); __builtin_amdgcn_sched_barrier(0); ATT_PV(0, vf, pw); ATT_PV(1, vg, pw); }
        if (actN) { ATT_MOD(t + 1, p0, p1); if (hb == 1) ATT_EXP(p0, p1, pw); }
        if (more3) { if (TYPE == T_D) ATT_BAR(3); else ATT_BAR(2); }
        else ATT_BAR(0);
        actC = actN;
    }
#undef ATT_BAR
#undef ATT_ACTIVE
#undef ATT_QK
#undef ATT_LDK
#undef ATT_LDV
#undef ATT_MOD
#undef ATT_EXP
#undef ATT_PV
    l = xhalf_sum(l);
    if (BAND) l += EX2(sink2 - m);
    if (hi == 0) wsf[32 + r32] = 1.0f / l;
    asm volatile("s_waitcnt lgkmcnt(0)" ::: "memory");
    {   ATT_LAS bf16* stg = (ATT_LAS bf16*)(lds + L_OST) + wid * 2048;
#pragma unroll
        for (int i = 0; i < 4; ++i) { const f32x4 rl = *(const ATT_LAS f32x4*)(wsf + 32 + 8 * i + 4 * hi);
#pragma unroll
            for (int j = 0; j < 4; ++j) { const int orow = 8 * i + 4 * hi + j;
#pragma unroll
                for (int d0 = 0; d0 < 2; ++d0) { const unsigned w = cvtpk(o[d0][4 * i + j] * rl[j], 0.f); stg[orow * 64 + d0 * 32 + r32] = (bf16)(w & 0xffffu); } } }
        asm volatile("s_waitcnt lgkmcnt(0)" ::: "memory");
#pragma unroll
        for (int i = 0; i < 4; ++i) { const int row = i * 8 + (lane >> 3), ch = lane & 7; const u32x4 v = *(const ATT_LAS u32x4*)(stg + row * 64 + ch * 8);
            *(u32x4*)(outp + (rowbase + (size_t)(qfw + row) * DIL) * ldo + ch * 8) = v; }
    }
    if (BAND) { if (lse_out != nullptr && hi == 0) lse_out[(rowbase + (size_t)(qfw + r32) * DIL) * 4] = m + __builtin_amdgcn_logf(l); }
    __syncthreads();
#undef ATT_ISSUE
}
}

namespace att2 {
#define A2_LAS __attribute__((address_space(3)))
typedef att::bf16x8 bf16x8; typedef att::s16x4 s16x4; typedef att::f32x16 f32x16; typedef att::f32x4 f32x4; typedef att::u32x4 u32x4; typedef unsigned short bf16;
enum { T_B = 1, T_D = 3 };
constexpr int S = 4096, QP = 2816, NW = 8, QBLK = 32, QB = 256, KVBLK = 64;
constexpr int NSLOT = 3, SLOTB = 8192;
constexpr int L_K = 0, L_V = NSLOT * SLOTB, L_WS = 2 * NSLOT * SLOTB, L_OST = L_WS + NW * 64 * 4, L_TAB = L_OST + NW * 4096, TAB_N = 5600, TAB_PADN = 96, L_KM = L_TAB + (TAB_N + TAB_PADN) * 4, L_END = L_KM + 4096;
static_assert(L_TAB % 16 == 0 && L_KM % 16 == 0 && L_END <= 131072, "attention engine 2 LDS map");
constexpr float THR = 8.0f;
typedef A2_LAS const char* lds_cptr;
#define A2_MX3(a, b, c) __builtin_fmaxf(__builtin_fmaxf((a), (b)), (c))
__device__ __forceinline__ void kload8(bf16x8* kf, lds_cptr kp) {
    kf[0] = *(const A2_LAS bf16x8*)(kp);        kf[1] = *(const A2_LAS bf16x8*)(kp + 512);  kf[2] = *(const A2_LAS bf16x8*)(kp + 2048); kf[3] = *(const A2_LAS bf16x8*)(kp + 2560);
    kf[4] = *(const A2_LAS bf16x8*)(kp + 4096); kf[5] = *(const A2_LAS bf16x8*)(kp + 4608); kf[6] = *(const A2_LAS bf16x8*)(kp + 6144); kf[7] = *(const A2_LAS bf16x8*)(kp + 6656);
}
__device__ __forceinline__ void kload2(bf16x8* kf, lds_cptr kp, int j) { kf[2 * j] = *(const A2_LAS bf16x8*)(kp + j * 2048); kf[2 * j + 1] = *(const A2_LAS bf16x8*)(kp + j * 2048 + 512); }
#define A2_SBAR() __builtin_amdgcn_sched_barrier(0)
#define A2_WAIT_BAR(N) asm volatile("s_waitcnt vmcnt(" #N ") lgkmcnt(0)\n\ts_barrier" ::: "memory")
#define A2_MFMA(a, b, c) __builtin_amdgcn_mfma_f32_32x32x16_bf16(a, b, c, 0, 0, 0)

template <int TYPE>
__device__ __forceinline__ void attn_unit2(A2_LAS unsigned char* lds, const bf16* qkv, int b, int h, int qb, const float* tabg, int tab_id, int& cur_tab, const float* c2bh, const unsigned* nrm, const float* kmbh,
                                           bf16* outp, int ldo) {
    int tid_ = threadIdx.x; asm volatile("" : "+v"(tid_));
    const int tid = tid_, lane = tid & 63, r32 = lane & 31, hi = lane >> 5; const int wid = __builtin_amdgcn_readfirstlane(tid >> 6);
    const int qcol = (TYPE == T_B ? 768 : 2048) + 64 * h, kcol = (TYPE == T_B ? 1024 : 2304) + 64 * h, vcol = (TYPE == T_B ? 1280 : 2560) + 64 * h;
    const size_t rowbase = (size_t)b * S; const int q0 = QB * qb, qrel = wid * QBLK + r32, qrow = q0 + qrel;
    int tlo = 0;
    if (TYPE == T_D) {
        const float qm = __uint_as_float(nrm[0]) + __uint_as_float(nrm[1]), kmx = __uint_as_float(nrm[2]) + __uint_as_float(nrm[3]);
        const float bound = 2.0f * sqrtf(qm * kmx) * 1.01f + 42.0f;
        const float c0 = c2bh[q0];
        const bool skip = (lane < 4 * qb) && (c0 - c2bh[64 * (lane < 4 * qb ? lane : 0) + 63] < -bound);
        tlo = __builtin_popcountll(__ballot(skip)) & ~1;
    }
    const int NT = 4 * (qb + 1) - tlo, key0 = 64 * tlo;
    A2_LAS float* tab = (A2_LAS float*)(lds + L_TAB);
    A2_LAS float* km = (A2_LAS float*)(lds + L_KM);
    A2_LAS float* wsf = (A2_LAS float*)(lds + L_WS) + wid * 64;
    const unsigned lds0 = (unsigned)(uintptr_t)lds;
    if (TYPE == T_B) { if (tab_id != cur_tab) { cur_tab = tab_id; for (int i = tid; i < TAB_N + TAB_PADN; i += 512) tab[i] = (i < 4096) ? tabg[4095 - i] : (i < TAB_N ? 0.f : -INFINITY); }
        for (int i = tid; i < 16 * 64; i += 512) km[i] = kmbh[i]; }
    else { cur_tab = -1; for (int i = tid; i < NT * 64; i += 512) tab[i] = c2bh[key0 + i]; }
    const bf16* ksrc = qkv + (rowbase + key0 + lane) * QP + kcol + wid * 8;
    const bf16* vsrc = qkv + (rowbase + key0 + 16 * (wid & 3) + (lane >> 2)) * QP + vcol + (wid >> 2) * 32 + (lane & 3) * 8;
    const unsigned kdst = lds0 + L_K + wid * 1024, vdst = lds0 + L_V + wid * 1024;
#define A2_DMA_K(t, slot) att::glds16(ksrc + (size_t)(t) * KVBLK * QP, (unsigned)__builtin_amdgcn_readfirstlane(kdst + (slot)))
#define A2_DMA_V(t, slot) att::glds16(vsrc + (size_t)(t) * KVBLK * QP, (unsigned)__builtin_amdgcn_readfirstlane(vdst + (slot)))
    const lds_cptr shm3 = (lds_cptr)lds; const lds_cptr kp0 = shm3 + L_K + hi * 1024 + r32 * 16; const lds_cptr vp0 = shm3 + L_V + ((lane >> 4) & 1) * 32 + (lane & 3) * 8 + (4 * hi + ((lane & 15) >> 2)) * 64;
    bf16x8 kf[8];
    A2_DMA_K(0, 0); A2_DMA_V(0, 0); A2_DMA_K(1, SLOTB);
    bf16x8 qr[4];
    { const bf16* qp = qkv + (rowbase + qrow) * QP + qcol;
#pragma unroll
      for (int d0 = 0; d0 < 4; ++d0) qr[d0] = *(const bf16x8*)(qp + d0 * 16 + hi * 8); }
    const float cq = (TYPE == T_D) ? c2bh[qrow] : 0.f;
    float mhat = 0.f, l_reg = 0.f; f32x16 o[2]; o[0] = f32x16{}; o[1] = f32x16{};
    bool resc = false;
    A2_DMA_K(2, 2 * SLOTB);
    A2_WAIT_BAR(3);
    unsigned sel = 0u;
    if (TYPE == T_B) {
        float g[16];
#pragma unroll
        for (int n = 0; n < 16; ++n) { g[n] = -INFINITY; if (n < qb) { float s = 0.f;
#pragma unroll
                for (int d0 = 0; d0 < 4; ++d0) { const f32x4 a = *(const A2_LAS f32x4*)(km + n * 64 + 16 * d0 + 8 * hi), c = *(const A2_LAS f32x4*)(km + n * 64 + 16 * d0 + 8 * hi + 4);
                    const bf16x8 qv = qr[d0];
                    s = fmaf(__builtin_bit_cast(float, (unsigned)(unsigned short)qv[0] << 16), a[0], s); s = fmaf(__builtin_bit_cast(float, (unsigned)(unsigned short)qv[1] << 16), a[1], s);
                    s = fmaf(__builtin_bit_cast(float, (unsigned)(unsigned short)qv[2] << 16), a[2], s); s = fmaf(__builtin_bit_cast(float, (unsigned)(unsigned short)qv[3] << 16), a[3], s);
                    s = fmaf(__builtin_bit_cast(float, (unsigned)(unsigned short)qv[4] << 16), c[0], s); s = fmaf(__builtin_bit_cast(float, (unsigned)(unsigned short)qv[5] << 16), c[1], s);
                    s = fmaf(__builtin_bit_cast(float, (unsigned)(unsigned short)qv[6] << 16), c[2], s); s = fmaf(__builtin_bit_cast(float, (unsigned)(unsigned short)qv[7] << 16), c[3], s); }
                g[n] = att::xhalf_sum(s); } }
#pragma unroll
        for (int r = 0; r < 3; ++r) { float best = -INFINITY; int bi = -1;
#pragma unroll
            for (int n = 0; n < 16; ++n) if (n < qb && !((sel >> n) & 1u) && g[n] > best) { best = g[n]; bi = n; }
            if (bi >= 0) sel |= 1u << bi; }
    }
#define A2_CB(tau, CB0, CB1) do { const float base_ = cq - mhat; \
        if (TYPE == T_D) { const A2_LAS float* cp_ = tab + 64 * (tau) + 4 * hi; \
            _Pragma("unroll") for (int r = 0; r < 16; ++r) { CB0[r] = base_ - cp_[att::offr(r)]; CB1[r] = base_ - cp_[att::offr(r) + 32]; } \
        } else { const int k0_ = key0 + 64 * (tau); const bool pick_ = (k0_ < q0) ? ((sel >> (k0_ >> 8)) & 1u) : true; \
            const A2_LAS float* tb_ = pick_ ? tab + (4095 - (qrow - k0_ - 4 * hi)) : tab + TAB_N; \
            _Pragma("unroll") for (int r = 0; r < 16; ++r) { CB0[r] = tb_[att::offr(r)] + base_; CB1[r] = tb_[att::offr(r) + 32] + base_; } } } while (0)
#define A2_CMASK(P0, P1, t) do { const int jb_ = (t) - (NT - 4); if (jb_ >= 0) { const int kb_ = 64 * jb_ + 4 * hi; \
        _Pragma("unroll") for (int r = 0; r < 16; ++r) { const int kv_ = kb_ + att::offr(r); if (kv_ > qrel) P0[r] = -INFINITY; if (kv_ + 32 > qrel) P1[r] = -INFINITY; } } } while (0)
#define A2_DECIDE(C0, C1) do { float a_ = A2_MX3(C0[0], C0[1], C1[0]), b_ = A2_MX3(C0[2], C0[3], C1[1]); a_ = A2_MX3(a_, C1[2], C1[3]); \
        _Pragma("unroll") for (int r = 4; r < 16; r += 4) { a_ = A2_MX3(a_, C0[r], C0[r + 1]); b_ = A2_MX3(b_, C0[r + 2], C0[r + 3]); a_ = A2_MX3(a_, C1[r], C1[r + 1]); b_ = A2_MX3(b_, C1[r + 2], C1[r + 3]); } \
        const float rm_ = att::xhalf_max(__builtin_fmaxf(a_, b_)); \
        resc = false; \
        if (__builtin_expect(__ballot(rm_ > THR) != 0ull, 0)) { const float dl_ = __builtin_fmaxf(rm_, 0.f); mhat += dl_; \
            _Pragma("unroll") for (int r = 0; r < 16; ++r) { C0[r] -= dl_; C1[r] -= dl_; } \
            const float f_ = EX2(-dl_); l_reg *= f_; if (hi == 0) wsf[r32] = f_; resc = true; } } while (0)
#define A2_RESC() do { if (resc) { asm volatile("s_waitcnt lgkmcnt(0)" ::: "memory"); \
        _Pragma("unroll") for (int i = 0; i < 4; ++i) { const f32x4 fr_ = *(const A2_LAS f32x4*)(wsf + 8 * i + 4 * hi); \
            _Pragma("unroll") for (int j = 0; j < 4; ++j) { o[0][4 * i + j] *= fr_[j]; o[1][4 * i + j] *= fr_[j]; } } } } while (0)
    f32x16 pA0, pA1, pB0, pB1;
    int sl_prev = 0, sl_cur = 0, sl_next = SLOTB;
#define A2_ROT() do { sl_prev = sl_cur; sl_cur = sl_next; sl_next = (sl_next == (NSLOT - 1) * SLOTB) ? 0 : sl_next + SLOTB; } while (0)
    { A2_CB(0, pA0, pA1); kload8(kf, kp0);
#pragma unroll
      for (int d0 = 0; d0 < 4; ++d0) { pA0 = A2_MFMA(kf[2 * d0], qr[d0], pA0); pA1 = A2_MFMA(kf[2 * d0 + 1], qr[d0], pA1); } }
    A2_CMASK(pA0, pA1, 0);
    A2_DECIDE(pA0, pA1);
#pragma unroll
    for (int r = 0; r < 16; ++r) { pA0[r] = EX2(pA0[r]); pA1[r] = EX2(pA1[r]); }
    A2_WAIT_BAR(0);
    A2_RESC();
    A2_DMA_K(3, 0); A2_DMA_V(1, SLOTB);
    A2_ROT();
    kload8(kf, kp0 + sl_cur);
    A2_WAIT_BAR(2);
    s16x4 vlo[8], vhi[8]; u32x4 pw0, pw1, pw2, pw3;
#define A2_PKW(P, B) att::cvtpk(P[B], P[B + 1])
#define A2_PAF(k) __builtin_bit_cast(bf16x8, pw##k)
#define A2_VFR(i) (bf16x8){vlo[i][0], vlo[i][1], vlo[i][2], vlo[i][3], vhi[i][0], vhi[i][1], vhi[i][2], vhi[i][3]}
#define A2_PIN(x) asm volatile("" : "+v"(x))
#define A2_GAPA(MF, A0, A1, A2, A3, W0, W1, PW) do { MF; sacc += A0; sacc += A1; sacc += A2; sacc += A3; A2_PIN(sacc); W0; W1; A2_PIN(PW); A2_SBAR(); } while (0)
#define A2_GAPB(MF, X, B) do { MF; X[B] = EX2(X[B]); X[B + 1] = EX2(X[B + 1]); X[B + 2] = EX2(X[B + 2]); X[B + 3] = EX2(X[B + 3]); A2_PIN(X); A2_SBAR(); } while (0)
#define A2_VRD(i) do { vlo[i] = att::vtr(vp_ + (((i) >> 2) * 4096 + ((i) & 3) * 1024)); vhi[i] = att::vtr(vp_ + (((i) >> 2) * 4096 + ((i) & 3) * 1024 + 512)); } while (0)
#define A2_KRD(G, j) do { if (G) { kload2(kf, kp0 + sl_next, j); A2_SBAR(); } } while (0)
#define A2_STEP(C0, C1, P0, P1, t, GK, GV, GL, MASKED) do { A2_SBAR(); \
        A2_CB(t, C0, C1); A2_SBAR();     \
        const lds_cptr vp_ = vp0 + sl_prev; \
        A2_VRD(0); A2_SBAR(); float sacc = (P0[0] + P0[1]); \
        A2_GAPA(C0 = A2_MFMA(kf[0], qr[0], C0), P0[2], P0[3], P0[4], P0[5],     pw0[0] = A2_PKW(P0, 0),  pw0[1] = A2_PKW(P0, 2),  pw0); \
        A2_VRD(4); A2_SBAR(); A2_GAPA(C1 = A2_MFMA(kf[1], qr[0], C1), P0[6], P0[7], P0[8], P0[9],     pw0[2] = A2_PKW(P0, 4),  pw0[3] = A2_PKW(P0, 6),  pw0); \
        A2_VRD(1); A2_SBAR(); A2_GAPA(C0 = A2_MFMA(kf[2], qr[1], C0),   P0[10], P0[11], P0[12], P0[13], pw1[0] = A2_PKW(P0, 8),  pw1[1] = A2_PKW(P0, 10), pw1); \
        A2_VRD(5); A2_SBAR(); A2_GAPA(C1 = A2_MFMA(kf[3], qr[1], C1),   P0[14], P0[15], P1[0], P1[1],   pw1[2] = A2_PKW(P0, 12), pw1[3] = A2_PKW(P0, 14), pw1); \
        A2_VRD(2); A2_SBAR(); A2_GAPA(C0 = A2_MFMA(kf[4], qr[2], C0),   P1[2], P1[3], P1[4], P1[5],     pw2[0] = A2_PKW(P1, 0),  pw2[1] = A2_PKW(P1, 2),  pw2); \
        A2_VRD(6); A2_SBAR(); A2_GAPA(C1 = A2_MFMA(kf[5], qr[2], C1),   P1[6], P1[7], P1[8], P1[9],     pw2[2] = A2_PKW(P1, 4),  pw2[3] = A2_PKW(P1, 6),  pw2); \
        A2_VRD(3); A2_SBAR(); A2_GAPA(C0 = A2_MFMA(kf[6], qr[3], C0),   P1[10], P1[11], P1[12], P1[13], pw3[0] = A2_PKW(P1, 8),  pw3[1] = A2_PKW(P1, 10), pw3); \
        A2_VRD(7); A2_SBAR(); A2_GAPA(C1 = A2_MFMA(kf[7], qr[3], C1),   P1[14], P1[15], 0.f, 0.f,       pw3[2] = A2_PKW(P1, 12), pw3[3] = A2_PKW(P1, 14), pw3); \
        l_reg += sacc; \
        if (GK) { A2_DMA_K((t) + 3, sl_cur); } if (GV) { A2_DMA_V((t) + 1, sl_next); } \
        if (MASKED) A2_CMASK(C0, C1, t); \
        A2_DECIDE(C0, C1); \
        A2_SBAR(); \
        A2_GAPB(o[0] = A2_MFMA(A2_PAF(0), A2_VFR(0), o[0]), C0, 0); \
        A2_GAPB(o[1] = A2_MFMA(A2_PAF(0), A2_VFR(4), o[1]), C0, 4); \
        A2_KRD(GL, 0); A2_GAPB(o[0] = A2_MFMA(A2_PAF(1), A2_VFR(1), o[0]), C0, 8); \
        A2_KRD(GL, 1); A2_GAPB(o[1] = A2_MFMA(A2_PAF(1), A2_VFR(5), o[1]), C0, 12); \
        A2_KRD(GL, 2); A2_GAPB(o[0] = A2_MFMA(A2_PAF(2), A2_VFR(2), o[0]), C1, 0); \
        A2_KRD(GL, 3); A2_GAPB(o[1] = A2_MFMA(A2_PAF(2), A2_VFR(6), o[1]), C1, 4); \
        A2_GAPB(o[0] = A2_MFMA(A2_PAF(3), A2_VFR(3), o[0]), C1, 8); \
        A2_GAPB(o[1] = A2_MFMA(A2_PAF(3), A2_VFR(7), o[1]), C1, 12); \
    } while (0)
    int t = 1;
    for (; t + 5 < NT; t += 2) {
        A2_STEP(pB0, pB1, pA0, pA1, t, true, true, true, false);     A2_WAIT_BAR(2); A2_RESC(); A2_ROT();
        A2_STEP(pA0, pA1, pB0, pB1, t + 1, true, true, true, false); A2_WAIT_BAR(2); A2_RESC(); A2_ROT();
    }
#define A2_ENDW(tt) do { if ((tt) + 3 < NT) { A2_WAIT_BAR(2); } else if ((tt) + 2 < NT) { A2_WAIT_BAR(1); } else { A2_WAIT_BAR(0); } } while (0)
    for (; t + 1 < NT; t += 2) {
        A2_STEP(pB0, pB1, pA0, pA1, t, (t + 3 < NT), (t + 1 < NT), (t + 1 < NT), true);         A2_ENDW(t);     A2_RESC(); A2_ROT();
        A2_STEP(pA0, pA1, pB0, pB1, t + 1, (t + 4 < NT), (t + 2 < NT), (t + 2 < NT), true);     A2_ENDW(t + 1); A2_RESC(); A2_ROT();
    }
    A2_STEP(pB0, pB1, pA0, pA1, NT - 1, false, false, false, true); A2_RESC();
    { float sacc = pB0[0] + pB0[1];
#pragma unroll
      for (int r = 2; r < 16; ++r) sacc += pB0[r];
#pragma unroll
      for (int r = 0; r < 16; ++r) sacc += pB1[r];
      l_reg += sacc;
      pw0 = (u32x4){A2_PKW(pB0, 0), A2_PKW(pB0, 2), A2_PKW(pB0, 4), A2_PKW(pB0, 6)}; pw1 = (u32x4){A2_PKW(pB0, 8), A2_PKW(pB0, 10), A2_PKW(pB0, 12), A2_PKW(pB0, 14)};
      pw2 = (u32x4){A2_PKW(pB1, 0), A2_PKW(pB1, 2), A2_PKW(pB1, 4), A2_PKW(pB1, 6)}; pw3 = (u32x4){A2_PKW(pB1, 8), A2_PKW(pB1, 10), A2_PKW(pB1, 12), A2_PKW(pB1, 14)};
      A2_SBAR();
      const lds_cptr vp_ = vp0 + sl_cur;
#pragma unroll
      for (int i = 0; i < 8; ++i) A2_VRD(i);
      o[0] = A2_MFMA(A2_PAF(0), A2_VFR(0), o[0]); o[0] = A2_MFMA(A2_PAF(1), A2_VFR(1), o[0]); o[0] = A2_MFMA(A2_PAF(2), A2_VFR(2), o[0]); o[0] = A2_MFMA(A2_PAF(3), A2_VFR(3), o[0]);
      o[1] = A2_MFMA(A2_PAF(0), A2_VFR(4), o[1]); o[1] = A2_MFMA(A2_PAF(1), A2_VFR(5), o[1]); o[1] = A2_MFMA(A2_PAF(2), A2_VFR(6), o[1]); o[1] = A2_MFMA(A2_PAF(3), A2_VFR(7), o[1]); }
    l_reg = att::xhalf_sum(l_reg);
    if (hi == 0) wsf[32 + r32] = 1.0f / l_reg;
    asm volatile("s_waitcnt lgkmcnt(0)" ::: "memory");
    {   A2_LAS bf16* stg = (A2_LAS bf16*)(lds + L_OST) + wid * 2048;
#pragma unroll
        for (int i = 0; i < 4; ++i) { const f32x4 rl = *(const A2_LAS f32x4*)(wsf + 32 + 8 * i + 4 * hi);
#pragma unroll
            for (int j = 0; j < 4; ++j) { const int orow = 8 * i + 4 * hi + j;
#pragma unroll
                for (int d0 = 0; d0 < 2; ++d0) { const unsigned w = att::cvtpk(o[d0][4 * i + j] * rl[j], 0.f); stg[orow * 64 + d0 * 32 + r32] = (bf16)(w & 0xffffu); } } }
        asm volatile("s_waitcnt lgkmcnt(0)" ::: "memory");
#pragma unroll
        for (int i = 0; i < 4; ++i) { const int row = i * 8 + (lane >> 3), ch = lane & 7; const u32x4 v = *(const A2_LAS u32x4*)(stg + row * 64 + ch * 8);
            *(u32x4*)(outp + (rowbase + q0 + wid * QBLK + row) * ldo + ch * 8) = v; }
    }
    asm volatile("s_waitcnt lgkmcnt(0)\n\ts_barrier" ::: "memory");
#undef A2_DMA_K
#undef A2_DMA_V
#undef A2_CB
#undef A2_CMASK
#undef A2_DECIDE
#undef A2_RESC
#undef A2_ROT
#undef A2_PKW
#undef A2_PAF
#undef A2_VFR
#undef A2_PIN
#undef A2_GAPA
#undef A2_GAPB
#undef A2_VRD
#undef A2_KRD
#undef A2_STEP
#undef A2_ENDW
}
}

namespace att3 {
#define A3_LAS __attribute__((address_space(3)))
typedef att::bf16x8 bf16x8; typedef att::s16x4 s16x4; typedef att::f32x16 f32x16; typedef att::f32x4 f32x4; typedef att::u32x4 u32x4; typedef unsigned short bf16;
constexpr int S = 4096, QP = 2816, SLOTB = 8192;
constexpr int L_K = 0, L_V = 6 * SLOTB, L_WS = 12 * SLOTB, L_TAB = L_WS + 2048, TAB_N = 5600, L_END = L_TAB + TAB_N * 4;
static_assert(L_TAB % 16 == 0 && L_END <= 131072, "attention engine 3 LDS map");
#define A3_MFMA(a, b, c) __builtin_amdgcn_mfma_f32_32x32x16_bf16(a, b, c, 0, 0, 0)

struct BandSrc { const bf16* k; const bf16* v; int rs, kw, tmin; };
__device__ __forceinline__ void band_dma(unsigned lds_region, const bf16* src, int rs, int kw, int tmin, bool isV, int wid, int lane) {
    for (int t = tmin; t < 6; ++t) { const int k0 = kw + 64 * t;
        if (!isV) att::glds16(src + (size_t)(k0 + lane) * rs + wid * 8, (unsigned)__builtin_amdgcn_readfirstlane(lds_region + t * SLOTB + wid * 1024));
        else att::glds16(src + (size_t)(k0 + 16 * (wid & 3) + (lane >> 2)) * rs + (wid >> 2) * 32 + (lane & 3) * 8, (unsigned)__builtin_amdgcn_readfirstlane(lds_region + t * SLOTB + wid * 1024)); }
}
#define A3_WAITV(n4, n6) do { if (n4) asm volatile("s_waitcnt vmcnt(4)" ::: "memory"); else if (n6) asm volatile("s_waitcnt vmcnt(6)" ::: "memory"); else asm volatile("s_waitcnt vmcnt(0)" ::: "memory"); } while (0)
template <int DIL>
__device__ __forceinline__ void attn_band(A3_LAS unsigned char* lds, const bf16* qkv, int b, int h, int qb, int res, int W, int qcol, int kcol, int vcol,
                                          const float* tabg, int tab_id, int& cur_tab, float sink2, bf16* outp, int ldo, float* lse_out, const BandSrc nx, const bool nxt) {
    int tid_ = threadIdx.x; asm volatile("" : "+v"(tid_));
    const int tid = tid_, lane = tid & 63, r32 = lane & 31, hi = lane >> 5; const int wid = __builtin_amdgcn_readfirstlane(tid >> 6);
    const size_t rowbase = (size_t)b * S + res;
    const int q0 = 256 * qb, kw = q0 - 128, tmin = (qb == 0) ? 2 : 0, ta = wid >> 1;
    A3_LAS float* tab = (A3_LAS float*)(lds + L_TAB);
    A3_LAS float* wsf = (A3_LAS float*)(lds + L_WS) + wid * 64;
    const unsigned lds0 = (unsigned)(uintptr_t)lds;
    if (tab_id != cur_tab) { cur_tab = tab_id; for (int i = tid; i < TAB_N; i += 512) tab[i] = (i < 4096 && 4095 - i <= W * DIL) ? tabg[4095 - i] : -INFINITY; }
    const int qfw = q0 + 32 * wid;
    bf16x8 qr[4];
    { const bf16* qrow = qkv + (rowbase + (size_t)(qfw + r32) * DIL) * QP + qcol;
#pragma unroll
      for (int d0 = 0; d0 < 4; ++d0) qr[d0] = *(const bf16x8*)(qrow + 16 * d0 + 8 * hi); }
    A3_WAITV(tmin == 2, tmin == 0);
    __syncthreads();
    f32x16 p[3][2];
#pragma unroll
    for (int i = 0; i < 3; ++i) {
        const int t = ta + i;
        if (t >= tmin) {
            const A3_LAS char* kb = (const A3_LAS char*)(lds + L_K + t * SLOTB) + hi * 1024 + r32 * 16;
            f32x16& a0 = p[i][0]; f32x16& a1 = p[i][1];
#pragma unroll
            for (int d0 = 0; d0 < 4; ++d0) { const bf16x8 b0 = *(const A3_LAS bf16x8*)(kb + d0 * 2048), b1 = *(const A3_LAS bf16x8*)(kb + d0 * 2048 + 512);
                if (d0 == 0) { a0 = A3_MFMA(b0, qr[0], f32x16{}); a1 = A3_MFMA(b1, qr[0], f32x16{}); } else { a0 = A3_MFMA(b0, qr[d0], a0); a1 = A3_MFMA(b1, qr[d0], a1); } }
            const int d0l = qfw + r32 - (kw + 64 * t) - 4 * hi;
            const A3_LAS float* tb = tab + (4095 - DIL * d0l);
#pragma unroll
            for (int r = 0; r < 16; ++r) { a0[r] += tb[DIL * att::offr(r)]; a1[r] += tb[DIL * (att::offr(r) + 32)]; }
        }
    }
    __syncthreads();
    if (nxt) band_dma(lds0 + L_K, nx.k, nx.rs, nx.kw, nx.tmin, false, wid, lane);
    float m = -INFINITY, m2 = -INFINITY;
#pragma unroll
    for (int i = 0; i < 3; ++i) { if (ta + i >= tmin) {
#pragma unroll
        for (int r = 0; r < 16; r += 2) { m = __builtin_fmaxf(__builtin_fmaxf(m, p[i][0][r]), p[i][0][r + 1]); m2 = __builtin_fmaxf(__builtin_fmaxf(m2, p[i][1][r]), p[i][1][r + 1]); } } }
    m = __builtin_fmaxf(m, m2);
    m = att::xhalf_max(m);
    const float negm = -m;
    if (nxt) A3_WAITV(nx.tmin == 2, nx.tmin == 0); else A3_WAITV(false, false);
    __syncthreads();
    float l = 0.f; f32x16 o[2]; o[0] = f32x16{}; o[1] = f32x16{};
    const int vpo = ((lane >> 4) & 1) * 32 + (lane & 3) * 8 + (4 * hi + ((lane & 15) >> 2)) * 64;
#pragma unroll
    for (int i = 0; i < 3; ++i) {
        const int t = ta + i;
        if (t >= tmin) {
            float sacc = 0.f;
#pragma unroll
            for (int r = 0; r < 16; ++r) { p[i][0][r] = EX2(p[i][0][r] + negm); p[i][1][r] = EX2(p[i][1][r] + negm); sacc += p[i][0][r] + p[i][1][r]; }
            l += sacc;
            u32x4 pw[4];
#pragma unroll
            for (int j = 0; j < 4; ++j) { pw[0][j] = att::cvtpk(p[i][0][2 * j], p[i][0][2 * j + 1]); pw[1][j] = att::cvtpk(p[i][0][8 + 2 * j], p[i][0][9 + 2 * j]); pw[2][j] = att::cvtpk(p[i][1][2 * j], p[i][1][2 * j + 1]); pw[3][j] = att::cvtpk(p[i][1][8 + 2 * j], p[i][1][9 + 2 * j]); }
            const A3_LAS char* vp = (const A3_LAS char*)(lds + L_V + t * SLOTB) + vpo;
#pragma unroll
            for (int d0 = 0; d0 < 2; ++d0)
#pragma unroll
                for (int ks = 0; ks < 4; ++ks) { const s16x4 lo = att::vtr(vp + d0 * 4096 + ks * 1024), hh = att::vtr(vp + d0 * 4096 + ks * 1024 + 512);
                    const bf16x8 vf = (bf16x8){lo[0], lo[1], lo[2], lo[3], hh[0], hh[1], hh[2], hh[3]};
                    o[d0] = A3_MFMA(__builtin_bit_cast(bf16x8, pw[ks]), vf, o[d0]); }
        }
    }
    l = att::xhalf_sum(l);
    l += EX2(sink2 - m);
    if (hi == 0) wsf[32 + r32] = 1.0f / l;
    __syncthreads();
    {   A3_LAS bf16* stg = (A3_LAS bf16*)(lds + L_V) + wid * 2048;
#pragma unroll
        for (int i = 0; i < 4; ++i) { const f32x4 rl = *(const A3_LAS f32x4*)(wsf + 32 + 8 * i + 4 * hi);
#pragma unroll
            for (int j = 0; j < 4; ++j) { const int orow = 8 * i + 4 * hi + j;
#pragma unroll
                for (int d0 = 0; d0 < 2; ++d0) { const unsigned w = att::cvtpk(o[d0][4 * i + j] * rl[j], 0.f); stg[orow * 64 + d0 * 32 + r32] = (bf16)(w & 0xffffu); } } }
        asm volatile("s_waitcnt lgkmcnt(0)" ::: "memory");
#pragma unroll
        for (int i = 0; i < 4; ++i) { const int row = i * 8 + (lane >> 3), ch = lane & 7; const u32x4 v = *(const A3_LAS u32x4*)(stg + row * 64 + ch * 8);
            *(u32x4*)(outp + (rowbase + (size_t)(qfw + row) * DIL) * ldo + ch * 8) = v; }
    }
    if (lse_out != nullptr && hi == 0) lse_out[(rowbase + (size_t)(qfw + r32) * DIL) * 4] = m + __builtin_amdgcn_logf(l);
    asm volatile("s_waitcnt lgkmcnt(0)" ::: "memory"); __syncthreads();
    if (nxt) band_dma(lds0 + L_V, nx.v, nx.rs, nx.kw, nx.tmin, true, wid, lane);
}
}

#ifndef PG8_SP2
#define PG8_SP2 true
#endif
#ifndef PG8_ALIGN
#define PG8_ALIGN true
#endif

constexpr int NWAVES = 8;
constexpr int NB = 8, S = 4096, DM = 1024, M = NB * S, HD = 64, QP = 2816, NIN = 2820, DFF = 2816, NGU = 5632, DEPTH = 2;
constexpr float LOG2E = 1.4426950408889634f, C2 = 0.125f * LOG2E, EPS = 1e-6f;
constexpr int C_QA = 0, C_KA = 256, C_VA = 512, C_QB = 768, C_KB = 1024, C_VB = 1280, C_QC = 1536, C_KC = 1792, C_VC = 1920, C_QD = 2048, C_KD = 2304, C_VD = 2560;
constexpr int NPHASE = 14, PH_PER_LAYER = 6;
constexpr int N_LAUNCHES = MK_N_LAUNCHES;

constexpr size_t MiB = 1u << 20;
constexpr size_t WS_CTL = 0, CTL_ZERO_BYTES = 1 * MiB;
constexpr size_t WS_WIN = 1 * MiB;
constexpr size_t WS_WOUT = 12 * MiB;
constexpr size_t WS_WGU = 16 * MiB;
constexpr size_t WS_WDN = 38 * MiB;
constexpr size_t WS_SMALL = 49 * MiB;
constexpr size_t WS_WFD = WS_SMALL;
constexpr size_t WS_BIAST = WS_SMALL + 64 * 1024;
constexpr size_t WS_RSTD = WS_SMALL + 256 * 1024;
constexpr size_t WS_LF = WS_SMALL + 512 * 1024;
constexpr size_t WS_C2 = WS_SMALL + 1024 * 1024;
constexpr size_t WS_KMEAN = WS_SMALL + 1536 * 1024;
constexpr size_t WS_XB = 52 * MiB;
constexpr size_t WS_MIX = 116 * MiB;
constexpr size_t WS_QKV = 180 * MiB;
constexpr size_t WS_PA = 356 * MiB;
constexpr size_t WS_LSE = 404 * MiB;
constexpr size_t WS_SS = 406 * MiB;
constexpr size_t WS_FD = 408 * MiB;
constexpr size_t WS_X8 = 416 * MiB;
constexpr size_t WS_END = 448 * MiB;
constexpr float WSCALE = 64.0f, ASCALE = 8.0f;
constexpr int CW_BAR = 4096, CW_NORM = 16384, CW_KMEAN = 65536;
constexpr int CW_UNUSED_ = 0;

constexpr int RING_OFF = 0, RING_BYTES = 131072;
constexpr int LDSCTL_OFF = RING_BYTES, MISC_OFF = LDSCTL_OFF + 320;
constexpr int LDS_BYTES = 147456;

#define GAS __attribute__((address_space(1)))
#define LAS __attribute__((address_space(3)))
typedef unsigned short bf16;
typedef unsigned v4u __attribute__((ext_vector_type(4)));
typedef float f32x4 __attribute__((ext_vector_type(4)));
typedef GAS unsigned gu32;
#define RLX_AGENT __ATOMIC_RELAXED, __HIP_MEMORY_SCOPE_AGENT
#define LDS_WAIT() asm volatile("s_waitcnt lgkmcnt(0)" ::: "memory")
__device__ __forceinline__ unsigned f2bf(float f) { unsigned u = __builtin_bit_cast(unsigned, f); return (u + 0x7fffu + ((u >> 16) & 1u)) >> 16; }
__device__ __forceinline__ unsigned pk2(float lo, float hi) { return f2bf(lo) | (f2bf(hi) << 16); }
__device__ __forceinline__ float bflo(unsigned w) { return __builtin_bit_cast(float, w << 16); }
__device__ __forceinline__ float bfhi(unsigned w) { return __builtin_bit_cast(float, w & 0xffff0000u); }

#define XB_TMO      128
#define XB_XCNT(j)  (256  + 64 * (j))
#define XB_XSUB(j)  (1280 + 64 * (j))
#define XB_XGEN(j)  (2304 + 64 * (j))
#define XB_TOP      3328
#define XB_TOPGEN   3392
#define XCD_BAR_WORDS 3456
#define XB_SPIN_CAP (1u << 18)

__device__ __forceinline__ unsigned xb_ld(unsigned* p)              { return __hip_atomic_load(p, __ATOMIC_RELAXED, __HIP_MEMORY_SCOPE_AGENT); }
__device__ __forceinline__ unsigned xb_add(unsigned* p, unsigned v) { return __hip_atomic_fetch_add(p, v, __ATOMIC_RELAXED, __HIP_MEMORY_SCOPE_AGENT); }
__device__ __forceinline__ unsigned xb_xcc_id() { return (unsigned)__builtin_amdgcn_s_getreg((3 << 11) | 20) & 0xFu; }
#define XB_SPIN(cond, bar) do { unsigned _sp = 0; while (cond) { __builtin_amdgcn_s_sleep(1); \
    if ((++_sp & 255u) == 0u) { if (xb_ld(&(bar)[XB_TMO])) break; if (_sp > XB_SPIN_CAP) { atomicAdd(&(bar)[XB_TMO], 1u); break; } } } } while (0)

struct XcdBarrier {
    unsigned* bar; unsigned x;
    volatile LAS unsigned* st;
};

__device__ __forceinline__ XcdBarrier xcd_barrier_post(unsigned* bar, volatile LAS unsigned* st) {
    XcdBarrier b; b.bar = bar; b.x = xb_xcc_id(); b.st = st;
    if (threadIdx.x == 0) (void)xb_add(&bar[XB_XCNT(b.x)], 1u);
    return b;
}
__device__ __forceinline__ void xcd_barrier_complete(unsigned* bar, unsigned x, unsigned& nloc, unsigned& nx) {
    const unsigned G = gridDim.x * gridDim.y * gridDim.z;
    unsigned sum, cnt, mine, sp = 0u;
    for (;;) {
        sum = 0u; cnt = 0u; mine = 0u;
#pragma unroll
        for (unsigned j = 0; j < 16; ++j) { const unsigned c = xb_ld(&bar[XB_XCNT(j)]); sum += c; cnt += (c > 0u) ? 1u : 0u; mine = (j == x) ? c : mine; }
        if (sum == G) break;
        __builtin_amdgcn_s_sleep(1);
        if ((++sp & 255u) == 0u) { if (xb_ld(&bar[XB_TMO])) break; if (sp > XB_SPIN_CAP) { atomicAdd(&bar[XB_TMO], 1u); break; } }
    }
    nloc = mine > 0u ? mine : 1u; nx = cnt > 0u ? cnt : 1u;
}

__device__ __forceinline__ void xcd_barrier(const XcdBarrier& b) {
    asm volatile("s_waitcnt vmcnt(0)" ::: "memory");
    __syncthreads();
    if (threadIdx.x == 0) {
        unsigned* bar = b.bar;
        __builtin_amdgcn_s_waitcnt(0);
        unsigned nloc = b.st[0], nx = b.st[1];
        if (nloc == 0u) { xcd_barrier_complete(bar, b.x, nloc, nx); b.st[0] = nloc; b.st[1] = nx; }
        const unsigned old = xb_add(&bar[XB_XSUB(b.x)], 1u);
        const unsigned gen = old / nloc;
        if (old + 1u == (gen + 1u) * nloc) {
            __builtin_amdgcn_fence(__ATOMIC_RELEASE, "agent");
            asm volatile("s_waitcnt vmcnt(0)" ::: "memory");
            const unsigned og = xb_add(&bar[XB_TOP], 1u);
            const unsigned tg = og / nx;
            if (og + 1u == (tg + 1u) * nx) xb_add(&bar[XB_TOPGEN], 1u);
            else XB_SPIN(xb_ld(&bar[XB_TOPGEN]) == tg, bar);
            __builtin_amdgcn_fence(__ATOMIC_ACQUIRE, "agent");
            xb_add(&bar[XB_XGEN(b.x)], 1u);
            asm volatile("s_waitcnt vmcnt(0)" ::: "memory");
        } else {
            XB_SPIN(xb_ld(&bar[XB_XGEN(b.x)]) == gen, bar);
            __builtin_amdgcn_fence(__ATOMIC_ACQUIRE, "agent");
            asm volatile("s_waitcnt vmcnt(0)" ::: "memory");
        }
    }
    __syncthreads();
}


__device__ __forceinline__ float wave_sum(float v) {
#pragma unroll
    for (int o = 1; o < 64; o <<= 1) v += __shfl_xor(v, o);
    return v;
}

__device__ __forceinline__ void tr_item(const float* W, int ldw, int K, const float* g, bf16* WT, int k0, int n0, int drow0, LAS float* scr, int lane) {
    float v[32];
#pragma unroll
    for (int i = 0; i < 32; ++i) { const int kk = 2 * i + (lane >> 5); v[i] = W[(size_t)(k0 + kk) * ldw + n0 + (lane & 31)]; }
    if (g) {
#pragma unroll
        for (int i = 0; i < 32; ++i) v[i] *= g[k0 + 2 * i + (lane >> 5)];
    }
#pragma unroll
    for (int i = 0; i < 32; ++i) scr[(2 * i + (lane >> 5)) * 33 + (lane & 31)] = v[i];
    LDS_WAIT(); asm volatile("" ::: "memory");
    const int c = lane & 7;
#pragma unroll
    for (int j = 0; j < 4; ++j) { const int n = (lane >> 3) + 8 * j; const LAS float* s = scr + (8 * c) * 33 + n;
        v4u o; o.x = pk2(s[0 * 33], s[1 * 33]); o.y = pk2(s[2 * 33], s[3 * 33]); o.z = pk2(s[4 * 33], s[5 * 33]); o.w = pk2(s[6 * 33], s[7 * 33]);
        *(GAS v4u*)(WT + (size_t)(drow0 + n) * K + k0 + 8 * c) = o; }
    LDS_WAIT(); asm volatile("" ::: "memory");
}
__device__ __forceinline__ void tr_item8(const float* W, int ldw, int K, const float* g, float sc, unsigned char* WT8, int k0, int n0, int drow0, LAS float* scr, int lane) {
    float v[32];
#pragma unroll
    for (int i = 0; i < 32; ++i) { const int kk = 2 * i + (lane >> 5); v[i] = W[(size_t)(k0 + kk) * ldw + n0 + (lane & 31)]; }
#pragma unroll
    for (int i = 0; i < 32; ++i) v[i] *= g ? g[k0 + 2 * i + (lane >> 5)] * sc : sc;
#pragma unroll
    for (int i = 0; i < 32; ++i) scr[(2 * i + (lane >> 5)) * 33 + (lane & 31)] = v[i];
    LDS_WAIT(); asm volatile("" ::: "memory");
    const int c = lane & 3;
#pragma unroll
    for (int j = 0; j < 2; ++j) { const int n = (lane >> 2) + 16 * j; const LAS float* s = scr + (16 * c) * 33 + n;
        v4u o; o.x = pg8::pk4_fp8(s[0 * 33], s[1 * 33], s[2 * 33], s[3 * 33]); o.y = pg8::pk4_fp8(s[4 * 33], s[5 * 33], s[6 * 33], s[7 * 33]);
        o.z = pg8::pk4_fp8(s[8 * 33], s[9 * 33], s[10 * 33], s[11 * 33]); o.w = pg8::pk4_fp8(s[12 * 33], s[13 * 33], s[14 * 33], s[15 * 33]);
        *(GAS v4u*)(WT8 + (size_t)(drow0 + n) * K + k0 + 16 * c) = o; }
    LDS_WAIT(); asm volatile("" ::: "memory");
}
__device__ __forceinline__ int t5_bucket(int n) {
    if (n < 16) return n;
    int b = 16;
    b += (n >= 22); b += (n >= 30); b += (n >= 40); b += (n >= 54); b += (n >= 73); b += (n >= 99); b += (n >= 134); b += (n >= 182);
    b += (n >= 246); b += (n >= 332); b += (n >= 450); b += (n >= 609); b += (n >= 825); b += (n >= 1117); b += (n >= 1513);
    return b;
}

struct Ptrs {
    const float *x, *norm1_g, *w_in, *f_bias, *sinks, *mix_g, *w_out, *norm2_g, *w_gate, *w_up, *w_down, *rel_bias, *final_g;
    float* out; unsigned char* ws;
};

__device__ __forceinline__ void phase_prep(const Ptrs& P, LAS unsigned char* lds, int gw, int NGW, int wave, int lane) {
    LAS float* scr = (LAS float*)(lds + RING_OFF + wave * 16384);
    constexpr int I_IN = 16 * 88, I_OUT = 16 * 32, I_G = 16 * 88, I_DN = 44 * 32, I_LAYER = I_IN + I_OUT + 2 * I_G + I_DN;
    for (int it = gw; it < DEPTH * I_LAYER; it += NGW) {
        const int l = it / I_LAYER; int r = it % I_LAYER;
        if (r < I_IN) { const int kb = r / 88, nb = r % 88; tr_item(P.w_in + (size_t)l * DM * NIN, NIN, DM, P.norm1_g + l * DM, (bf16*)(P.ws + WS_WIN) + (size_t)l * QP * DM, 64 * kb, 32 * nb, 32 * nb, scr, lane); continue; } r -= I_IN;
        if (r < I_OUT) { const int kb = r / 32, nb = r % 32; tr_item(P.w_out + (size_t)l * DM * DM, DM, DM, P.mix_g + l * DM, (bf16*)(P.ws + WS_WOUT) + (size_t)l * DM * DM, 64 * kb, 32 * nb, 32 * nb, scr, lane); continue; } r -= I_OUT;
        if (r < I_G) { const int kb = r / 88, nb = r % 88, n0 = 32 * nb; tr_item8(P.w_gate + (size_t)l * DM * DFF, DFF, DM, P.norm2_g + l * DM, WSCALE, P.ws + WS_WGU + (size_t)l * NGU * DM, 64 * kb, n0, 256 * (n0 / 128) + (n0 % 128), scr, lane); continue; } r -= I_G;
        if (r < I_G) { const int kb = r / 88, nb = r % 88, n0 = 32 * nb; tr_item8(P.w_up + (size_t)l * DM * DFF, DFF, DM, P.norm2_g + l * DM, WSCALE, P.ws + WS_WGU + (size_t)l * NGU * DM, 64 * kb, n0, 256 * (n0 / 128) + 128 + (n0 % 128), scr, lane); continue; } r -= I_G;
        { const int kb = r / 32, nb = r % 32; tr_item8(P.w_down + (size_t)l * DFF * DM, DM, DFF, nullptr, WSCALE, P.ws + WS_WDN + (size_t)l * DM * DFF, 64 * kb, 32 * nb, 32 * nb, scr, lane); }
    }
    const int gt = gw * 64 + lane, NGT = NGW * 64;
    float* biasT = (float*)(P.ws + WS_BIAST);
    for (int i = gt; i < 12 * 4096; i += NGT) { const int col = i >> 12, dist = i & 4095; biasT[i] = P.rel_bias[t5_bucket(dist) * 12 + col] * LOG2E; }
    float* wfd = (float*)(P.ws + WS_WFD);
    for (int i = gt; i < DEPTH * DM * 4; i += NGT) { const int l = i / (DM * 4), k = (i / 4) % DM, h = i & 3; wfd[i] = P.norm1_g[l * DM + k] * P.w_in[((size_t)l * DM + k) * NIN + 2816 + h]; }
}

template <bool WITH_FD>
__device__ __forceinline__ void row_pass(const float* xin, bf16* xb, float* rstd, const LAS float* wfd, const float* fbias, float* lf, int gw, int NGW, int lane) {
    f32x4 nx[4];
    if (gw < M) { const GAS f32x4* xr = (const GAS f32x4*)(xin + (size_t)gw * DM) + lane;
#pragma unroll
        for (int j = 0; j < 4; ++j) nx[j] = xr[64 * j]; }
    for (int m = gw; m < M; m += NGW) {
        f32x4 v[4]; float s = 0.f;
#pragma unroll
        for (int j = 0; j < 4; ++j) v[j] = nx[j];
        if (m + NGW < M) { const GAS f32x4* xr = (const GAS f32x4*)(xin + (size_t)(m + NGW) * DM) + lane;
#pragma unroll
            for (int j = 0; j < 4; ++j) nx[j] = xr[64 * j]; }
#pragma unroll
        for (int j = 0; j < 4; ++j) s += (v[j].x * v[j].x + v[j].y * v[j].y) + (v[j].z * v[j].z + v[j].w * v[j].w);
        const float wave_sum_keep = wave_sum(s);
        const float rs = 1.0f / sqrtf(wave_sum_keep * (1.0f / DM) + EPS);
        GAS unsigned long long* o8 = (GAS unsigned long long*)(xb + (size_t)m * DM) + lane;
#pragma unroll
        for (int j = 0; j < 4; ++j) o8[64 * j] = (unsigned long long)pk2(v[j].x, v[j].y) | ((unsigned long long)pk2(v[j].z, v[j].w) << 32);
        if (WITH_FD) {
            float f0 = 0.f, f1 = 0.f, f2 = 0.f, f3 = 0.f;
#pragma unroll
            for (int j = 0; j < 4; ++j)
#pragma unroll
                for (int i = 0; i < 4; ++i) { const f32x4 w = *(const LAS f32x4*)(wfd + (4 * lane + 256 * j + i) * 4); const float xv = v[j][i]; f0 += xv * w.x; f1 += xv * w.y; f2 += xv * w.z; f3 += xv * w.w; }
            f0 = wave_sum(f0); f1 = wave_sum(f1); f2 = wave_sum(f2); f3 = wave_sum(f3);
            if (lane < 4) { const float f = lane == 0 ? f0 : lane == 1 ? f1 : lane == 2 ? f2 : f3; const float z = f * rs + fbias[lane];
                lf[(size_t)lane * M + m] = fminf(z, 0.f) - log1pf(expf(-fabsf(z))); }
        }
        if (lane < 16) rstd[(size_t)m * 16 + lane] = (lane == 0) ? wave_sum_keep : 0.f;
    }
}
__device__ __forceinline__ void final_pass(const bf16* xb, float* out, const float* g, const float* ss, int gw, int NGW, int lane) {
    v4u na = {0u, 0u, 0u, 0u}, nb = {0u, 0u, 0u, 0u}; float ns = 0.f;
    if (gw < M) { const GAS v4u* p = (const GAS v4u*)(xb + (size_t)gw * DM) + 2 * lane; na = p[0]; nb = p[1]; ns = lane < 16 ? ss[(size_t)gw * 16 + lane] : 0.f; }
    for (int m = gw; m < M; m += NGW) {
        const v4u a = na, b = nb; const float sv = ns; float f[16];
        if (m + NGW < M) { const GAS v4u* p = (const GAS v4u*)(xb + (size_t)(m + NGW) * DM) + 2 * lane; na = p[0]; nb = p[1]; ns = lane < 16 ? ss[(size_t)(m + NGW) * 16 + lane] : 0.f; }
        f[0] = bflo(a.x); f[1] = bfhi(a.x); f[2] = bflo(a.y); f[3] = bfhi(a.y); f[4] = bflo(a.z); f[5] = bfhi(a.z); f[6] = bflo(a.w); f[7] = bfhi(a.w);
        f[8] = bflo(b.x); f[9] = bfhi(b.x); f[10] = bflo(b.y); f[11] = bfhi(b.y); f[12] = bflo(b.z); f[13] = bfhi(b.z); f[14] = bflo(b.w); f[15] = bfhi(b.w);
        const float s = wave_sum(sv);
        const float rs = 1.0f / sqrtf(s * (1.0f / DM) + EPS);
        GAS f32x4* o = (GAS f32x4*)(out + (size_t)m * DM) + 4 * lane; const f32x4* gv = (const f32x4*)g + 4 * lane;
#pragma unroll
        for (int j = 0; j < 4; ++j) { const f32x4 gg = gv[j]; o[j] = (f32x4){f[4 * j] * rs * gg[0], f[4 * j + 1] * rs * gg[1], f[4 * j + 2] * rs * gg[2], f[4 * j + 3] * rs * gg[3]}; }
    }
}
__device__ __forceinline__ void unpack16(const v4u a, const v4u b, float (&f)[16]) {
    f[0] = bflo(a.x); f[1] = bfhi(a.x); f[2] = bflo(a.y); f[3] = bfhi(a.y); f[4] = bflo(a.z); f[5] = bfhi(a.z); f[6] = bflo(a.w); f[7] = bfhi(a.w);
    f[8] = bflo(b.x); f[9] = bfhi(b.x); f[10] = bflo(b.y); f[11] = bfhi(b.y); f[12] = bflo(b.z); f[13] = bfhi(b.z); f[14] = bflo(b.w); f[15] = bfhi(b.w);
}
__device__ __forceinline__ void mixnorm_pass(bf16* mix, const bf16* pa, const float* lse, int gw, int NGW, int lane) {
    for (int m = gw; m < M; m += NGW) {
        GAS v4u* p = (GAS v4u*)(mix + (size_t)m * DM) + 2 * lane;
        float f[16];
        if ((ATT_MFMA_MASK & 1) && lane < 16) {
            const int hd = lane >> 2;
            const float l0 = lse[(size_t)m * 4 + hd], l1 = lse[((size_t)M + m) * 4 + hd], l2 = lse[((size_t)2 * M + m) * 4 + hd];
            const float mx = fmaxf(l0, fmaxf(l1, l2)); float w0 = EX2(l0 - mx), w1 = EX2(l1 - mx), w2 = EX2(l2 - mx); const float inv = 1.0f / (w0 + w1 + w2); w0 *= inv; w1 *= inv; w2 *= inv;
            float t[16];
            { const GAS v4u* q = (const GAS v4u*)(pa + (size_t)m * 256) + 2 * lane; unpack16(q[0], q[1], t);
#pragma unroll
              for (int i = 0; i < 16; ++i) f[i] = w0 * t[i]; }
            { const GAS v4u* q = (const GAS v4u*)(pa + ((size_t)M + m) * 256) + 2 * lane; unpack16(q[0], q[1], t);
#pragma unroll
              for (int i = 0; i < 16; ++i) f[i] += w1 * t[i]; }
            { const GAS v4u* q = (const GAS v4u*)(pa + ((size_t)2 * M + m) * 256) + 2 * lane; unpack16(q[0], q[1], t);
#pragma unroll
              for (int i = 0; i < 16; ++i) f[i] += w2 * t[i]; }
        } else { const v4u a = p[0], b = p[1]; unpack16(a, b, f); }
        {
        }
        float s = 0.f;
#pragma unroll
        for (int i = 0; i < 16; ++i) s += f[i] * f[i];
        s += __shfl_xor(s, 1); s += __shfl_xor(s, 2); s += __shfl_xor(s, 4); s += __shfl_xor(s, 8);
        const float rs = 1.0f / sqrtf(s * (1.0f / 256.0f) + EPS);
        v4u oa, ob;
        oa.x = pk2(f[0] * rs, f[1] * rs); oa.y = pk2(f[2] * rs, f[3] * rs); oa.z = pk2(f[4] * rs, f[5] * rs); oa.w = pk2(f[6] * rs, f[7] * rs);
        ob.x = pk2(f[8] * rs, f[9] * rs); ob.y = pk2(f[10] * rs, f[11] * rs); ob.z = pk2(f[12] * rs, f[13] * rs); ob.w = pk2(f[14] * rs, f[15] * rs);
        p[0] = oa; p[1] = ob;
    }
}
__device__ __forceinline__ void scan_job(int b, int h, const float* lf_in, const float* ss, const float* fdp, float fbias_h, float* c2, LAS float* scr, int tid, int lane, int wave) {
    const size_t row0 = (size_t)b * S + 8 * tid;
    float v[8];
    if (lf_in) { const f32x4 a = *(const f32x4*)(lf_in + (size_t)h * M + row0), c = *(const f32x4*)(lf_in + (size_t)h * M + row0 + 4); v[0] = a[0]; v[1] = a[1]; v[2] = a[2]; v[3] = a[3]; v[4] = c[0]; v[5] = c[1]; v[6] = c[2]; v[7] = c[3]; }
    else {
#pragma unroll
        for (int i = 0; i < 8; ++i) { const f32x4* sp = (const f32x4*)(ss + (row0 + i) * 16); const f32x4* fp = (const f32x4*)(fdp + (row0 + i) * 64 + h * 16);
            const f32x4 s0 = sp[0], s1 = sp[1], s2 = sp[2], s3 = sp[3], f0 = fp[0], f1 = fp[1], f2 = fp[2], f3 = fp[3];
            const float s = ((s0[0] + s0[1]) + (s0[2] + s0[3])) + ((s1[0] + s1[1]) + (s1[2] + s1[3])) + ((s2[0] + s2[1]) + (s2[2] + s2[3])) + ((s3[0] + s3[1]) + (s3[2] + s3[3]));
            const float fd = ((f0[0] + f0[1]) + (f0[2] + f0[3])) + ((f1[0] + f1[1]) + (f1[2] + f1[3])) + ((f2[0] + f2[1]) + (f2[2] + f2[3])) + ((f3[0] + f3[1]) + (f3[2] + f3[3]));
            const float z = fd * (1.0f / sqrtf(s * (1.0f / DM) + EPS)) + fbias_h;
            v[i] = fminf(z, 0.f) - log1pf(expf(-fabsf(z))); }
    }
#pragma unroll
    for (int i = 1; i < 8; ++i) v[i] += v[i - 1];
    const float tot = v[7]; float inc = tot;
#pragma unroll
    for (int o = 1; o < 64; o <<= 1) { const float y = __shfl_up(inc, o); if (lane >= o) inc += y; }
    if (lane == 63) scr[wave] = inc;
    __syncthreads();
    float pre = inc - tot;
#pragma unroll
    for (int w = 0; w < NWAVES; ++w) pre += (w < wave) ? scr[w] : 0.f;
    f32x4* dst = (f32x4*)(c2 + (size_t)(b * 4 + h) * S + 8 * tid);
    dst[0] = (f32x4){v[0] + pre, v[1] + pre, v[2] + pre, v[3] + pre} * LOG2E; dst[1] = (f32x4){v[4] + pre, v[5] + pre, v[6] + pre, v[7] + pre} * LOG2E;
    __syncthreads();
}

__device__ __forceinline__ float dot_row(const bf16* krow, const float (&q)[64]) {
    const GAS v4u* p = (const GAS v4u*)krow; float s = 0.f;
#pragma unroll
    for (int i = 0; i < 8; ++i) { const v4u w = p[i];
        s = fmaf(q[8 * i + 0], bflo(w.x), s); s = fmaf(q[8 * i + 1], bfhi(w.x), s); s = fmaf(q[8 * i + 2], bflo(w.y), s); s = fmaf(q[8 * i + 3], bfhi(w.y), s);
        s = fmaf(q[8 * i + 4], bflo(w.z), s); s = fmaf(q[8 * i + 5], bfhi(w.z), s); s = fmaf(q[8 * i + 6], bflo(w.w), s); s = fmaf(q[8 * i + 7], bfhi(w.w), s); }
    return s;
}
__device__ __forceinline__ void axpy_row(const bf16* vrow, float a, float p, float (&o)[64]) {
    const GAS v4u* q = (const GAS v4u*)vrow;
#pragma unroll
    for (int i = 0; i < 8; ++i) { const v4u w = q[i];
        o[8 * i + 0] = fmaf(p, bflo(w.x), o[8 * i + 0] * a); o[8 * i + 1] = fmaf(p, bfhi(w.x), o[8 * i + 1] * a); o[8 * i + 2] = fmaf(p, bflo(w.y), o[8 * i + 2] * a); o[8 * i + 3] = fmaf(p, bfhi(w.y), o[8 * i + 3] * a);
        o[8 * i + 4] = fmaf(p, bflo(w.z), o[8 * i + 4] * a); o[8 * i + 5] = fmaf(p, bfhi(w.z), o[8 * i + 5] * a); o[8 * i + 6] = fmaf(p, bflo(w.w), o[8 * i + 6] * a); o[8 * i + 7] = fmaf(p, bfhi(w.w), o[8 * i + 7] * a); }
}
#define NV_STEP(KEY, BIAS2, VALID) do { if (VALID) { \
        const bf16* kr_ = qkv + (rowb + (size_t)(KEY)) * QP; \
        const float s_ = dot_row(kr_ + kcol, q) + (BIAS2); \
        const float mn_ = fmaxf(m, s_), a_ = EX2(m - mn_), p_ = EX2(s_ - mn_); l = l * a_ + p_; m = mn_; \
        axpy_row(kr_ + vcol, a_, p_, o); } } while (0)
__device__ __forceinline__ void attn_naive_item(int type, int b, int h, int chunk, const bf16* qkv, bf16* mix, const float* biasT, const float* c2, const float* kmean, const float* sinks_l, int lane) {
    const int t0 = chunk * 64, t = t0 + lane; const size_t rowb = (size_t)b * S;
    int qcol, kcol, vcol;
    if (type == 0) { qcol = C_QA + 64 * h; kcol = C_KA + 64 * h; vcol = C_VA + 64 * h; }
    else if (type == 1) { qcol = C_QB + 64 * h; kcol = C_KB + 64 * h; vcol = C_VB + 64 * h; }
    else if (type == 2) { qcol = C_QC + 64 * h; kcol = C_KC + 64 * (h >> 1); vcol = C_VC + 64 * (h >> 1); }
    else { qcol = C_QD + 64 * h; kcol = C_KD + 64 * h; vcol = C_VD + 64 * h; }
    float q[64], o[64];
    { const GAS v4u* p = (const GAS v4u*)(qkv + (rowb + t) * QP + qcol);
#pragma unroll
      for (int i = 0; i < 8; ++i) { const v4u w = p[i]; q[8 * i] = bflo(w.x); q[8 * i + 1] = bfhi(w.x); q[8 * i + 2] = bflo(w.y); q[8 * i + 3] = bfhi(w.y); q[8 * i + 4] = bflo(w.z); q[8 * i + 5] = bfhi(w.z); q[8 * i + 6] = bflo(w.w); q[8 * i + 7] = bfhi(w.w); } }
#pragma unroll
    for (int d = 0; d < 64; ++d) o[d] = 0.f;
    float m = -1e30f, l = 0.f;
    if (type == 0) {
        const float* bt = biasT + h * 4096;
        for (int g = 0; g < 3; ++g) { const int dil = g == 0 ? 1 : g == 1 ? 4 : 16;
            for (int jj = 0; jj <= 128; ++jj) { const int key = t - dil * jj; const bool valid = key >= 0; const float b2 = bt[jj * dil]; NV_STEP(valid ? key : 0, b2, valid); } }
    } else if (type == 1) {
        const float* bt = biasT + (4 + h) * 4096; const int own = t0 >> 8;
        float g[16];
#pragma unroll
        for (int n = 0; n < 16; ++n) { g[n] = -INFINITY; if (n < own) { const float* km = kmean + ((size_t)(b * 4 + h) * 16 + n) * 64; float s = 0.f;
#pragma unroll
                for (int d = 0; d < 64; ++d) s = fmaf(q[d], km[d], s);
                g[n] = s; } }
        unsigned sel = 0u;
#pragma unroll
        for (int r = 0; r < 3; ++r) { float best = -INFINITY; int bi = -1;
#pragma unroll
            for (int n = 0; n < 16; ++n) if (n < own && !((sel >> n) & 1u) && g[n] > best) { best = g[n]; bi = n; }
            if (bi >= 0) sel |= 1u << bi; }
        for (int n = 0; n < own; ++n) { const bool pick = (sel >> n) & 1u;
            if (__ballot(pick) != 0ull) for (int i = 0; i < 256; ++i) { const int key = n * 256 + i; NV_STEP(key, bt[t - key], pick); } }
        for (int key = own * 256; key <= t0 + 63; ++key) { const bool valid = key <= t; NV_STEP(key, bt[valid ? t - key : 0], valid); }
    } else if (type == 2) {
        const float* bt = biasT + (8 + h) * 4096; const int jlo = t0 - 127 > 0 ? t0 - 127 : 0;
        for (int key = jlo; key <= t0 + 63; ++key) { const int dist = t - key; const bool valid = dist >= 0 && dist <= 127; NV_STEP(key, bt[valid ? dist : 0], valid); }
        l += EX2(sinks_l[h] * LOG2E - m);
    } else {
        const float* cc = c2 + (size_t)(b * 4 + h) * S; const float ct = cc[t];
        for (int key = 0; key <= t0 + 63; ++key) { const bool valid = key <= t; NV_STEP(key, ct - cc[key], valid); }
    }
    const float inv = 1.0f / l;
    GAS v4u* op = (GAS v4u*)(mix + (rowb + t) * DM + type * 256 + h * 64);
#pragma unroll
    for (int i = 0; i < 8; ++i) { v4u w; w.x = pk2(o[8 * i] * inv, o[8 * i + 1] * inv); w.y = pk2(o[8 * i + 2] * inv, o[8 * i + 3] * inv); w.z = pk2(o[8 * i + 4] * inv, o[8 * i + 5] * inv); w.w = pk2(o[8 * i + 6] * inv, o[8 * i + 7] * inv); op[i] = w; }
}
__device__ __forceinline__ void attn_naive_phase(const bf16* qkv, bf16* mix, const float* biasT, const float* c2, const float* kmean, const float* sinks_l, int gw, int NGW, int lane) {
    for (int idx = gw; idx < 4 * NB * 4 * 64; idx += NGW) {
        const int chunk = 63 - (idx >> 7), rem = idx & 127, type = rem >> 5, bh = rem & 31;
        if ((ATT_MFMA_MASK >> type) & 1) continue;
        attn_naive_item(type, bh >> 2, bh & 3, chunk, qkv, mix, biasT, c2, kmean, sinks_l, lane);
    }
}

__device__ __forceinline__ void attn_mfma_phase(LAS unsigned char* lds, unsigned char* ws, const float* sinks_l, int l, int c, int G) {
    int cur_tab = -1, cur_tab2 = -1, cur_tab3 = -1;
#define ATT_OPAQUE() int b = b0_, h = h0_, hs = hs0_; asm volatile("" : "+s"(b), "+s"(h), "+s"(hs)); \
        const bf16* qkv = (const bf16*)(ws + WS_QKV); bf16* mix = (bf16*)(ws + WS_MIX); const float* biasT = (const float*)(ws + WS_BIAST)
    for (int v = c; v < 256; v += G) {
        const int b0_ = (v & 31) >> 2, h0_ = v & 3, hs0_ = v >> 5;
        for (int j = 0; j < 2; ++j) {
            if ((ATT_MFMA_MASK >> 1) & 1) for (int d_ = 0; d_ < ADUP(1); ++d_) { ATT_OPAQUE(); const int qb = j ? hs : 15 - hs;
                if ((ATT2_MASK >> 1) & 1) att2::attn_unit2<att2::T_B>(lds, qkv, b, h, qb, biasT + (4 + h) * 4096, 4 + h, cur_tab2, nullptr, nullptr, (const float*)(ws + WS_CTL) + CW_KMEAN + (size_t)l * 32768 + (size_t)(b * 4 + h) * 16 * 64, mix + 256 + 64 * h, DM);
                else att::attn_item<att::T_B>(lds, qkv, b, h, qb, 0, 1, 0, 0, 0, 0, biasT + (4 + h) * 4096, 4 + h, cur_tab, nullptr, nullptr, (const float*)(ws + WS_CTL) + CW_KMEAN + (size_t)l * 32768 + (size_t)(b * 4 + h) * 16 * 64, 0.f, mix + 256 + 64 * h, DM, nullptr); }
            if ((ATT_MFMA_MASK >> 3) & 1) for (int d_ = 0; d_ < ADUP(3); ++d_) { ATT_OPAQUE(); const int qb = j ? hs : 15 - hs; if (j) h = (h + 2) & 3;
                if ((ATT2_MASK >> 3) & 1) att2::attn_unit2<att2::T_D>(lds, qkv, b, h, qb, nullptr, -1, cur_tab2, (const float*)(ws + WS_C2) + (size_t)(b * 4 + h) * S, (const unsigned*)(ws + WS_CTL) + CW_NORM + 128 * l + (b * 4 + h) * 4, nullptr, mix + 768 + 64 * h, DM);
                else att::attn_item<att::T_D>(lds, qkv, b, h, qb, 0, 1, 0, 0, 0, 0, nullptr, -1, cur_tab, (const float*)(ws + WS_C2) + (size_t)(b * 4 + h) * S, (const unsigned*)(ws + WS_CTL) + CW_NORM + 128 * l + (b * 4 + h) * 4, nullptr, 0.f, mix + 768 + 64 * h, DM, nullptr); }
        }
        if ((ATT_MFMA_MASK & 5) == 5) for (int d_ = 0; d_ < ADUP(0); ++d_) {
#define A3_GEOM(J) const int cls_ = (J) >> 1, rest_ = 2 * hs + ((J) & 1); const int dil_ = cls_ <= 1 ? 1 : cls_ == 2 ? 4 : 16, qb_ = cls_ <= 1 ? rest_ : cls_ == 2 ? rest_ >> 2 : 0, res_ = cls_ <= 1 ? 0 : cls_ == 2 ? rest_ & 3 : rest_; const bool swa_ = cls_ == 0
#define A3_SRC(J, OUT) do { A3_GEOM(J); const bf16* rb_ = qkv + ((size_t)b * S + res_) * QP; OUT.k = rb_ + (swa_ ? C_KC + 64 * (h >> 1) : C_KA + 64 * h); OUT.v = rb_ + (swa_ ? C_VC + 64 * (h >> 1) : C_VA + 64 * h); OUT.rs = dil_ * QP; OUT.kw = 256 * qb_ - 128; OUT.tmin = qb_ == 0 ? 2 : 0; } while (0)
            att3::BandSrc cur_, nx_; nx_.k = nullptr; nx_.v = nullptr; nx_.rs = 0; nx_.kw = 0; nx_.tmin = 0;
            { ATT_OPAQUE(); A3_SRC(0, cur_); const int wid_ = __builtin_amdgcn_readfirstlane(threadIdx.x >> 6), lane_ = threadIdx.x & 63; const unsigned l0_ = (unsigned)(uintptr_t)lds;
              att3::band_dma(l0_ + att3::L_K, cur_.k, cur_.rs, cur_.kw, cur_.tmin, false, wid_, lane_); att3::band_dma(l0_ + att3::L_V, cur_.v, cur_.rs, cur_.kw, cur_.tmin, true, wid_, lane_); }
            for (int j8 = 0; j8 < 8; ++j8) { ATT_OPAQUE();
                A3_GEOM(j8); const size_t g = (size_t)(cls_ - 1);
                if (j8 < 7) A3_SRC(j8 + 1, nx_);
#define A3_CALL(D) att3::attn_band<D>(lds, qkv, b, h, qb_, res_, swa_ ? 127 : 128, (swa_ ? C_QC : C_QA) + 64 * h, swa_ ? C_KC + 64 * (h >> 1) : C_KA + 64 * h, swa_ ? C_VC + 64 * (h >> 1) : C_VA + 64 * h, \
                    biasT + ((swa_ ? 8 : 0) + h) * 4096, cls_ * 4 + h, cur_tab3, swa_ ? sinks_l[h] * LOG2E : -INFINITY, \
                    swa_ ? mix + 512 + 64 * h : (bf16*)(ws + WS_PA) + g * M * 256 + 64 * h, swa_ ? DM : 256, swa_ ? nullptr : (float*)(ws + WS_LSE) + g * M * 4 + h, nx_, j8 < 7)
                if (dil_ == 1) A3_CALL(1); else if (dil_ == 4) A3_CALL(4); else A3_CALL(16);
#undef A3_CALL
                cur_ = nx_;
            }
#undef A3_GEOM
#undef A3_SRC
        }
    }
#undef ATT_OPAQUE
}

struct Args { const float* in[13]; float* out; unsigned char* ws; int ph_lo, ph_hi, li, pad; };
__global__ void __launch_bounds__(NWAVES * 64, 2) hybrid_fwd(Args args) {
    extern __shared__ __attribute__((aligned(16))) unsigned char lds_raw[];
    LAS unsigned char* lds = (LAS unsigned char*)lds_raw;
    volatile LAS unsigned* MISC = (volatile LAS unsigned*)(lds + MISC_OFF);
    const int tid = threadIdx.x, lane = tid & 63, wave = __builtin_amdgcn_readfirstlane(tid >> 6);
    const int G = gridDim.x; const int bx = blockIdx.x; const int vcu = (G % 8 == 0) ? (bx % 8) * (G / 8) + bx / 8 : bx;
    const int gw = vcu * NWAVES + wave, NGW = G * NWAVES;
    Ptrs P;
    P.x = args.in[0]; P.norm1_g = args.in[1]; P.w_in = args.in[2]; P.f_bias = args.in[3]; P.sinks = args.in[4]; P.mix_g = args.in[5]; P.w_out = args.in[6];
    P.norm2_g = args.in[7]; P.w_gate = args.in[8]; P.w_up = args.in[9]; P.w_down = args.in[10]; P.rel_bias = args.in[11]; P.final_g = args.in[12];
    P.out = args.out; P.ws = args.ws;
    unsigned char* ws = args.ws;
    gu32* ctl = (gu32*)(ws + WS_CTL);
    bf16* XB = (bf16*)(ws + WS_XB); bf16* MIX = (bf16*)(ws + WS_MIX); bf16* QKV = (bf16*)(ws + WS_QKV); bf16* ACT = (bf16*)(ws + WS_QKV);
    float* SSB = (float*)(ws + WS_SS); float* FDB = (float*)(ws + WS_FD); float* LF = (float*)(ws + WS_LF); float* CC2 = (float*)(ws + WS_C2); float* KMEAN = (float*)(ws + WS_KMEAN);
    const float* BIAST = (const float*)(ws + WS_BIAST);
    for (int u = tid; u < (LDS_BYTES - LDSCTL_OFF) / 4; u += NWAVES * 64) ((LAS unsigned*)(lds + LDSCTL_OFF))[u] = 0u;
    __syncthreads();
    XcdBarrier bar; bar.bar = (unsigned*)(ctl + CW_BAR) + args.li * XCD_BAR_WORDS; bar.x = 0; bar.st = nullptr;
    if (N_LAUNCHES == 1) bar = xcd_barrier_post((unsigned*)(ctl + CW_BAR) + args.li * XCD_BAR_WORDS, MISC + 8);
    const int lo = args.ph_lo, hi = args.ph_hi;
#define IN(k) (lo <= (k) && (k) < hi)
#define SEAM(k) do { if (IN(k) && IN((k) + 1)) { if (N_LAUNCHES == 1) xcd_barrier(bar); } } while (0)

    if (IN(0)) {
        phase_prep(P, lds, gw, NGW, wave, lane);
        __syncthreads();
        { LAS float* wl = (LAS float*)(lds + RING_OFF); for (int i = tid; i < DM * 4; i += NWAVES * 64) { const int k = i >> 2, h = i & 3; wl[i] = P.norm1_g[k] * P.w_in[(size_t)k * NIN + 2816 + h]; } }
        __syncthreads();
        row_pass<true>(P.x, XB, SSB, (const LAS float*)(lds + RING_OFF), P.f_bias, LF, gw, NGW, lane);
        SEAM(0);
    }

    { constexpr int l = 0;
    {
        const int pb = 1 + PH_PER_LAYER * l;
        if (IN(pb + 0)) {
            pg8::Gemm g{XB, (const bf16*)(ws + WS_WIN) + (size_t)l * QP * DM, M, QP, DM}; pg8::StaticOrder So; So.init(M, QP, G, bx);
            pg8::EpiQKV E{QKV, QP, SSB, C2, (LAS float*)(lds + LDSCTL_OFF + 1024), (float*)(ctl + CW_KMEAN) + (size_t)l * 32768, (unsigned*)(ctl + CW_NORM + 128 * l)};
            pg8::rstd_table((LAS float*)(lds + LDSCTL_OFF + 1024), SSB, So);
            pg8::gemm_phase<pg8::EpiQKV, pg8::StaticOrder, PG8_ALIGN, PG8_SP2>(lds + RING_OFF, g, So, E);
            for (int j = bx; j < 32 + 128; j += G) if (j >= 128) { const int bh = j - 128;
                scan_job(bh >> 2, bh & 3, l == 0 ? LF : nullptr, SSB, FDB, P.f_bias[l * 4 + (bh & 3)], CC2, (LAS float*)(lds + LDSCTL_OFF + 1024), tid, lane, wave); }
            SEAM(pb + 0);
        }
        if (IN(pb + 1)) {
            if (ATT_MFMA_MASK != 15) attn_naive_phase(QKV, MIX, BIAST, CC2, KMEAN, P.sinks + l * 4, gw, NGW, lane);
            if (ATT_MFMA_MASK != 0) { __syncthreads(); attn_mfma_phase(lds + RING_OFF, ws, P.sinks + l * 4, l, bx, G); }
            SEAM(pb + 1); }
        if (IN(pb + 2)) { mixnorm_pass(MIX, (const bf16*)(ws + WS_PA), (const float*)(ws + WS_LSE), gw, NGW, lane); SEAM(pb + 2); }
        if (IN(pb + 3)) {
            pg8::Gemm g{MIX, (const bf16*)(ws + WS_WOUT) + (size_t)l * DM * DM, M, DM, DM}; pg8::StaticOrder So; So.init(M, DM, G, bx);
            pg8::EpiResidX E{XB, SSB, nullptr, nullptr, DM, 1.0f, ws + WS_X8};
            pg8::gemm_phase<pg8::EpiResidX, pg8::StaticOrder, PG8_ALIGN, PG8_SP2>(lds + RING_OFF, g, So, E);
            SEAM(pb + 3);
        }
        if (IN(pb + 4)) {
            pg8::Gemm g{(const bf16*)(ws + WS_X8), (const bf16*)(ws + WS_WGU + (size_t)l * NGU * DM), M, NGU, DM}; pg8::StaticOrder So; So.init(M, NGU, G, bx);
            pg8::EpiSwiGLU E{(unsigned char*)ACT, DFF, SSB, (LAS float*)(lds + LDSCTL_OFF + 1024), 1.0f / WSCALE, ASCALE};
            pg8::rstd_table((LAS float*)(lds + LDSCTL_OFF + 1024), SSB, So);
            pg8::gemm_phase<pg8::EpiSwiGLU, pg8::StaticOrder, PG8_ALIGN, PG8_SP2, true>(lds + RING_OFF, g, So, E);
            SEAM(pb + 4);
        }
        if (IN(pb + 5)) {
            pg8::Gemm g{ACT, (const bf16*)(ws + WS_WDN + (size_t)l * DM * DFF), M, DM, DFF}; pg8::StaticOrder So; So.init(M, DM, G, bx);
            pg8::EpiResidX E{XB, SSB, (l + 1 < DEPTH) ? (const float*)(ws + WS_WFD) + (size_t)(l + 1) * DM * 4 : nullptr, FDB, DM, 1.0f / (WSCALE * ASCALE), nullptr};
            pg8::gemm_phase<pg8::EpiResidX, pg8::StaticOrder, PG8_ALIGN, PG8_SP2, true>(lds + RING_OFF, g, So, E);
            SEAM(pb + 5);
        }
    }
    }
    { constexpr int l = 1;
    {
        const int pb = 1 + PH_PER_LAYER * l;
        if (IN(pb + 0)) {
            pg8::Gemm g{XB, (const bf16*)(ws + WS_WIN) + (size_t)l * QP * DM, M, QP, DM}; pg8::StaticOrder So; So.init(M, QP, G, bx);
            pg8::EpiQKV E{QKV, QP, SSB, C2, (LAS float*)(lds + LDSCTL_OFF + 1024), (float*)(ctl + CW_KMEAN) + (size_t)l * 32768, (unsigned*)(ctl + CW_NORM + 128 * l)};
            pg8::rstd_table((LAS float*)(lds + LDSCTL_OFF + 1024), SSB, So);
            pg8::gemm_phase<pg8::EpiQKV, pg8::StaticOrder, PG8_ALIGN, PG8_SP2>(lds + RING_OFF, g, So, E);
            for (int j = bx; j < 32 + 128; j += G) if (j >= 128) { const int bh = j - 128;
                scan_job(bh >> 2, bh & 3, l == 0 ? LF : nullptr, SSB, FDB, P.f_bias[l * 4 + (bh & 3)], CC2, (LAS float*)(lds + LDSCTL_OFF + 1024), tid, lane, wave); }
            SEAM(pb + 0);
        }
        if (IN(pb + 1)) {
            if (ATT_MFMA_MASK != 15) attn_naive_phase(QKV, MIX, BIAST, CC2, KMEAN, P.sinks + l * 4, gw, NGW, lane);
            if (ATT_MFMA_MASK != 0) { __syncthreads(); attn_mfma_phase(lds + RING_OFF, ws, P.sinks + l * 4, l, bx, G); }
            SEAM(pb + 1); }
        if (IN(pb + 2)) { mixnorm_pass(MIX, (const bf16*)(ws + WS_PA), (const float*)(ws + WS_LSE), gw, NGW, lane); SEAM(pb + 2); }
        if (IN(pb + 3)) {
            pg8::Gemm g{MIX, (const bf16*)(ws + WS_WOUT) + (size_t)l * DM * DM, M, DM, DM}; pg8::StaticOrder So; So.init(M, DM, G, bx);
            pg8::EpiResidX E{XB, SSB, nullptr, nullptr, DM, 1.0f, ws + WS_X8};
            pg8::gemm_phase<pg8::EpiResidX, pg8::StaticOrder, PG8_ALIGN, PG8_SP2>(lds + RING_OFF, g, So, E);
            SEAM(pb + 3);
        }
        if (IN(pb + 4)) {
            pg8::Gemm g{(const bf16*)(ws + WS_X8), (const bf16*)(ws + WS_WGU + (size_t)l * NGU * DM), M, NGU, DM}; pg8::StaticOrder So; So.init(M, NGU, G, bx);
            pg8::EpiSwiGLU E{(unsigned char*)ACT, DFF, SSB, (LAS float*)(lds + LDSCTL_OFF + 1024), 1.0f / WSCALE, ASCALE};
            pg8::rstd_table((LAS float*)(lds + LDSCTL_OFF + 1024), SSB, So);
            pg8::gemm_phase<pg8::EpiSwiGLU, pg8::StaticOrder, PG8_ALIGN, PG8_SP2, true>(lds + RING_OFF, g, So, E);
            SEAM(pb + 4);
        }
        if (IN(pb + 5)) {
            pg8::Gemm g{ACT, (const bf16*)(ws + WS_WDN + (size_t)l * DM * DFF), M, DM, DFF}; pg8::StaticOrder So; So.init(M, DM, G, bx);
            pg8::EpiResidX E{XB, SSB, (l + 1 < DEPTH) ? (const float*)(ws + WS_WFD) + (size_t)(l + 1) * DM * 4 : nullptr, FDB, DM, 1.0f / (WSCALE * ASCALE), nullptr};
            pg8::gemm_phase<pg8::EpiResidX, pg8::StaticOrder, PG8_ALIGN, PG8_SP2, true>(lds + RING_OFF, g, So, E);
            SEAM(pb + 5);
        }
    }
    }
    if (IN(NPHASE - 1)) final_pass(XB, P.out, P.final_g, SSB, gw, NGW, lane);
#undef IN
#undef SEAM
}

extern "C" void kernel_launch(void* const* d_in, const int* in_sizes, int n_in, void* d_out, int out_size, void* d_ws, size_t ws_size, hipStream_t stream) {
    static int grid = 0;
    if (grid == 0) {
        if (n_in != 13 || in_sizes[0] != M * DM || out_size != M * DM || ws_size < WS_END) { fprintf(stderr, "kernel_launch: unexpected shapes (n_in %d, in0 %d, out %d, ws %zu); nothing launched\n", n_in, n_in > 0 ? in_sizes[0] : -1, out_size, ws_size); grid = -1; return; }
        int dev = 0, cus = 0, per_cu = 0;
        if (hipGetDevice(&dev) != hipSuccess || hipDeviceGetAttribute(&cus, hipDeviceAttributeMultiprocessorCount, dev) != hipSuccess) { fprintf(stderr, "kernel_launch: device query failed\n"); grid = -1; return; }
        if (hipFuncSetAttribute((const void*)hybrid_fwd, hipFuncAttributeMaxDynamicSharedMemorySize, LDS_BYTES) != hipSuccess) { fprintf(stderr, "kernel_launch: hipFuncSetAttribute failed\n"); grid = -1; return; }
        if (hipOccupancyMaxActiveBlocksPerMultiprocessor(&per_cu, (const void*)hybrid_fwd, NWAVES * 64, LDS_BYTES) != hipSuccess || per_cu < 1)
            fprintf(stderr, "kernel_launch: note: occupancy query reports %d workgroups per CU\n", per_cu);
        (void)hipGetLastError();
        grid = cus;
    }
    if (grid < 0) return;
    if (hipMemsetAsync((char*)d_ws + WS_CTL, 0, CTL_ZERO_BYTES, stream) != hipSuccess) { fprintf(stderr, "kernel_launch: hipMemsetAsync failed\n"); return; }
    Args a{};
    for (int i = 0; i < 13; ++i) a.in[i] = (const float*)d_in[i];
    a.out = (float*)d_out; a.ws = (unsigned char*)d_ws;
    const int n_l = (PROBE_PHASE >= 0) ? 3 : N_LAUNCHES;
    for (int li = 0; li < n_l; ++li) {
        if (PROBE_PHASE >= 0) { a.ph_lo = li == 0 ? 0 : li == 1 ? PROBE_PHASE : PROBE_PHASE + 1; a.ph_hi = li == 0 ? PROBE_PHASE + 1 : li == 1 ? PROBE_PHASE + 1 : NPHASE; a.li = li; if (a.ph_lo >= a.ph_hi) continue; }
        else { a.ph_lo = (N_LAUNCHES == 1) ? 0 : li; a.ph_hi = (N_LAUNCHES == 1) ? NPHASE : li + 1; a.li = (N_LAUNCHES == 1) ? 0 : li; }
        hipLaunchKernelGGL(hybrid_fwd, dim3(grid), dim3(NWAVES * 64), LDS_BYTES, stream, a);
        const hipError_t le = hipPeekAtLastError();
        if (le != hipSuccess) { fprintf(stderr, "kernel_launch: launch %d failed: %s\n", li, hipGetErrorName(le)); break; }
    }
}
```

```cpp
#include <hip/hip_runtime.h>
#include <cstdio>
#include <cstdint>
#ifndef MK_N_LAUNCHES
#define MK_N_LAUNCHES 1
#endif
#define EX2(x) __builtin_amdgcn_exp2f(x)
#ifndef ATT_MFMA_MASK
#define ATT_MFMA_MASK 15
#endif
#ifndef DUP_MASK
#define DUP_MASK 0
#endif
#define DUPN(k) ((((DUP_MASK) >> (k)) & 1) + 1)
#ifndef ATT_DUP_TYPES
#define ATT_DUP_TYPES 0
#endif
#define ADUP(t) ((((ATT_DUP_TYPES) >> (t)) & 1) + 1)
#ifndef PROBE_PHASE
#define PROBE_PHASE -1
#endif
#ifndef ATT2_MASK
#define ATT2_MASK 10
#endif
#ifndef ATT3_ON
#define ATT3_ON 1
#endif
namespace pg8 {
#define PG8_LAS __attribute__((address_space(3)))
typedef unsigned short bf16_t;
typedef short bf16x8 __attribute__((ext_vector_type(8)));
typedef float f32x4 __attribute__((ext_vector_type(4)));
typedef unsigned u32x4 __attribute__((ext_vector_type(4)));
typedef int i32x4_t __attribute__((ext_vector_type(4)));
typedef int i32x8_t __attribute__((ext_vector_type(8)));
constexpr int BM = 256, BK = 64, HALF = 128, HTB = HALF * BK * 2  , STAGE_BYTES = 8 * HTB, NXCD = 8, WGM = 8;

__host__ __device__ __forceinline__ int lds_byte(int r, int c) { const int st = (r >> 4) * 2 + (c >> 5), rr = r & 15, cc = c & 31, ob = rr * 64 + cc * 2; return st * 1024 + (ob ^ (((ob >> 9) & 1) << 5)); }
__host__ __device__ __forceinline__ void stage_rc(int b, int& R, int& C) { const int st = b / 1024, sb = b % 1024, swz = sb ^ (((sb >> 9) & 1) << 5); R = (st >> 1) * 16 + swz / 64; C = (st & 1) * 32 + (swz % 64) / 2; }
__host__ __device__ __forceinline__ int perm32(int rho) { const int n = rho >> 4, i = rho & 15; return 8 * (i >> 2) + 4 * n + (i & 3); }

struct Unit { int pm, pn, ui; };
struct Gemm { const bf16_t* A; const bf16_t* Bt; int M, N, K; };

struct StaticOrder {
    int nM, nN, nwg, G, c;
    __host__ __device__ void init(int M, int N, int G_, int c_) { nM = M / BM; nN = N / BM; nwg = nM * nN; G = G_; c = c_; }
    __host__ __device__ bool next(int i, Unit& u) const {
        const long L = (long)i * G + c; if (L >= nwg) return false;
        int wgid = (int)L; { const int q = nwg / NXCD, r = nwg % NXCD, xcd = wgid % NXCD, off = wgid / NXCD; wgid = (xcd < r ? xcd * (q + 1) : r * (q + 1) + (xcd - r) * q) + off; }
        const int nig = WGM * nN, gid = wgid / nig, fm = gid * WGM, gsz = (nM - fm) < WGM ? (nM - fm) : WGM;
        u.pm = fm + ((wgid % nig) % gsz); u.pn = (wgid % nig) / gsz; u.ui = i; return true;
    }
    __device__ __forceinline__ void a_ready(const Unit&) const {}
    __device__ __forceinline__ void done(const Unit&) const {}
};

__device__ __forceinline__ unsigned cvt_pk_bf16(float lo, float hi) { unsigned r; asm volatile("v_cvt_pk_bf16_f32 %0, %1, %2" : "=v"(r) : "v"(lo), "v"(hi)); return r; }

#ifndef WT_STORES
#define WT_STORES 0
#endif
__device__ __forceinline__ void st16_wt(void* p, u32x4 v) {
#if WT_STORES
    asm volatile("global_store_dwordx4 %0, %1, off sc1\n\ts_nop 1" :: "v"(p), "v"(v) : "memory");
#else
    *(u32x4*)p = v;
#endif
}
typedef unsigned u32x2_t __attribute__((ext_vector_type(2)));
__device__ __forceinline__ void st8_wt(void* p, u32x2_t v) {
#if WT_STORES
    asm volatile("global_store_dwordx2 %0, %1, off sc1\n\ts_nop 1" :: "v"(p), "v"(v) : "memory");
#else
    *(u32x2_t*)p = v;
#endif
}
__device__ __forceinline__ unsigned pk4_fp8(float a, float b, float c, float d) {
    a = __builtin_amdgcn_fmed3f(a, -448.f, 448.f); b = __builtin_amdgcn_fmed3f(b, -448.f, 448.f); c = __builtin_amdgcn_fmed3f(c, -448.f, 448.f); d = __builtin_amdgcn_fmed3f(d, -448.f, 448.f);
    unsigned w = __builtin_amdgcn_cvt_pk_fp8_f32(a, b, 0u, false); return __builtin_amdgcn_cvt_pk_fp8_f32(c, d, w, true);
}
__device__ __forceinline__ float rstd_from_slots(const float* ss, int r) {
    const f32x4* p = (const f32x4*)(ss + (size_t)r * 16); const f32x4 a = p[0], b = p[1], c = p[2], d = p[3];
    const float s = ((a[0] + a[1]) + (a[2] + a[3])) + ((b[0] + b[1]) + (b[2] + b[3])) + ((c[0] + c[1]) + (c[2] + c[3])) + ((d[0] + d[1]) + (d[2] + d[3]));
    return 1.0f / sqrtf(s * (1.0f / 1024.0f) + 1e-6f);
}

template <class Sched> __device__ __forceinline__ void rstd_table(PG8_LAS float* tbl, const float* ss, const Sched& S) {
    Unit u;
    for (int i = 0; S.next(i, u); ++i) { if (threadIdx.x < 256) tbl[i * 256 + threadIdx.x] = rstd_from_slots(ss, u.pm * BM + (int)threadIdx.x); }
    __syncthreads();
}
struct EpiQKV {
    static constexpr bool PERM = true, AFTER_DRAIN = false;
    bf16_t* O; int ldc; const float* rstd; float qscale; PG8_LAS float* rsl;
    float* kmean; unsigned* nrm;
    __device__ __forceinline__ void operator()(const f32x4 (&acc)[2][2][4][2], const Unit& u, int wr, int wc, int fr, int fq) const {
        const int row0 = u.pm * BM + wr * 64 + fr, col0 = u.pn * BM + wc * 32 + 8 * fq;
        const float ts = (u.pn == 0 || u.pn == 3 || u.pn == 6 || u.pn == 8) ? qscale : 1.0f;
        const PG8_LAS float* sc = rsl + u.ui * 256 + wr * 64;
        const bool do_km = (u.pn == 4);
        const bool do_nrm = (u.pn == 8 || u.pn == 9);
        float cs[2][8]; float nmx[2] = {0.f, 0.f};
#pragma unroll
        for (int bj = 0; bj < 2; ++bj)
#pragma unroll
            for (int j = 0; j < 8; ++j) cs[bj][j] = 0.f;
#pragma unroll
        for (int ai = 0; ai < 2; ++ai)
#pragma unroll
            for (int m = 0; m < 4; ++m) { const int r = row0 + ai * HALF + m * 16; const float s = sc[ai * HALF + m * 16 + fr] * ts; bf16_t* rowp = O + (size_t)r * ldc + col0;
#pragma unroll
                for (int bj = 0; bj < 2; ++bj) { const f32x4 v0 = acc[ai][bj][m][0] * s, v1 = acc[ai][bj][m][1] * s;
                    u32x4 w; w.x = cvt_pk_bf16(v0[0], v0[1]); w.y = cvt_pk_bf16(v0[2], v0[3]); w.z = cvt_pk_bf16(v1[0], v1[1]); w.w = cvt_pk_bf16(v1[2], v1[3]);
                    st16_wt(rowp + bj * HALF, w);
                    if (do_km) {
#pragma unroll
                        for (int i = 0; i < 4; ++i) { cs[bj][i] += v0[i]; cs[bj][4 + i] += v1[i]; } }
                    if (do_nrm) { float q = (v0[0] * v0[0] + v0[1] * v0[1]) + (v0[2] * v0[2] + v0[3] * v0[3]) + (v1[0] * v1[0] + v1[1] * v1[1]) + (v1[2] * v1[2] + v1[3] * v1[3]);
                        q += __shfl_xor(q, 16); q += __shfl_xor(q, 32); nmx[bj] = __builtin_fmaxf(nmx[bj], q); } } }
        if (do_km) {
#pragma unroll
            for (int bj = 0; bj < 2; ++bj)
#pragma unroll
                for (int j = 0; j < 8; ++j) { float v = cs[bj][j]; v += __shfl_xor(v, 1); v += __shfl_xor(v, 2); v += __shfl_xor(v, 4); v += __shfl_xor(v, 8);
                    if (fr == 0) { const int cg = bj * HALF + wc * 32 + 8 * fq + j; atomicAdd(kmean + ((size_t)((u.pm >> 4) * 4 + (cg >> 6)) * 16 + (u.pm & 15)) * 64 + (cg & 63), v * (1.0f / 256.0f)); } }
        }
        if (do_nrm) {
#pragma unroll
            for (int bj = 0; bj < 2; ++bj) { float v = nmx[bj]; v = __builtin_fmaxf(v, __shfl_xor(v, 1)); v = __builtin_fmaxf(v, __shfl_xor(v, 2)); v = __builtin_fmaxf(v, __shfl_xor(v, 4)); v = __builtin_fmaxf(v, __shfl_xor(v, 8));
                if (fr == 0 && fq == 0) atomicMax(nrm + ((u.pm >> 4) * 4 + 2 * bj + (wc >> 1)) * 4 + (u.pn == 9 ? 2 : 0) + (wc & 1), __float_as_uint(v)); }
        }
    }
};
struct EpiResid {
    static constexpr bool PERM = false, AFTER_DRAIN = false;
    const float* base; float* out; int ldc;
    __device__ __forceinline__ void operator()(const f32x4 (&acc)[2][2][4][2], const Unit& u, int wr, int wc, int fr, int fq) const {
        const int row0 = u.pm * BM + wr * 64 + fr, col0 = u.pn * BM + wc * 32 + 4 * fq;
#pragma unroll
        for (int ai = 0; ai < 2; ++ai)
#pragma unroll
            for (int m = 0; m < 4; ++m) { const size_t off = (size_t)(row0 + ai * HALF + m * 16) * ldc + col0;
#pragma unroll
                for (int bj = 0; bj < 2; ++bj)
#pragma unroll
                    for (int n = 0; n < 2; ++n) { const f32x4 b = *(const f32x4*)(base + off + bj * HALF + n * 16); *(f32x4*)(out + off + bj * HALF + n * 16) = b + acc[ai][bj][m][n]; } }
    }
};
struct EpiResidX {
    static constexpr bool PERM = true, AFTER_DRAIN = false;
    bf16_t* xb; float* ss; const float* wfd; float* fdp; int ldc; float ascale; unsigned char* x8;
    __device__ __forceinline__ void operator()(const f32x4 (&acc)[2][2][4][2], const Unit& u, int wr, int wc, int fr, int fq) const {
        const int row0 = u.pm * BM + wr * 64 + fr, col0 = u.pn * BM + wc * 32 + 8 * fq; const int slot = u.pn * 4 + wc;
#pragma unroll
        for (int ai = 0; ai < 2; ++ai)
#pragma unroll
            for (int m = 0; m < 4; ++m) { const int r = row0 + ai * HALF + m * 16; bf16_t* rowp = xb + (size_t)r * ldc + col0;
                float s2 = 0.f, f0 = 0.f, f1 = 0.f, f2 = 0.f, f3 = 0.f;
#pragma unroll
                for (int bj = 0; bj < 2; ++bj) { const u32x4 xw = *(const u32x4*)(rowp + bj * HALF);
                    float v[8];
                    v[0] = fmaf(acc[ai][bj][m][0][0], ascale, __builtin_bit_cast(float, xw.x << 16)); v[1] = fmaf(acc[ai][bj][m][0][1], ascale, __builtin_bit_cast(float, xw.x & 0xffff0000u));
                    v[2] = fmaf(acc[ai][bj][m][0][2], ascale, __builtin_bit_cast(float, xw.y << 16)); v[3] = fmaf(acc[ai][bj][m][0][3], ascale, __builtin_bit_cast(float, xw.y & 0xffff0000u));
                    v[4] = fmaf(acc[ai][bj][m][1][0], ascale, __builtin_bit_cast(float, xw.z << 16)); v[5] = fmaf(acc[ai][bj][m][1][1], ascale, __builtin_bit_cast(float, xw.z & 0xffff0000u));
                    v[6] = fmaf(acc[ai][bj][m][1][2], ascale, __builtin_bit_cast(float, xw.w << 16)); v[7] = fmaf(acc[ai][bj][m][1][3], ascale, __builtin_bit_cast(float, xw.w & 0xffff0000u));
                    u32x4 w; w.x = cvt_pk_bf16(v[0], v[1]); w.y = cvt_pk_bf16(v[2], v[3]); w.z = cvt_pk_bf16(v[4], v[5]); w.w = cvt_pk_bf16(v[6], v[7]);
                    st16_wt(rowp + bj * HALF, w);
                    if (x8) { u32x2_t q; q.x = pk4_fp8(v[0], v[1], v[2], v[3]); q.y = pk4_fp8(v[4], v[5], v[6], v[7]); st8_wt(x8 + (size_t)r * ldc + col0 + bj * HALF, q); }
#pragma unroll
                    for (int i = 0; i < 8; ++i) s2 = fmaf(v[i], v[i], s2);
                    if (wfd) {
#pragma unroll
                        for (int i = 0; i < 8; ++i) { const f32x4 wv = *(const f32x4*)(wfd + (size_t)(col0 + bj * HALF + i) * 4); f0 += v[i] * wv[0]; f1 += v[i] * wv[1]; f2 += v[i] * wv[2]; f3 += v[i] * wv[3]; } } }
                s2 += __shfl_xor(s2, 16); s2 += __shfl_xor(s2, 32);
                if (wfd) { f0 += __shfl_xor(f0, 16); f0 += __shfl_xor(f0, 32); f1 += __shfl_xor(f1, 16); f1 += __shfl_xor(f1, 32); f2 += __shfl_xor(f2, 16); f2 += __shfl_xor(f2, 32); f3 += __shfl_xor(f3, 16); f3 += __shfl_xor(f3, 32); }
                if (fq == 0) { ss[(size_t)r * 16 + slot] = s2; if (wfd) { float* fp = fdp + (size_t)r * 64 + slot; fp[0] = f0; fp[16] = f1; fp[32] = f2; fp[48] = f3; } } }
    }
};
struct EpiSwiGLU {
    static constexpr bool PERM = true, AFTER_DRAIN = false;
    unsigned char* O; int ldc; const float* rstd; PG8_LAS float* rsl; float ascale, oscale;
    __device__ __forceinline__ void operator()(const f32x4 (&acc)[2][2][4][2], const Unit& u, int wr, int wc, int fr, int fq) const {
        const int row0 = u.pm * BM + wr * 64 + fr, col0 = u.pn * HALF + wc * 32 + 8 * fq;
        const PG8_LAS float* sc = rsl + u.ui * 256 + wr * 64;
#pragma unroll
        for (int ai = 0; ai < 2; ++ai)
#pragma unroll
            for (int m = 0; m < 4; ++m) { const int r = row0 + ai * HALF + m * 16; const float s = sc[ai * HALF + m * 16 + fr] * ascale; unsigned char* rowp = O + (size_t)r * ldc + col0;
                const float sn = -1.4426950408889634f * s, su = s * oscale;
                float a[8];
#pragma unroll
                for (int n = 0; n < 2; ++n)
#pragma unroll
                    for (int i = 0; i < 4; ++i) { const float ag = acc[ai][0][m][n][i], au = acc[ai][1][m][n][i];
                        const float sg = __builtin_amdgcn_rcpf(1.0f + __builtin_amdgcn_exp2f(ag * sn)); a[4 * n + i] = (ag * s) * sg * (au * su); }
                u32x2_t w; w.x = pk4_fp8(a[0], a[1], a[2], a[3]); w.y = pk4_fp8(a[4], a[5], a[6], a[7]);
                st8_wt(rowp, w); }
    }
};

template <class Epi, class Sched, bool ALIGN_EPI = false, bool SP2 = false, bool F8 = false>
__device__ __forceinline__ void gemm_phase(PG8_LAS unsigned char* lds, const Gemm g, const Sched& S, const Epi& E) {
    const int tid = threadIdx.x, wid = __builtin_amdgcn_readfirstlane(tid >> 6), lane = tid & 63, wr = wid >> 2, wc = wid & 3, fr = lane & 15, fq = lane >> 4;
    const int KB = F8 ? g.K : 2 * g.K, nt = KB / (BK * 2);
    unsigned voffA[2], voffB[2];
#pragma unroll
    for (int i = 0; i < 2; ++i) { int R, C; stage_rc(tid * 16 + i * 8192, R, C); const int Rb = Epi::PERM ? ((R & ~31) + perm32(R & 31)) : R;
        voffA[i] = (unsigned)(R * KB + C * 2); voffB[i] = (unsigned)(Rb * KB + C * 2); }
    const size_t kstep = (size_t)(BK * 2);
    const size_t hstep = (size_t)HALF * KB;
    const size_t tstep = 2 * hstep;
    const unsigned ldsw = (unsigned)wid * 1024u;
    int aoffk[2], boffk[2];
#pragma unroll
    for (int k = 0; k < 2; ++k) { const int c = F8 ? 16 * fq + 8 * k : fq * 8 + 32 * k; aoffk[k] = lds_byte(wr * 64 + fr, c); boffk[k] = lds_byte(wc * 32 + fr, c); }
#define PG8_SA(b, h) (((b) * 2 + (h)) * HTB)
#define PG8_SB(b, h) ((4 + (b) * 2 + (h)) * HTB)
#define PG8_STAGE(bufoff, gbase, voff) do { _Pragma("unroll") for (int _i = 0; _i < 2; ++_i) \
        __builtin_amdgcn_global_load_lds((const unsigned*)((const char*)(gbase) + (voff)[_i]), (PG8_LAS unsigned*)(lds + (bufoff) + ldsw + _i * 8192), 16, 0, 0); } while (0)
#define PG8_LDA(dst, b, h) do { _Pragma("unroll") for (int m = 0; m < 4; ++m) _Pragma("unroll") for (int k = 0; k < 2; ++k) dst[m][k] = *(const PG8_LAS bf16x8*)(lds + PG8_SA(b, h) + aoffk[k] + m * 2048); } while (0)
#define PG8_LDA8(dst, b, h) do { _Pragma("unroll") for (int m = 0; m < 4; ++m) { const i32x4_t lo_ = *(const PG8_LAS i32x4_t*)(lds + PG8_SA(b, h) + aoffk[0] + m * 2048), hi_ = *(const PG8_LAS i32x4_t*)(lds + PG8_SA(b, h) + aoffk[1] + m * 2048); dst[m] = __builtin_shufflevector(lo_, hi_, 0, 1, 2, 3, 4, 5, 6, 7); } } while (0)
#define PG8_LDB(dst, b, h) do { _Pragma("unroll") for (int n = 0; n < 2; ++n) _Pragma("unroll") for (int k = 0; k < 2; ++k) dst[n][k] = *(const PG8_LAS bf16x8*)(lds + PG8_SB(b, h) + boffk[k] + n * 2048); } while (0)
#define PG8_LDB8(dst, b, h) do { _Pragma("unroll") for (int n = 0; n < 2; ++n) { const i32x4_t lo_ = *(const PG8_LAS i32x4_t*)(lds + PG8_SB(b, h) + boffk[0] + n * 2048), hi_ = *(const PG8_LAS i32x4_t*)(lds + PG8_SB(b, h) + boffk[1] + n * 2048); dst[n] = __builtin_shufflevector(lo_, hi_, 0, 1, 2, 3, 4, 5, 6, 7); } } while (0)
#define PG8_MMA(ai, bj, At, Bt) do { __builtin_amdgcn_s_setprio(1); _Pragma("unroll") for (int m = 0; m < 4; ++m) _Pragma("unroll") for (int n = 0; n < 2; ++n) _Pragma("unroll") for (int k = 0; k < 2; ++k) \
        acc[ai][bj][m][n] = __builtin_amdgcn_mfma_f32_16x16x32_bf16(Bt[n][k], At[m][k], acc[ai][bj][m][n], 0, 0, 0); __builtin_amdgcn_s_setprio(0); } while (0)
#define PG8_MMA8(ai, bj, At, Bt) do { __builtin_amdgcn_sched_barrier(0); __builtin_amdgcn_s_setprio(1); _Pragma("unroll") for (int m = 0; m < 4; ++m) _Pragma("unroll") for (int n = 0; n < 2; ++n) \
        acc[ai][bj][m][n] = __builtin_amdgcn_mfma_scale_f32_16x16x128_f8f6f4(Bt[n], At[m], acc[ai][bj][m][n], 0, 0, 0, 0x7f7f7f7f, 0, 0x7f7f7f7f); __builtin_amdgcn_s_setprio(0); \
        asm volatile("" : "+v"(acc[ai][bj][0][0]), "+v"(acc[ai][bj][0][1]), "+v"(acc[ai][bj][1][0]), "+v"(acc[ai][bj][1][1]), "+v"(acc[ai][bj][2][0]), "+v"(acc[ai][bj][2][1]), "+v"(acc[ai][bj][3][0]), "+v"(acc[ai][bj][3][1])); \
        __builtin_amdgcn_sched_barrier(0); } while (0)
#define PG8_LDAx(b, h) do { if constexpr (F8) PG8_LDA8(At8, b, h); else PG8_LDA(At, b, h); } while (0)
#define PG8_LDBx(w, b, h) do { if constexpr (F8) { if ((w) == 0) PG8_LDB8(B08, b, h); else PG8_LDB8(B18, b, h); } else { if ((w) == 0) PG8_LDB(B0, b, h); else PG8_LDB(B1, b, h); } } while (0)
#define PG8_MMAx(ai, bj, w) do { if constexpr (F8) { if ((w) == 0) PG8_MMA8(ai, bj, At8, B08); else PG8_MMA8(ai, bj, At8, B18); } else { if ((w) == 0) PG8_MMA(ai, bj, At, B0); else PG8_MMA(ai, bj, At, B1); } } while (0)
#define PG8_WAIT_V(n) asm volatile("s_waitcnt vmcnt(" #n ")" ::: "memory")
#define PG8_WAIT_L(n) asm volatile("s_waitcnt lgkmcnt(" #n ")" ::: "memory")
#define PG8_BAR __builtin_amdgcn_s_barrier()
#define PG8_SCHED __builtin_amdgcn_sched_barrier(0)
    Unit cur, nxt; int ui = 0;
    if (!S.next(0, cur)) return;
    f32x4 acc[2][2][4][2];
#pragma unroll
    for (int a = 0; a < 2; ++a)
#pragma unroll
        for (int b = 0; b < 2; ++b)
#pragma unroll
            for (int m = 0; m < 4; ++m)
#pragma unroll
                for (int n = 0; n < 2; ++n) acc[a][b][m][n] = (f32x4){0.f, 0.f, 0.f, 0.f};
    bf16x8 At[4][2], B0[2][2], B1[2][2]; i32x8_t At8[4], B08[2], B18[2];
    const char* cA = (const char*)g.A + (size_t)cur.pm * tstep; const char* cB = (const char*)g.Bt + (size_t)cur.pn * tstep;
    S.a_ready(cur);
    if constexpr (SP2) {
        PG8_STAGE(PG8_SB(0, 0), cB, voffB); PG8_STAGE(PG8_SB(0, 1), cB + hstep, voffB); PG8_STAGE(PG8_SA(0, 0), cA, voffA); PG8_STAGE(PG8_SA(0, 1), cA + hstep, voffA);
        if (wr == 1) PG8_BAR;
        PG8_WAIT_V(2); PG8_BAR;
        PG8_STAGE(PG8_SB(1, 0), cB + kstep, voffB); PG8_STAGE(PG8_SA(1, 0), cA + kstep, voffA); PG8_STAGE(PG8_SB(1, 1), cB + hstep + kstep, voffB);
        PG8_WAIT_V(6); PG8_BAR;
    } else {
        PG8_STAGE(PG8_SB(0, 0), cB, voffB); PG8_STAGE(PG8_SA(0, 0), cA, voffA); PG8_STAGE(PG8_SB(0, 1), cB + hstep, voffB); PG8_STAGE(PG8_SA(0, 1), cA + hstep, voffA);
        if (wr == 1) PG8_BAR;
        PG8_WAIT_V(4); PG8_BAR;
        PG8_STAGE(PG8_SB(1, 0), cB + kstep, voffB); PG8_STAGE(PG8_SA(1, 0), cA + kstep, voffA); PG8_STAGE(PG8_SB(1, 1), cB + hstep + kstep, voffB);
        PG8_WAIT_V(6); PG8_BAR;
    }
    for (;;) {
        const bool has_next = S.next(ui + 1, nxt);
        const char* nA = has_next ? (const char*)g.A + (size_t)nxt.pm * tstep : cA; const char* nB = has_next ? (const char*)g.Bt + (size_t)nxt.pn * tstep : cB;
        for (int t = 0; t < nt; t += 2) {
            const bool last = (t == nt - 2);
            const char* a1 = cA + (size_t)(t + 1) * kstep;
            const char* a2 = last ? nA : cA + (size_t)(t + 2) * kstep; const char* b2 = last ? nB : cB + (size_t)(t + 2) * kstep;
            const char* a3 = a2 + kstep; const char* b3 = b2 + kstep;
            if (last && has_next) S.a_ready(nxt);
            if constexpr (SP2) {
            PG8_LDBx(0, 0, 0); PG8_LDBx(1, 0, 1); PG8_SCHED; PG8_LDAx(0, 0); PG8_STAGE(PG8_SA(1, 1), a1 + hstep, voffA);
            PG8_WAIT_V(8); PG8_WAIT_L(0); PG8_BAR; PG8_MMAx(0, 0, 0); PG8_MMAx(0, 1, 1); PG8_BAR; PG8_SCHED;
            PG8_LDAx(0, 1); PG8_STAGE(PG8_SB(0, 0), b2, voffB); PG8_STAGE(PG8_SB(0, 1), b2 + hstep, voffB); PG8_STAGE(PG8_SA(0, 0), a2, voffA);
            PG8_WAIT_V(8); PG8_WAIT_L(0); PG8_BAR; PG8_MMAx(1, 0, 0); PG8_MMAx(1, 1, 1); PG8_BAR; PG8_SCHED;
            PG8_LDBx(0, 1, 0); PG8_LDBx(1, 1, 1); PG8_SCHED; PG8_LDAx(1, 0); PG8_STAGE(PG8_SA(0, 1), a2 + hstep, voffA);
            PG8_WAIT_V(8); PG8_WAIT_L(0); PG8_BAR; PG8_MMAx(0, 0, 0); PG8_MMAx(0, 1, 1); PG8_BAR; PG8_SCHED;
            PG8_LDAx(1, 1); PG8_STAGE(PG8_SB(1, 0), b3, voffB); PG8_STAGE(PG8_SB(1, 1), b3 + hstep, voffB); PG8_STAGE(PG8_SA(1, 0), a3, voffA);
            PG8_WAIT_V(8); PG8_WAIT_L(0); PG8_BAR; PG8_MMAx(1, 0, 0); PG8_MMAx(1, 1, 1); PG8_BAR; PG8_SCHED;
            } else {
            PG8_LDBx(0, 0, 0); PG8_SCHED; PG8_LDAx(0, 0); PG8_STAGE(PG8_SA(1, 1), a1 + hstep, voffA);
            PG8_WAIT_L(8); PG8_BAR; PG8_WAIT_L(0); PG8_MMAx(0, 0, 0); PG8_BAR; PG8_SCHED;
            PG8_LDBx(1, 0, 1); PG8_STAGE(PG8_SB(0, 0), b2, voffB);
            PG8_BAR; PG8_WAIT_L(0); PG8_MMAx(0, 1, 1); PG8_BAR;
            PG8_LDAx(0, 1); PG8_STAGE(PG8_SA(0, 0), a2, voffA);
            PG8_BAR; PG8_WAIT_L(0); PG8_MMAx(1, 0, 0); PG8_BAR; PG8_SCHED;
            PG8_STAGE(PG8_SB(0, 1), b2 + hstep, voffB);
            PG8_WAIT_V(6); PG8_BAR; PG8_MMAx(1, 1, 1); PG8_BAR;
            PG8_LDBx(0, 1, 0); PG8_SCHED; PG8_LDAx(1, 0); PG8_STAGE(PG8_SA(0, 1), a2 + hstep, voffA);
            PG8_WAIT_L(8); PG8_BAR; PG8_WAIT_L(0); PG8_MMAx(0, 0, 0); PG8_BAR; PG8_SCHED;
            PG8_LDBx(1, 1, 1); PG8_STAGE(PG8_SB(1, 0), b3, voffB);
            PG8_BAR; PG8_WAIT_L(0); PG8_MMAx(0, 1, 1); PG8_BAR;
            PG8_LDAx(1, 1); PG8_STAGE(PG8_SA(1, 0), a3, voffA);
            PG8_BAR; PG8_WAIT_L(0); PG8_MMAx(1, 0, 0); PG8_BAR; PG8_SCHED;
            PG8_STAGE(PG8_SB(1, 1), b3 + hstep, voffB);
            PG8_WAIT_V(6); PG8_BAR; PG8_MMAx(1, 1, 1); PG8_BAR;
            }
        }
        if constexpr (ALIGN_EPI) { if (wr == 0) PG8_BAR; }
        if constexpr (!Epi::AFTER_DRAIN) { E(acc, cur, wr, wc, fr, fq); S.done(cur); }
        if (!has_next) break;
#pragma unroll
        for (int a = 0; a < 2; ++a)
#pragma unroll
            for (int b = 0; b < 2; ++b)
#pragma unroll
                for (int m = 0; m < 4; ++m)
#pragma unroll
                    for (int n = 0; n < 2; ++n) acc[a][b][m][n] = (f32x4){0.f, 0.f, 0.f, 0.f};
        cur = nxt; cA = nA; cB = nB; ++ui;
        if constexpr (ALIGN_EPI) { if (wr == 1) PG8_BAR; }
    }
    PG8_WAIT_V(0);
    if constexpr (!ALIGN_EPI) { if (wr == 0) PG8_BAR; }
    PG8_BAR;
    if constexpr (Epi::AFTER_DRAIN) { E.fused(acc, cur, wr, wc, fr, fq, lds, wid, lane); S.done(cur); }
#undef PG8_SA
#undef PG8_SB
#undef PG8_STAGE
#undef PG8_LDA
#undef PG8_LDB
#undef PG8_MMA
#undef PG8_MMA8
#undef PG8_LDAx
#undef PG8_LDBx
#undef PG8_MMAx
#undef PG8_LDA8
#undef PG8_LDB8
#undef PG8_WAIT_V
#undef PG8_WAIT_L
#undef PG8_BAR
#undef PG8_SCHED
}
}
namespace att {
#define ATT_LAS __attribute__((address_space(3)))
typedef short bf16x8 __attribute__((ext_vector_type(8)));
typedef short s16x4 __attribute__((ext_vector_type(4)));
typedef float f32x16 __attribute__((ext_vector_type(16)));
typedef float f32x4 __attribute__((ext_vector_type(4)));
typedef unsigned u32x4 __attribute__((ext_vector_type(4)));
typedef unsigned short bf16;
enum { T_A = 0, T_B = 1, T_C = 2, T_D = 3 };
constexpr int S = 4096, QP = 2816;
constexpr int SLOTB = 8192;
constexpr int NSLOT = 4;
constexpr int L_K = 0, L_V = NSLOT * SLOTB, L_KB = 2 * NSLOT * SLOTB, L_WS = L_KB + NSLOT * 256 + 256, L_TAB = L_WS + 2048, TAB_N = 5600, L_KM = L_TAB + TAB_N * 4, L_OST = L_KM + 4096, L_END = L_OST + 8 * 4096;
static_assert(L_TAB % 16 == 0 && L_KM % 16 == 0 && L_OST % 16 == 0 && L_END <= 131072, "attention LDS map");
constexpr float THR = 8.0f;
__device__ __forceinline__ constexpr int offr(int r) { return (r & 3) + 8 * (r >> 2); }
__device__ __forceinline__ unsigned cvtpk(float lo, float hi) { typedef float f2 __attribute__((ext_vector_type(2))); typedef __bf16 b2 __attribute__((ext_vector_type(2))); f2 v = {lo, hi}; b2 b = __builtin_convertvector(v, b2); return __builtin_bit_cast(unsigned, b); }
__device__ __forceinline__ s16x4 vtr(const ATT_LAS char* p) { typedef short v4i16_t __attribute__((ext_vector_type(4))); return __builtin_bit_cast(s16x4, __builtin_amdgcn_ds_read_tr16_b64_v4i16((ATT_LAS v4i16_t*)p)); }
__device__ __forceinline__ float xhalf_max(float v) { auto rr = __builtin_amdgcn_permlane32_swap(__float_as_uint(v), __float_as_uint(v), false, false); return fmaxf(__uint_as_float(rr[0]), __uint_as_float(rr[1])); }
__device__ __forceinline__ float xhalf_sum(float v) { auto rr = __builtin_amdgcn_permlane32_swap(__float_as_uint(v), __float_as_uint(v), false, false); return __uint_as_float(rr[0]) + __uint_as_float(rr[1]); }

__device__ __forceinline__ void glds16(const void* gsrc, unsigned lds_dst) { unsigned keep;
    asm volatile("s_mov_b32 %0, m0\n\ts_mov_b32 m0, %2\n\ts_nop 0\n\tglobal_load_lds_dwordx4 %1, off\n\ts_mov_b32 m0, %0" : "=&s"(keep) : "v"(gsrc), "s"(lds_dst) : "memory"); }
__device__ __forceinline__ void glds4(const void* gsrc, unsigned lds_dst) { unsigned keep;
    asm volatile("s_mov_b32 %0, m0\n\ts_mov_b32 m0, %2\n\ts_nop 0\n\tglobal_load_lds_dword %1, off\n\ts_mov_b32 m0, %0" : "=&s"(keep) : "v"(gsrc), "s"(lds_dst) : "memory"); }

template <int TYPE>
__device__ __forceinline__ void attn_item(ATT_LAS unsigned char* lds, const bf16* qkv, int b, int h, int qb, int res, int dil_rt, int W_rt, int qcol_rt, int kcol_rt, int vcol_rt, const float* tabg, int tab_id, int& cur_tab, const float* c2bh, const unsigned* nrm, const float* kmbh, float sink2,
                                          bf16* outp, int ldo, float* lse_out) {
    const int tid = threadIdx.x, lane = tid & 63, r32 = lane & 31, hi = lane >> 5; const int wid = __builtin_amdgcn_readfirstlane(tid >> 6);
    constexpr bool BAND = (TYPE == T_A);
    const int W = W_rt; const int DIL = BAND ? dil_rt : 1;
    const int qcol = BAND ? qcol_rt : (TYPE == T_B ? 768 : 2048) + 64 * h;
    const int kcol = BAND ? kcol_rt : (TYPE == T_B ? 1024 : 2304) + 64 * h;
    const int vcol = BAND ? vcol_rt : (TYPE == T_B ? 1280 : 2560) + 64 * h;
    const size_t rowbase = (size_t)b * S + res;
    const int qf0 = 256 * qb, qfw = qf0 + 32 * wid;
    const int kf0 = BAND ? qf0 - 128 : 0, NT = BAND ? 6 : 4 * (qb + 1);
    int tlo = (BAND && qb == 0) ? 2 : 0;
    if (TYPE == T_D) {
        const float qm = __uint_as_float(nrm[0]) + __uint_as_float(nrm[1]), kmx = __uint_as_float(nrm[2]) + __uint_as_float(nrm[3]);
        const float bound = 2.0f * sqrtf(qm * kmx) * 1.01f + 42.0f;
        const float c0 = c2bh[qf0];
        const bool skip = (lane < 4 * qb) && (c0 - c2bh[64 * (lane < 4 * qb ? lane : 0) + 63] < -bound);
        tlo = __builtin_popcountll(__ballot(skip));
    }
    ATT_LAS float* tab = (ATT_LAS float*)(lds + L_TAB);
    ATT_LAS float* km = (ATT_LAS float*)(lds + L_KM);
    ATT_LAS float* wsf = (ATT_LAS float*)(lds + L_WS) + wid * 64;
    const unsigned lds0 = (unsigned)(uintptr_t)lds;
#define ATT_ISSUE(t) do { const int k0_ = kf0 + 64 * (t); const int sl_ = ((t) - tlo) % NSLOT; int kk_ = k0_ + lane; kk_ = kk_ < 0 ? 0 : kk_; \
        glds16(qkv + (rowbase + (size_t)kk_ * DIL) * QP + kcol + wid * 8, (unsigned)__builtin_amdgcn_readfirstlane(lds0 + L_K + sl_ * SLOTB + wid * 1024)); \
        int kv_ = k0_ + 16 * (wid & 3) + (lane >> 2); kv_ = kv_ < 0 ? 0 : kv_; \
        glds16(qkv + (rowbase + (size_t)kv_ * DIL) * QP + vcol + (wid >> 2) * 32 + (lane & 3) * 8, (unsigned)__builtin_amdgcn_readfirstlane(lds0 + L_V + sl_ * SLOTB + wid * 1024)); \
        if (TYPE == T_D) glds4(c2bh + k0_ + lane, (unsigned)__builtin_amdgcn_readfirstlane(lds0 + L_KB + sl_ * 256)); } while (0)
    if (TYPE != T_D) { if (tab_id != cur_tab) { cur_tab = tab_id;
            for (int i = tid; i < TAB_N; i += 512) tab[i] = (i < 4096) ? tabg[4095 - i] : 0.f; } }
    if (TYPE == T_B) { for (int i = tid; i < 16 * 64; i += 512) km[i] = kmbh[i]; }
    bf16x8 qr[4];
    { const bf16* qrow = qkv + (rowbase + (size_t)(qfw + r32) * DIL) * QP + qcol;
#pragma unroll
      for (int d0 = 0; d0 < 4; ++d0) qr[d0] = *(const bf16x8*)(qrow + 16 * d0 + 8 * hi); }
    const float cq = (TYPE == T_D) ? c2bh[qfw + r32] : 0.f;
    ATT_ISSUE(tlo); if (tlo + 1 < NT) ATT_ISSUE(tlo + 1); if (tlo + 2 < NT) ATT_ISSUE(tlo + 2);
    asm volatile("s_waitcnt vmcnt(0)" ::: "memory");
    __syncthreads();
    unsigned sel = 0u;
    if (TYPE == T_B) {
        float g[16];
#pragma unroll
        for (int n = 0; n < 16; ++n) { g[n] = -INFINITY; if (n < qb) { float s = 0.f;
#pragma unroll
                for (int d0 = 0; d0 < 4; ++d0) { const f32x4 a = *(const ATT_LAS f32x4*)(km + n * 64 + 16 * d0 + 8 * hi), c = *(const ATT_LAS f32x4*)(km + n * 64 + 16 * d0 + 8 * hi + 4);
                    const bf16x8 qv = qr[d0];
                    s = fmaf(__builtin_bit_cast(float, (unsigned)(unsigned short)qv[0] << 16), a[0], s); s = fmaf(__builtin_bit_cast(float, (unsigned)(unsigned short)qv[1] << 16), a[1], s);
                    s = fmaf(__builtin_bit_cast(float, (unsigned)(unsigned short)qv[2] << 16), a[2], s); s = fmaf(__builtin_bit_cast(float, (unsigned)(unsigned short)qv[3] << 16), a[3], s);
                    s = fmaf(__builtin_bit_cast(float, (unsigned)(unsigned short)qv[4] << 16), c[0], s); s = fmaf(__builtin_bit_cast(float, (unsigned)(unsigned short)qv[5] << 16), c[1], s);
                    s = fmaf(__builtin_bit_cast(float, (unsigned)(unsigned short)qv[6] << 16), c[2], s); s = fmaf(__builtin_bit_cast(float, (unsigned)(unsigned short)qv[7] << 16), c[3], s); }
                g[n] = xhalf_sum(s); } }
#pragma unroll
        for (int r = 0; r < 3; ++r) { float best = -INFINITY; int bi = -1;
#pragma unroll
            for (int n = 0; n < 16; ++n) if (n < qb && !((sel >> n) & 1u) && g[n] > best) { best = g[n]; bi = n; }
            if (bi >= 0) sel |= 1u << bi; }
    }
    float m = 0.f, l = 0.f; f32x16 o[2]; o[0] = f32x16{}; o[1] = f32x16{};
    const int vpo = ((lane >> 4) & 1) * 32 + (lane & 3) * 8 + (4 * hi + ((lane & 15) >> 2)) * 64;
    f32x16 p0 = f32x16{}, p1 = f32x16{}; u32x4 pw[4] = {u32x4{}, u32x4{}, u32x4{}, u32x4{}};
    const int hb = wid >> 2;
#define ATT_BAR(N) asm volatile("s_waitcnt vmcnt(" #N ") lgkmcnt(0)\n\ts_barrier" ::: "memory")
#define ATT_ACTIVE(T, ACT, PICK) do { const int k0_ = kf0 + 64 * (T); PICK = true; \
        if (BAND) ACT = (k0_ <= qfw + 31) && (k0_ + 63 >= qfw - W); \
        else if (TYPE == T_B) { const bool past_ = k0_ < qf0; PICK = past_ ? ((sel >> (k0_ >> 8)) & 1u) : true; ACT = past_ ? (__ballot(PICK) != 0ull) : (k0_ <= qfw + 31); } \
        else ACT = (k0_ <= qfw + 31); } while (0)
#define ATT_LDK(T, KF) do { const int sl_ = ((T) - tlo) % NSLOT; const ATT_LAS char* kb_ = (const ATT_LAS char*)(lds + L_K + sl_ * SLOTB) + hi * 1024 + r32 * 16; \
        _Pragma("unroll") for (int d0 = 0; d0 < 4; ++d0) { KF[2 * d0] = *(const ATT_LAS bf16x8*)(kb_ + d0 * 2048); KF[2 * d0 + 1] = *(const ATT_LAS bf16x8*)(kb_ + d0 * 2048 + 512); } } while (0)
#define ATT_LDV(T, D0, VF) do { const int sl_ = ((T) - tlo) % NSLOT; const ATT_LAS char* vp = (const ATT_LAS char*)(lds + L_V + sl_ * SLOTB) + vpo; \
        _Pragma("unroll") for (int ks = 0; ks < 4; ++ks) { const s16x4 lo = vtr(vp + (D0) * 4096 + ks * 1024), hh = vtr(vp + (D0) * 4096 + ks * 1024 + 512); \
            VF[ks] = (bf16x8){lo[0], lo[1], lo[2], lo[3], hh[0], hh[1], hh[2], hh[3]}; } } while (0)
#define ATT_QK(KF, P0, P1, PICK) do { \
        f32x16 ci_; { const float c_ = (TYPE == T_B && !(PICK)) ? -INFINITY : cq - m; _Pragma("unroll") for (int r = 0; r < 16; ++r) ci_[r] = c_; } \
        _Pragma("unroll") for (int d0 = 0; d0 < 4; ++d0) { \
            if (d0 == 0) { P0 = __builtin_amdgcn_mfma_f32_32x32x16_bf16(KF[0], qr[0], ci_, 0, 0, 0); P1 = __builtin_amdgcn_mfma_f32_32x32x16_bf16(KF[1], qr[0], ci_, 0, 0, 0); } \
            else { P0 = __builtin_amdgcn_mfma_f32_32x32x16_bf16(KF[2 * d0], qr[d0], P0, 0, 0, 0); P1 = __builtin_amdgcn_mfma_f32_32x32x16_bf16(KF[2 * d0 + 1], qr[d0], P1, 0, 0, 0); } } } while (0)
#define ATT_MOD(T, P0, P1) do { const int sl_ = ((T) - tlo) % NSLOT; const int k0 = kf0 + 64 * (T); \
        const int d0l = qfw + r32 - k0 - 4 * hi; \
        if (TYPE != T_D) { \
            if (TYPE == T_B && qfw - k0 - 63 >= 1513) { const float bfar = tab[0]; \
                _Pragma("unroll") for (int r = 0; r < 16; ++r) { P0[r] += bfar; P1[r] += bfar; } \
            } else { const ATT_LAS float* tb = tab + (4095 - DIL * d0l); \
                _Pragma("unroll") for (int r = 0; r < 16; ++r) { P0[r] += tb[DIL * offr(r)]; P1[r] += tb[DIL * (offr(r) + 32)]; } } \
        } else { const ATT_LAS float* cb = (const ATT_LAS float*)(lds + L_KB + sl_ * 256) + 4 * hi; \
            _Pragma("unroll") for (int i = 0; i < 4; ++i) { const f32x4 c0 = *(const ATT_LAS f32x4*)(cb + 8 * i), c1 = *(const ATT_LAS f32x4*)(cb + 8 * i + 32); \
                _Pragma("unroll") for (int j = 0; j < 4; ++j) { P0[4 * i + j] -= c0[j]; P1[4 * i + j] -= c1[j]; } } } \
        if (k0 + 63 > qfw) { _Pragma("unroll") for (int r = 0; r < 16; ++r) { if (d0l - offr(r) < 0) P0[r] = -INFINITY; if (d0l - offr(r) - 32 < 0) P1[r] = -INFINITY; } } \
        if (BAND) { if (qfw + 31 - k0 > W) { _Pragma("unroll") for (int r = 0; r < 16; ++r) { if (d0l - offr(r) > W) P0[r] = -INFINITY; if (d0l - offr(r) - 32 > W) P1[r] = -INFINITY; } } } \
        float rm = fmaxf(P0[0], P1[0]), rm2 = fmaxf(P0[1], P1[1]); \
        _Pragma("unroll") for (int r = 2; r < 16; r += 2) { rm = fmaxf(fmaxf(rm, P0[r]), P1[r]); rm2 = fmaxf(fmaxf(rm2, P0[r + 1]), P1[r + 1]); } \
        rm = xhalf_max(fmaxf(rm, rm2)); \
        if (__ballot(rm > THR) != 0ull) { const float dl = fmaxf(rm, 0.f); m += dl; \
            _Pragma("unroll") for (int r = 0; r < 16; ++r) { P0[r] -= dl; P1[r] -= dl; } \
            const float f = EX2(-dl); l *= f; \
            if (hi == 0) wsf[r32] = f; \
            asm volatile("s_waitcnt lgkmcnt(0)" ::: "memory"); \
            _Pragma("unroll") for (int i = 0; i < 4; ++i) { const f32x4 fr = *(const ATT_LAS f32x4*)(wsf + 8 * i + 4 * hi); \
                _Pragma("unroll") for (int j = 0; j < 4; ++j) { o[0][4 * i + j] *= fr[j]; o[1][4 * i + j] *= fr[j]; } } } } while (0)
#define ATT_EXP(P0, P1, PW) do { float sacc = 0.f; \
        _Pragma("unroll") for (int r = 0; r < 16; ++r) { P0[r] = EX2(P0[r]); P1[r] = EX2(P1[r]); sacc += P0[r] + P1[r]; } \
        l += sacc; \
        _Pragma("unroll") for (int i = 0; i < 4; ++i) { PW[0][i] = cvtpk(P0[2 * i], P0[2 * i + 1]); PW[1][i] = cvtpk(P0[8 + 2 * i], P0[9 + 2 * i]); PW[2][i] = cvtpk(P1[2 * i], P1[2 * i + 1]); PW[3][i] = cvtpk(P1[8 + 2 * i], P1[9 + 2 * i]); } } while (0)
#define ATT_PV(D0, VF, PW) do { \
        _Pragma("unroll") for (int ks = 0; ks < 4; ++ks) o[D0] = __builtin_amdgcn_mfma_f32_32x32x16_bf16(__builtin_bit_cast(bf16x8, PW[ks]), VF[ks], o[D0], 0, 0, 0); } while (0)
    bool actC, pick0; ATT_ACTIVE(tlo, actC, pick0);
    if (actC) { bf16x8 kf0_[8]; ATT_LDK(tlo, kf0_); ATT_QK(kf0_, p0, p1, pick0); ATT_MOD(tlo, p0, p1); if (hb == 1) ATT_EXP(p0, p1, pw); }
    for (int t = tlo; t < NT; ++t) {
        const bool more1 = t + 1 < NT, more3 = t + 3 < NT;
        if (more3) ATT_ISSUE(t + 3);
        bool actN = false, pickN = true; if (more1) ATT_ACTIVE(t + 1, actN, pickN);
        bf16x8 kf[8], vf[4], vg[4];
        if (actC) ATT_LDV(t, 0, vf);
        __builtin_amdgcn_sched_barrier(0);
        if (hb == 0) { if (actC) ATT_EXP(p0, p1, pw); }
        if (actN) { ATT_LDK(t + 1, kf); ATT_QK(kf, p0, p1, pickN); }
        if (actC) { ATT_LDV(t, 1, vg); __builtin_amdgcn_sched_barrier(0); ATT_PV(0, vf, pw); ATT_PV(1, vg, pw); }
        if (actN) { ATT_MOD(t + 1, p0, p1); if (hb == 1) ATT_EXP(p0, p1, pw); }
        if (more3) { if (TYPE == T_D) ATT_BAR(3); else ATT_BAR(2); }
        else ATT_BAR(0);
        actC = actN;
    }
#undef ATT_BAR
#undef ATT_ACTIVE
#undef ATT_QK
#undef ATT_LDK
#undef ATT_LDV
#undef ATT_MOD
#undef ATT_EXP
#undef ATT_PV
    l = xhalf_sum(l);
    if (BAND) l += EX2(sink2 - m);
    if (hi == 0) wsf[32 + r32] = 1.0f / l;
    asm volatile("s_waitcnt lgkmcnt(0)" ::: "memory");
    {   ATT_LAS bf16* stg = (ATT_LAS bf16*)(lds + L_OST) + wid * 2048;
#pragma unroll
        for (int i = 0; i < 4; ++i) { const f32x4 rl = *(const ATT_LAS f32x4*)(wsf + 32 + 8 * i + 4 * hi);
#pragma unroll
            for (int j = 0; j < 4; ++j) { const int orow = 8 * i + 4 * hi + j;
#pragma unroll
                for (int d0 = 0; d0 < 2; ++d0) { const unsigned w = cvtpk(o[d0][4 * i + j] * rl[j], 0.f); stg[orow * 64 + d0 * 32 + r32] = (bf16)(w & 0xffffu); } } }
        asm volatile("s_waitcnt lgkmcnt(0)" ::: "memory");
#pragma unroll
        for (int i = 0; i < 4; ++i) { const int row = i * 8 + (lane >> 3), ch = lane & 7; const u32x4 v = *(const ATT_LAS u32x4*)(stg + row * 64 + ch * 8);
            *(u32x4*)(outp + (rowbase + (size_t)(qfw + row) * DIL) * ldo + ch * 8) = v; }
    }
    if (BAND) { if (lse_out != nullptr && hi == 0) lse_out[(rowbase + (size_t)(qfw + r32) * DIL) * 4] = m + __builtin_amdgcn_logf(l); }
    __syncthreads();
#undef ATT_ISSUE
}
}

namespace att2 {
#define A2_LAS __attribute__((address_space(3)))
typedef att::bf16x8 bf16x8; typedef att::s16x4 s16x4; typedef att::f32x16 f32x16; typedef att::f32x4 f32x4; typedef att::u32x4 u32x4; typedef unsigned short bf16;
enum { T_B = 1, T_D = 3 };
constexpr int S = 4096, QP = 2816, NW = 8, QBLK = 32, QB = 256, KVBLK = 64;
constexpr int NSLOT = 3, SLOTB = 8192;
constexpr int L_K = 0, L_V = NSLOT * SLOTB, L_WS = 2 * NSLOT * SLOTB, L_OST = L_WS + NW * 64 * 4, L_TAB = L_OST + NW * 4096, TAB_N = 5600, TAB_PADN = 96, L_KM = L_TAB + (TAB_N + TAB_PADN) * 4, L_END = L_KM + 4096;
static_assert(L_TAB % 16 == 0 && L_KM % 16 == 0 && L_END <= 131072, "attention engine 2 LDS map");
constexpr float THR = 8.0f;
typedef A2_LAS const char* lds_cptr;
#define A2_MX3(a, b, c) __builtin_fmaxf(__builtin_fmaxf((a), (b)), (c))
__device__ __forceinline__ void kload8(bf16x8* kf, lds_cptr kp) {
    kf[0] = *(const A2_LAS bf16x8*)(kp);        kf[1] = *(const A2_LAS bf16x8*)(kp + 512);  kf[2] = *(const A2_LAS bf16x8*)(kp + 2048); kf[3] = *(const A2_LAS bf16x8*)(kp + 2560);
    kf[4] = *(const A2_LAS bf16x8*)(kp + 4096); kf[5] = *(const A2_LAS bf16x8*)(kp + 4608); kf[6] = *(const A2_LAS bf16x8*)(kp + 6144); kf[7] = *(const A2_LAS bf16x8*)(kp + 6656);
}
__device__ __forceinline__ void kload2(bf16x8* kf, lds_cptr kp, int j) { kf[2 * j] = *(const A2_LAS bf16x8*)(kp + j * 2048); kf[2 * j + 1] = *(const A2_LAS bf16x8*)(kp + j * 2048 + 512); }
#define A2_SBAR() __builtin_amdgcn_sched_barrier(0)
#define A2_WAIT_BAR(N) asm volatile("s_waitcnt vmcnt(" #N ") lgkmcnt(0)\n\ts_barrier" ::: "memory")
#define A2_MFMA(a, b, c) __builtin_amdgcn_mfma_f32_32x32x16_bf16(a, b, c, 0, 0, 0)

template <int TYPE>
__device__ __forceinline__ void attn_unit2(A2_LAS unsigned char* lds, const bf16* qkv, int b, int h, int qb, const float* tabg, int tab_id, int& cur_tab, const float* c2bh, const unsigned* nrm, const float* kmbh,
                                           bf16* outp, int ldo) {
    int tid_ = threadIdx.x; asm volatile("" : "+v"(tid_));
    const int tid = tid_, lane = tid & 63, r32 = lane & 31, hi = lane >> 5; const int wid = __builtin_amdgcn_readfirstlane(tid >> 6);
    const int qcol = (TYPE == T_B ? 768 : 2048) + 64 * h, kcol = (TYPE == T_B ? 1024 : 2304) + 64 * h, vcol = (TYPE == T_B ? 1280 : 2560) + 64 * h;
    const size_t rowbase = (size_t)b * S; const int q0 = QB * qb, qrel = wid * QBLK + r32, qrow = q0 + qrel;
    int tlo = 0;
    if (TYPE == T_D) {
        const float qm = __uint_as_float(nrm[0]) + __uint_as_float(nrm[1]), kmx = __uint_as_float(nrm[2]) + __uint_as_float(nrm[3]);
        const float bound = 2.0f * sqrtf(qm * kmx) * 1.01f + 42.0f;
        const float c0 = c2bh[q0];
        const bool skip = (lane < 4 * qb) && (c0 - c2bh[64 * (lane < 4 * qb ? lane : 0) + 63] < -bound);
        tlo = __builtin_popcountll(__ballot(skip)) & ~1;
    }
    const int NT = 4 * (qb + 1) - tlo, key0 = 64 * tlo;
    A2_LAS float* tab = (A2_LAS float*)(lds + L_TAB);
    A2_LAS float* km = (A2_LAS float*)(lds + L_KM);
    A2_LAS float* wsf = (A2_LAS float*)(lds + L_WS) + wid * 64;
    const unsigned lds0 = (unsigned)(uintptr_t)lds;
    if (TYPE == T_B) { if (tab_id != cur_tab) { cur_tab = tab_id; for (int i = tid; i < TAB_N + TAB_PADN; i += 512) tab[i] = (i < 4096) ? tabg[4095 - i] : (i < TAB_N ? 0.f : -INFINITY); }
        for (int i = tid; i < 16 * 64; i += 512) km[i] = kmbh[i]; }
    else { cur_tab = -1; for (int i = tid; i < NT * 64; i += 512) tab[i] = c2bh[key0 + i]; }
    const bf16* ksrc = qkv + (rowbase + key0 + lane) * QP + kcol + wid * 8;
    const bf16* vsrc = qkv + (rowbase + key0 + 16 * (wid & 3) + (lane >> 2)) * QP + vcol + (wid >> 2) * 32 + (lane & 3) * 8;
    const unsigned kdst = lds0 + L_K + wid * 1024, vdst = lds0 + L_V + wid * 1024;
#define A2_DMA_K(t, slot) att::glds16(ksrc + (size_t)(t) * KVBLK * QP, (unsigned)__builtin_amdgcn_readfirstlane(kdst + (slot)))
#define A2_DMA_V(t, slot) att::glds16(vsrc + (size_t)(t) * KVBLK * QP, (unsigned)__builtin_amdgcn_readfirstlane(vdst + (slot)))
    const lds_cptr shm3 = (lds_cptr)lds; const lds_cptr kp0 = shm3 + L_K + hi * 1024 + r32 * 16; const lds_cptr vp0 = shm3 + L_V + ((lane >> 4) & 1) * 32 + (lane & 3) * 8 + (4 * hi + ((lane & 15) >> 2)) * 64;
    bf16x8 kf[8];
    A2_DMA_K(0, 0); A2_DMA_V(0, 0); A2_DMA_K(1, SLOTB);
    bf16x8 qr[4];
    { const bf16* qp = qkv + (rowbase + qrow) * QP + qcol;
#pragma unroll
      for (int d0 = 0; d0 < 4; ++d0) qr[d0] = *(const bf16x8*)(qp + d0 * 16 + hi * 8); }
    const float cq = (TYPE == T_D) ? c2bh[qrow] : 0.f;
    float mhat = 0.f, l_reg = 0.f; f32x16 o[2]; o[0] = f32x16{}; o[1] = f32x16{};
    bool resc = false;
    A2_DMA_K(2, 2 * SLOTB);
    A2_WAIT_BAR(3);
    unsigned sel = 0u;
    if (TYPE == T_B) {
        float g[16];
#pragma unroll
        for (int n = 0; n < 16; ++n) { g[n] = -INFINITY; if (n < qb) { float s = 0.f;
#pragma unroll
                for (int d0 = 0; d0 < 4; ++d0) { const f32x4 a = *(const A2_LAS f32x4*)(km + n * 64 + 16 * d0 + 8 * hi), c = *(const A2_LAS f32x4*)(km + n * 64 + 16 * d0 + 8 * hi + 4);
                    const bf16x8 qv = qr[d0];
                    s = fmaf(__builtin_bit_cast(float, (unsigned)(unsigned short)qv[0] << 16), a[0], s); s = fmaf(__builtin_bit_cast(float, (unsigned)(unsigned short)qv[1] << 16), a[1], s);
                    s = fmaf(__builtin_bit_cast(float, (unsigned)(unsigned short)qv[2] << 16), a[2], s); s = fmaf(__builtin_bit_cast(float, (unsigned)(unsigned short)qv[3] << 16), a[3], s);
                    s = fmaf(__builtin_bit_cast(float, (unsigned)(unsigned short)qv[4] << 16), c[0], s); s = fmaf(__builtin_bit_cast(float, (unsigned)(unsigned short)qv[5] << 16), c[1], s);
                    s = fmaf(__builtin_bit_cast(float, (unsigned)(unsigned short)qv[6] << 16), c[2], s); s = fmaf(__builtin_bit_cast(float, (unsigned)(unsigned short)qv[7] << 16), c[3], s); }
                g[n] = att::xhalf_sum(s); } }
#pragma unroll
        for (int r = 0; r < 3; ++r) { float best = -INFINITY; int bi = -1;
#pragma unroll
            for (int n = 0; n < 16; ++n) if (n < qb && !((sel >> n) & 1u) && g[n] > best) { best = g[n]; bi = n; }
            if (bi >= 0) sel |= 1u << bi; }
    }
#define A2_CB(tau, CB0, CB1) do { const float base_ = cq - mhat; \
        if (TYPE == T_D) { const A2_LAS float* cp_ = tab + 64 * (tau) + 4 * hi; \
            _Pragma("unroll") for (int r = 0; r < 16; ++r) { CB0[r] = base_ - cp_[att::offr(r)]; CB1[r] = base_ - cp_[att::offr(r) + 32]; } \
        } else { const int k0_ = key0 + 64 * (tau); const bool pick_ = (k0_ < q0) ? ((sel >> (k0_ >> 8)) & 1u) : true; \
            const A2_LAS float* tb_ = pick_ ? tab + (4095 - (qrow - k0_ - 4 * hi)) : tab + TAB_N; \
            _Pragma("unroll") for (int r = 0; r < 16; ++r) { CB0[r] = tb_[att::offr(r)] + base_; CB1[r] = tb_[att::offr(r) + 32] + base_; } } } while (0)
#define A2_CMASK(P0, P1, t) do { const int jb_ = (t) - (NT - 4); if (jb_ >= 0) { const int kb_ = 64 * jb_ + 4 * hi; \
        _Pragma("unroll") for (int r = 0; r < 16; ++r) { const int kv_ = kb_ + att::offr(r); if (kv_ > qrel) P0[r] = -INFINITY; if (kv_ + 32 > qrel) P1[r] = -INFINITY; } } } while (0)
#define A2_DECIDE(C0, C1) do { float a_ = A2_MX3(C0[0], C0[1], C1[0]), b_ = A2_MX3(C0[2], C0[3], C1[1]); a_ = A2_MX3(a_, C1[2], C1[3]); \
        _Pragma("unroll") for (int r = 4; r < 16; r += 4) { a_ = A2_MX3(a_, C0[r], C0[r + 1]); b_ = A2_MX3(b_, C0[r + 2], C0[r + 3]); a_ = A2_MX3(a_, C1[r], C1[r + 1]); b_ = A2_MX3(b_, C1[r + 2], C1[r + 3]); } \
        const float rm_ = att::xhalf_max(__builtin_fmaxf(a_, b_)); \
        resc = false; \
        if (__builtin_expect(__ballot(rm_ > THR) != 0ull, 0)) { const float dl_ = __builtin_fmaxf(rm_, 0.f); mhat += dl_; \
            _Pragma("unroll") for (int r = 0; r < 16; ++r) { C0[r] -= dl_; C1[r] -= dl_; } \
            const float f_ = EX2(-dl_); l_reg *= f_; if (hi == 0) wsf[r32] = f_; resc = true; } } while (0)
#define A2_RESC() do { if (resc) { asm volatile("s_waitcnt lgkmcnt(0)" ::: "memory"); \
        _Pragma("unroll") for (int i = 0; i < 4; ++i) { const f32x4 fr_ = *(const A2_LAS f32x4*)(wsf + 8 * i + 4 * hi); \
            _Pragma("unroll") for (int j = 0; j < 4; ++j) { o[0][4 * i + j] *= fr_[j]; o[1][4 * i + j] *= fr_[j]; } } } } while (0)
    f32x16 pA0, pA1, pB0, pB1;
    int sl_prev = 0, sl_cur = 0, sl_next = SLOTB;
#define A2_ROT() do { sl_prev = sl_cur; sl_cur = sl_next; sl_next = (sl_next == (NSLOT - 1) * SLOTB) ? 0 : sl_next + SLOTB; } while (0)
    { A2_CB(0, pA0, pA1); kload8(kf, kp0);
#pragma unroll
      for (int d0 = 0; d0 < 4; ++d0) { pA0 = A2_MFMA(kf[2 * d0], qr[d0], pA0); pA1 = A2_MFMA(kf[2 * d0 + 1], qr[d0], pA1); } }
    A2_CMASK(pA0, pA1, 0);
    A2_DECIDE(pA0, pA1);
#pragma unroll
    for (int r = 0; r < 16; ++r) { pA0[r] = EX2(pA0[r]); pA1[r] = EX2(pA1[r]); }
    A2_WAIT_BAR(0);
    A2_RESC();
    A2_DMA_K(3, 0); A2_DMA_V(1, SLOTB);
    A2_ROT();
    kload8(kf, kp0 + sl_cur);
    A2_WAIT_BAR(2);
    s16x4 vlo[8], vhi[8]; u32x4 pw0, pw1, pw2, pw3;
#define A2_PKW(P, B) att::cvtpk(P[B], P[B + 1])
#define A2_PAF(k) __builtin_bit_cast(bf16x8, pw##k)
#define A2_VFR(i) (bf16x8){vlo[i][0], vlo[i][1], vlo[i][2], vlo[i][3], vhi[i][0], vhi[i][1], vhi[i][2], vhi[i][3]}
#define A2_PIN(x) asm volatile("" : "+v"(x))
#define A2_GAPA(MF, A0, A1, A2, A3, W0, W1, PW) do { MF; sacc += A0; sacc += A1; sacc += A2; sacc += A3; A2_PIN(sacc); W0; W1; A2_PIN(PW); A2_SBAR(); } while (0)
#define A2_GAPB(MF, X, B) do { MF; X[B] = EX2(X[B]); X[B + 1] = EX2(X[B + 1]); X[B + 2] = EX2(X[B + 2]); X[B + 3] = EX2(X[B + 3]); A2_PIN(X); A2_SBAR(); } while (0)
#define A2_VRD(i) do { vlo[i] = att::vtr(vp_ + (((i) >> 2) * 4096 + ((i) & 3) * 1024)); vhi[i] = att::vtr(vp_ + (((i) >> 2) * 4096 + ((i) & 3) * 1024 + 512)); } while (0)
#define A2_KRD(G, j) do { if (G) { kload2(kf, kp0 + sl_next, j); A2_SBAR(); } } while (0)
#define A2_STEP(C0, C1, P0, P1, t, GK, GV, GL, MASKED) do { A2_SBAR(); \
        A2_CB(t, C0, C1); A2_SBAR();     \
        const lds_cptr vp_ = vp0 + sl_prev; \
        A2_VRD(0); A2_SBAR(); float sacc = (P0[0] + P0[1]); \
        A2_GAPA(C0 = A2_MFMA(kf[0], qr[0], C0), P0[2], P0[3], P0[4], P0[5],     pw0[0] = A2_PKW(P0, 0),  pw0[1] = A2_PKW(P0, 2),  pw0); \
        A2_VRD(4); A2_SBAR(); A2_GAPA(C1 = A2_MFMA(kf[1], qr[0], C1), P0[6], P0[7], P0[8], P0[9],     pw0[2] = A2_PKW(P0, 4),  pw0[3] = A2_PKW(P0, 6),  pw0); \
        A2_VRD(1); A2_SBAR(); A2_GAPA(C0 = A2_MFMA(kf[2], qr[1], C0),   P0[10], P0[11], P0[12], P0[13], pw1[0] = A2_PKW(P0, 8),  pw1[1] = A2_PKW(P0, 10), pw1); \
        A2_VRD(5); A2_SBAR(); A2_GAPA(C1 = A2_MFMA(kf[3], qr[1], C1),   P0[14], P0[15], P1[0], P1[1],   pw1[2] = A2_PKW(P0, 12), pw1[3] = A2_PKW(P0, 14), pw1); \
        A2_VRD(2); A2_SBAR(); A2_GAPA(C0 = A2_MFMA(kf[4], qr[2], C0),   P1[2], P1[3], P1[4], P1[5],     pw2[0] = A2_PKW(P1, 0),  pw2[1] = A2_PKW(P1, 2),  pw2); \
        A2_VRD(6); A2_SBAR(); A2_GAPA(C1 = A2_MFMA(kf[5], qr[2], C1),   P1[6], P1[7], P1[8], P1[9],     pw2[2] = A2_PKW(P1, 4),  pw2[3] = A2_PKW(P1, 6),  pw2); \
        A2_VRD(3); A2_SBAR(); A2_GAPA(C0 = A2_MFMA(kf[6], qr[3], C0),   P1[10], P1[11], P1[12], P1[13], pw3[0] = A2_PKW(P1, 8),  pw3[1] = A2_PKW(P1, 10), pw3); \
        A2_VRD(7); A2_SBAR(); A2_GAPA(C1 = A2_MFMA(kf[7], qr[3], C1),   P1[14], P1[15], 0.f, 0.f,       pw3[2] = A2_PKW(P1, 12), pw3[3] = A2_PKW(P1, 14), pw3); \
        l_reg += sacc; \
        if (GK) { A2_DMA_K((t) + 3, sl_cur); } if (GV) { A2_DMA_V((t) + 1, sl_next); } \
        if (MASKED) A2_CMASK(C0, C1, t); \
        A2_DECIDE(C0, C1); \
        A2_SBAR(); \
        A2_GAPB(o[0] = A2_MFMA(A2_PAF(0), A2_VFR(0), o[0]), C0, 0); \
        A2_GAPB(o[1] = A2_MFMA(A2_PAF(0), A2_VFR(4), o[1]), C0, 4); \
        A2_KRD(GL, 0); A2_GAPB(o[0] = A2_MFMA(A2_PAF(1), A2_VFR(1), o[0]), C0, 8); \
        A2_KRD(GL, 1); A2_GAPB(o[1] = A2_MFMA(A2_PAF(1), A2_VFR(5), o[1]), C0, 12); \
        A2_KRD(GL, 2); A2_GAPB(o[0] = A2_MFMA(A2_PAF(2), A2_VFR(2), o[0]), C1, 0); \
        A2_KRD(GL, 3); A2_GAPB(o[1] = A2_MFMA(A2_PAF(2), A2_VFR(6), o[1]), C1, 4); \
        A2_GAPB(o[0] = A2_MFMA(A2_PAF(3), A2_VFR(3), o[0]), C1, 8); \
        A2_GAPB(o[1] = A2_MFMA(A2_PAF(3), A2_VFR(7), o[1]), C1, 12); \
    } while (0)
    int t = 1;
    for (; t + 5 < NT; t += 2) {
        A2_STEP(pB0, pB1, pA0, pA1, t, true, true, true, false);     A2_WAIT_BAR(2); A2_RESC(); A2_ROT();
        A2_STEP(pA0, pA1, pB0, pB1, t + 1, true, true, true, false); A2_WAIT_BAR(2); A2_RESC(); A2_ROT();
    }
#define A2_ENDW(tt) do { if ((tt) + 3 < NT) { A2_WAIT_BAR(2); } else if ((tt) + 2 < NT) { A2_WAIT_BAR(1); } else { A2_WAIT_BAR(0); } } while (0)
    for (; t + 1 < NT; t += 2) {
        A2_STEP(pB0, pB1, pA0, pA1, t, (t + 3 < NT), (t + 1 < NT), (t + 1 < NT), true);         A2_ENDW(t);     A2_RESC(); A2_ROT();
        A2_STEP(pA0, pA1, pB0, pB1, t + 1, (t + 4 < NT), (t + 2 < NT), (t + 2 < NT), true);     A2_ENDW(t + 1); A2_RESC(); A2_ROT();
    }
    A2_STEP(pB0, pB1, pA0, pA1, NT - 1, false, false, false, true); A2_RESC();
    { float sacc = pB0[0] + pB0[1];
#pragma unroll
      for (int r = 2; r < 16; ++r) sacc += pB0[r];
#pragma unroll
      for (int r = 0; r < 16; ++r) sacc += pB1[r];
      l_reg += sacc;
      pw0 = (u32x4){A2_PKW(pB0, 0), A2_PKW(pB0, 2), A2_PKW(pB0, 4), A2_PKW(pB0, 6)}; pw1 = (u32x4){A2_PKW(pB0, 8), A2_PKW(pB0, 10), A2_PKW(pB0, 12), A2_PKW(pB0, 14)};
      pw2 = (u32x4){A2_PKW(pB1, 0), A2_PKW(pB1, 2), A2_PKW(pB1, 4), A2_PKW(pB1, 6)}; pw3 = (u32x4){A2_PKW(pB1, 8), A2_PKW(pB1, 10), A2_PKW(pB1, 12), A2_PKW(pB1, 14)};
      A2_SBAR();
      const lds_cptr vp_ = vp0 + sl_cur;
#pragma unroll
      for (int i = 0; i < 8; ++i) A2_VRD(i);
      o[0] = A2_MFMA(A2_PAF(0), A2_VFR(0), o[0]); o[0] = A2_MFMA(A2_PAF(1), A2_VFR(1), o[0]); o[0] = A2_MFMA(A2_PAF(2), A2_VFR(2), o[0]); o[0] = A2_MFMA(A2_PAF(3), A2_VFR(3), o[0]);
      o[1] = A2_MFMA(A2_PAF(0), A2_VFR(4), o[1]); o[1] = A2_MFMA(A2_PAF(1), A2_VFR(5), o[1]); o[1] = A2_MFMA(A2_PAF(2), A2_VFR(6), o[1]); o[1] = A2_MFMA(A2_PAF(3), A2_VFR(7), o[1]); }
    l_reg = att::xhalf_sum(l_reg);
    if (hi == 0) wsf[32 + r32] = 1.0f / l_reg;
    asm volatile("s_waitcnt lgkmcnt(0)" ::: "memory");
    {   A2_LAS bf16* stg = (A2_LAS bf16*)(lds + L_OST) + wid * 2048;
#pragma unroll
        for (int i = 0; i < 4; ++i) { const f32x4 rl = *(const A2_LAS f32x4*)(wsf + 32 + 8 * i + 4 * hi);
#pragma unroll
            for (int j = 0; j < 4; ++j) { const int orow = 8 * i + 4 * hi + j;
#pragma unroll
                for (int d0 = 0; d0 < 2; ++d0) { const unsigned w = att::cvtpk(o[d0][4 * i + j] * rl[j], 0.f); stg[orow * 64 + d0 * 32 + r32] = (bf16)(w & 0xffffu); } } }
        asm volatile("s_waitcnt lgkmcnt(0)" ::: "memory");
#pragma unroll
        for (int i = 0; i < 4; ++i) { const int row = i * 8 + (lane >> 3), ch = lane & 7; const u32x4 v = *(const A2_LAS u32x4*)(stg + row * 64 + ch * 8);
            *(u32x4*)(outp + (rowbase + q0 + wid * QBLK + row) * ldo + ch * 8) = v; }
    }
    asm volatile("s_waitcnt lgkmcnt(0)\n\ts_barrier" ::: "memory");
#undef A2_DMA_K
#undef A2_DMA_V
#undef A2_CB
#undef A2_CMASK
#undef A2_DECIDE
#undef A2_RESC
#undef A2_ROT
#undef A2_PKW
#undef A2_PAF
#undef A2_VFR
#undef A2_PIN
#undef A2_GAPA
#undef A2_GAPB
#undef A2_VRD
#undef A2_KRD
#undef A2_STEP
#undef A2_ENDW
}
}

namespace att3 {
#define A3_LAS __attribute__((address_space(3)))
typedef att::bf16x8 bf16x8; typedef att::s16x4 s16x4; typedef att::f32x16 f32x16; typedef att::f32x4 f32x4; typedef att::u32x4 u32x4; typedef unsigned short bf16;
constexpr int S = 4096, QP = 2816, SLOTB = 8192;
constexpr int L_K = 0, L_V = 6 * SLOTB, L_WS = 12 * SLOTB, L_TAB = L_WS + 2048, TAB_N = 5600, L_END = L_TAB + TAB_N * 4;
static_assert(L_TAB % 16 == 0 && L_END <= 131072, "attention engine 3 LDS map");
#define A3_MFMA(a, b, c) __builtin_amdgcn_mfma_f32_32x32x16_bf16(a, b, c, 0, 0, 0)

struct BandSrc { const bf16* k; const bf16* v; int rs, kw, tmin; };
__device__ __forceinline__ void band_dma(unsigned lds_region, const bf16* src, int rs, int kw, int tmin, bool isV, int wid, int lane) {
    for (int t = tmin; t < 6; ++t) { const int k0 = kw + 64 * t;
        if (!isV) att::glds16(src + (size_t)(k0 + lane) * rs + wid * 8, (unsigned)__builtin_amdgcn_readfirstlane(lds_region + t * SLOTB + wid * 1024));
        else att::glds16(src + (size_t)(k0 + 16 * (wid & 3) + (lane >> 2)) * rs + (wid >> 2) * 32 + (lane & 3) * 8, (unsigned)__builtin_amdgcn_readfirstlane(lds_region + t * SLOTB + wid * 1024)); }
}
#define A3_WAITV(n4, n6) do { if (n4) asm volatile("s_waitcnt vmcnt(4)" ::: "memory"); else if (n6) asm volatile("s_waitcnt vmcnt(6)" ::: "memory"); else asm volatile("s_waitcnt vmcnt(0)" ::: "memory"); } while (0)
template <int DIL>
__device__ __forceinline__ void attn_band(A3_LAS unsigned char* lds, const bf16* qkv, int b, int h, int qb, int res, int W, int qcol, int kcol, int vcol,
                                          const float* tabg, int tab_id, int& cur_tab, float sink2, bf16* outp, int ldo, float* lse_out, const BandSrc nx, const bool nxt) {
    int tid_ = threadIdx.x; asm volatile("" : "+v"(tid_));
    const int tid = tid_, lane = tid & 63, r32 = lane & 31, hi = lane >> 5; const int wid = __builtin_amdgcn_readfirstlane(tid >> 6);
    const size_t rowbase = (size_t)b * S + res;
    const int q0 = 256 * qb, kw = q0 - 128, tmin = (qb == 0) ? 2 : 0, ta = wid >> 1;
    A3_LAS float* tab = (A3_LAS float*)(lds + L_TAB);
    A3_LAS float* wsf = (A3_LAS float*)(lds + L_WS) + wid * 64;
    const unsigned lds0 = (unsigned)(uintptr_t)lds;
    if (tab_id != cur_tab) { cur_tab = tab_id; for (int i = tid; i < TAB_N; i += 512) tab[i] = (i < 4096 && 4095 - i <= W * DIL) ? tabg[4095 - i] : -INFINITY; }
    const int qfw = q0 + 32 * wid;
    bf16x8 qr[4];
    { const bf16* qrow = qkv + (rowbase + (size_t)(qfw + r32) * DIL) * QP + qcol;
#pragma unroll
      for (int d0 = 0; d0 < 4; ++d0) qr[d0] = *(const bf16x8*)(qrow + 16 * d0 + 8 * hi); }
    A3_WAITV(tmin == 2, tmin == 0);
    __syncthreads();
    f32x16 p[3][2];
#pragma unroll
    for (int i = 0; i < 3; ++i) {
        const int t = ta + i;
        if (t >= tmin) {
            const A3_LAS char* kb = (const A3_LAS char*)(lds + L_K + t * SLOTB) + hi * 1024 + r32 * 16;
            f32x16& a0 = p[i][0]; f32x16& a1 = p[i][1];
#pragma unroll
            for (int d0 = 0; d0 < 4; ++d0) { const bf16x8 b0 = *(const A3_LAS bf16x8*)(kb + d0 * 2048), b1 = *(const A3_LAS bf16x8*)(kb + d0 * 2048 + 512);
                if (d0 == 0) { a0 = A3_MFMA(b0, qr[0], f32x16{}); a1 = A3_MFMA(b1, qr[0], f32x16{}); } else { a0 = A3_MFMA(b0, qr[d0], a0); a1 = A3_MFMA(b1, qr[d0], a1); } }
            const int d0l = qfw + r32 - (kw + 64 * t) - 4 * hi;
            const A3_LAS float* tb = tab + (4095 - DIL * d0l);
#pragma unroll
            for (int r = 0; r < 16; ++r) { a0[r] += tb[DIL * att::offr(r)]; a1[r] += tb[DIL * (att::offr(r) + 32)]; }
        }
    }
    __syncthreads();
    if (nxt) band_dma(lds0 + L_K, nx.k, nx.rs, nx.kw, nx.tmin, false, wid, lane);
    float m = -INFINITY, m2 = -INFINITY;
#pragma unroll
    for (int i = 0; i < 3; ++i) { if (ta + i >= tmin) {
#pragma unroll
        for (int r = 0; r < 16; r += 2) { m = __builtin_fmaxf(__builtin_fmaxf(m, p[i][0][r]), p[i][0][r + 1]); m2 = __builtin_fmaxf(__builtin_fmaxf(m2, p[i][1][r]), p[i][1][r + 1]); } } }
    m = __builtin_fmaxf(m, m2);
    m = att::xhalf_max(m);
    const float negm = -m;
    if (nxt) A3_WAITV(nx.tmin == 2, nx.tmin == 0); else A3_WAITV(false, false);
    __syncthreads();
    float l = 0.f; f32x16 o[2]; o[0] = f32x16{}; o[1] = f32x16{};
    const int vpo = ((lane >> 4) & 1) * 32 + (lane & 3) * 8 + (4 * hi + ((lane & 15) >> 2)) * 64;
#pragma unroll
    for (int i = 0; i < 3; ++i) {
        const int t = ta + i;
        if (t >= tmin) {
            float sacc = 0.f;
#pragma unroll
            for (int r = 0; r < 16; ++r) { p[i][0][r] = EX2(p[i][0][r] + negm); p[i][1][r] = EX2(p[i][1][r] + negm); sacc += p[i][0][r] + p[i][1][r]; }
            l += sacc;
            u32x4 pw[4];
#pragma unroll
            for (int j = 0; j < 4; ++j) { pw[0][j] = att::cvtpk(p[i][0][2 * j], p[i][0][2 * j + 1]); pw[1][j] = att::cvtpk(p[i][0][8 + 2 * j], p[i][0][9 + 2 * j]); pw[2][j] = att::cvtpk(p[i][1][2 * j], p[i][1][2 * j + 1]); pw[3][j] = att::cvtpk(p[i][1][8 + 2 * j], p[i][1][9 + 2 * j]); }
            const A3_LAS char* vp = (const A3_LAS char*)(lds + L_V + t * SLOTB) + vpo;
#pragma unroll
            for (int d0 = 0; d0 < 2; ++d0)
#pragma unroll
                for (int ks = 0; ks < 4; ++ks) { const s16x4 lo = att::vtr(vp + d0 * 4096 + ks * 1024), hh = att::vtr(vp + d0 * 4096 + ks * 1024 + 512);
                    const bf16x8 vf = (bf16x8){lo[0], lo[1], lo[2], lo[3], hh[0], hh[1], hh[2], hh[3]};
                    o[d0] = A3_MFMA(__builtin_bit_cast(bf16x8, pw[ks]), vf, o[d0]); }
        }
    }
    l = att::xhalf_sum(l);
    l += EX2(sink2 - m);
    if (hi == 0) wsf[32 + r32] = 1.0f / l;
    __syncthreads();
    {   A3_LAS bf16* stg = (A3_LAS bf16*)(lds + L_V) + wid * 2048;
#pragma unroll
        for (int i = 0; i < 4; ++i) { const f32x4 rl = *(const A3_LAS f32x4*)(wsf + 32 + 8 * i + 4 * hi);
#pragma unroll
            for (int j = 0; j < 4; ++j) { const int orow = 8 * i + 4 * hi + j;
#pragma unroll
                for (int d0 = 0; d0 < 2; ++d0) { const unsigned w = att::cvtpk(o[d0][4 * i + j] * rl[j], 0.f); stg[orow * 64 + d0 * 32 + r32] = (bf16)(w & 0xffffu); } } }
        asm volatile("s_waitcnt lgkmcnt(0)" ::: "memory");
#pragma unroll
        for (int i = 0; i < 4; ++i) { const int row = i * 8 + (lane >> 3), ch = lane & 7; const u32x4 v = *(const A3_LAS u32x4*)(stg + row * 64 + ch * 8);
            *(u32x4*)(outp + (rowbase + (size_t)(qfw + row) * DIL) * ldo + ch * 8) = v; }
    }
    if (lse_out != nullptr && hi == 0) lse_out[(rowbase + (size_t)(qfw + r32) * DIL) * 4] = m + __builtin_amdgcn_logf(l);
    asm volatile("s_waitcnt lgkmcnt(0)" ::: "memory"); __syncthreads();
    if (nxt) band_dma(lds0 + L_V, nx.v, nx.rs, nx.kw, nx.tmin, true, wid, lane);
}
}

#ifndef PG8_SP2
#define PG8_SP2 true
#endif
#ifndef PG8_ALIGN
#define PG8_ALIGN true
#endif

constexpr int NWAVES = 8;
constexpr int NB = 8, S = 4096, DM = 1024, M = NB * S, HD = 64, QP = 2816, NIN = 2820, DFF = 2816, NGU = 5632, DEPTH = 2;
constexpr float LOG2E = 1.4426950408889634f, C2 = 0.125f * LOG2E, EPS = 1e-6f;
constexpr int C_QA = 0, C_KA = 256, C_VA = 512, C_QB = 768, C_KB = 1024, C_VB = 1280, C_QC = 1536, C_KC = 1792, C_VC = 1920, C_QD = 2048, C_KD = 2304, C_VD = 2560;
constexpr int NPHASE = 14, PH_PER_LAYER = 6;
constexpr int N_LAUNCHES = MK_N_LAUNCHES;

constexpr size_t MiB = 1u << 20;
constexpr size_t WS_CTL = 0, CTL_ZERO_BYTES = 1 * MiB;
constexpr size_t WS_WIN = 1 * MiB;
constexpr size_t WS_WOUT = 12 * MiB;
constexpr size_t WS_WGU = 16 * MiB;
constexpr size_t WS_WDN = 38 * MiB;
constexpr size_t WS_SMALL = 49 * MiB;
constexpr size_t WS_WFD = WS_SMALL;
constexpr size_t WS_BIAST = WS_SMALL + 64 * 1024;
constexpr size_t WS_RSTD = WS_SMALL + 256 * 1024;
constexpr size_t WS_LF = WS_SMALL + 512 * 1024;
constexpr size_t WS_C2 = WS_SMALL + 1024 * 1024;
constexpr size_t WS_KMEAN = WS_SMALL + 1536 * 1024;
constexpr size_t WS_XB = 52 * MiB;
constexpr size_t WS_MIX = 116 * MiB;
constexpr size_t WS_QKV = 180 * MiB;
constexpr size_t WS_PA = 356 * MiB;
constexpr size_t WS_LSE = 404 * MiB;
constexpr size_t WS_SS = 406 * MiB;
constexpr size_t WS_FD = 408 * MiB;
constexpr size_t WS_X8 = 416 * MiB;
constexpr size_t WS_END = 448 * MiB;
constexpr float WSCALE = 64.0f, ASCALE = 8.0f;
constexpr int CW_BAR = 4096, CW_NORM = 16384, CW_KMEAN = 65536;
constexpr int CW_UNUSED_ = 0;

constexpr int RING_OFF = 0, RING_BYTES = 131072;
constexpr int LDSCTL_OFF = RING_BYTES, MISC_OFF = LDSCTL_OFF + 320;
constexpr int LDS_BYTES = 147456;

#define GAS __attribute__((address_space(1)))
#define LAS __attribute__((address_space(3)))
typedef unsigned short bf16;
typedef unsigned v4u __attribute__((ext_vector_type(4)));
typedef float f32x4 __attribute__((ext_vector_type(4)));
typedef GAS unsigned gu32;
#define RLX_AGENT __ATOMIC_RELAXED, __HIP_MEMORY_SCOPE_AGENT
#define LDS_WAIT() asm volatile("s_waitcnt lgkmcnt(0)" ::: "memory")
__device__ __forceinline__ unsigned f2bf(float f) { unsigned u = __builtin_bit_cast(unsigned, f); return (u + 0x7fffu + ((u >> 16) & 1u)) >> 16; }
__device__ __forceinline__ unsigned pk2(float lo, float hi) { return f2bf(lo) | (f2bf(hi) << 16); }
__device__ __forceinline__ float bflo(unsigned w) { return __builtin_bit_cast(float, w << 16); }
__device__ __forceinline__ float bfhi(unsigned w) { return __builtin_bit_cast(float, w & 0xffff0000u); }

#define XB_TMO      128
#define XB_XCNT(j)  (256  + 64 * (j))
#define XB_XSUB(j)  (1280 + 64 * (j))
#define XB_XGEN(j)  (2304 + 64 * (j))
#define XB_TOP      3328
#define XB_TOPGEN   3392
#define XCD_BAR_WORDS 3456
#define XB_SPIN_CAP (1u << 18)

__device__ __forceinline__ unsigned xb_ld(unsigned* p)              { return __hip_atomic_load(p, __ATOMIC_RELAXED, __HIP_MEMORY_SCOPE_AGENT); }
__device__ __forceinline__ unsigned xb_add(unsigned* p, unsigned v) { return __hip_atomic_fetch_add(p, v, __ATOMIC_RELAXED, __HIP_MEMORY_SCOPE_AGENT); }
__device__ __forceinline__ unsigned xb_xcc_id() { return (unsigned)__builtin_amdgcn_s_getreg((3 << 11) | 20) & 0xFu; }
#define XB_SPIN(cond, bar) do { unsigned _sp = 0; while (cond) { __builtin_amdgcn_s_sleep(1); \
    if ((++_sp & 255u) == 0u) { if (xb_ld(&(bar)[XB_TMO])) break; if (_sp > XB_SPIN_CAP) { atomicAdd(&(bar)[XB_TMO], 1u); break; } } } } while (0)

struct XcdBarrier {
    unsigned* bar; unsigned x;
    volatile LAS unsigned* st;
};

__device__ __forceinline__ XcdBarrier xcd_barrier_post(unsigned* bar, volatile LAS unsigned* st) {
    XcdBarrier b; b.bar = bar; b.x = xb_xcc_id(); b.st = st;
    if (threadIdx.x == 0) (void)xb_add(&bar[XB_XCNT(b.x)], 1u);
    return b;
}
__device__ __forceinline__ void xcd_barrier_complete(unsigned* bar, unsigned x, unsigned& nloc, unsigned& nx) {
    const unsigned G = gridDim.x * gridDim.y * gridDim.z;
    unsigned sum, cnt, mine, sp = 0u;
    for (;;) {
        sum = 0u; cnt = 0u; mine = 0u;
#pragma unroll
        for (unsigned j = 0; j < 16; ++j) { const unsigned c = xb_ld(&bar[XB_XCNT(j)]); sum += c; cnt += (c > 0u) ? 1u : 0u; mine = (j == x) ? c : mine; }
        if (sum == G) break;
        __builtin_amdgcn_s_sleep(1);
        if ((++sp & 255u) == 0u) { if (xb_ld(&bar[XB_TMO])) break; if (sp > XB_SPIN_CAP) { atomicAdd(&bar[XB_TMO], 1u); break; } }
    }
    nloc = mine > 0u ? mine : 1u; nx = cnt > 0u ? cnt : 1u;
}

__device__ __forceinline__ void xcd_barrier(const XcdBarrier& b) {
    asm volatile("s_waitcnt vmcnt(0)" ::: "memory");
    __syncthreads();
    if (threadIdx.x == 0) {
        unsigned* bar = b.bar;
        __builtin_amdgcn_s_waitcnt(0);
        unsigned nloc = b.st[0], nx = b.st[1];
        if (nloc == 0u) { xcd_barrier_complete(bar, b.x, nloc, nx); b.st[0] = nloc; b.st[1] = nx; }
        const unsigned old = xb_add(&bar[XB_XSUB(b.x)], 1u);
        const unsigned gen = old / nloc;
        if (old + 1u == (gen + 1u) * nloc) {
            __builtin_amdgcn_fence(__ATOMIC_RELEASE, "agent");
            asm volatile("s_waitcnt vmcnt(0)" ::: "memory");
            const unsigned og = xb_add(&bar[XB_TOP], 1u);
            const unsigned tg = og / nx;
            if (og + 1u == (tg + 1u) * nx) xb_add(&bar[XB_TOPGEN], 1u);
            else XB_SPIN(xb_ld(&bar[XB_TOPGEN]) == tg, bar);
            __builtin_amdgcn_fence(__ATOMIC_ACQUIRE, "agent");
            xb_add(&bar[XB_XGEN(b.x)], 1u);
            asm volatile("s_waitcnt vmcnt(0)" ::: "memory");
        } else {
            XB_SPIN(xb_ld(&bar[XB_XGEN(b.x)]) == gen, bar);
            __builtin_amdgcn_fence(__ATOMIC_ACQUIRE, "agent");
            asm volatile("s_waitcnt vmcnt(0)" ::: "memory");
        }
    }
    __syncthreads();
}


__device__ __forceinline__ float wave_sum(float v) {
#pragma unroll
    for (int o = 1; o < 64; o <<= 1) v += __shfl_xor(v, o);
    return v;
}

__device__ __forceinline__ void tr_item(const float* W, int ldw, int K, const float* g, bf16* WT, int k0, int n0, int drow0, LAS float* scr, int lane) {
    float v[32];
#pragma unroll
    for (int i = 0; i < 32; ++i) { const int kk = 2 * i + (lane >> 5); v[i] = W[(size_t)(k0 + kk) * ldw + n0 + (lane & 31)]; }
    if (g) {
#pragma unroll
        for (int i = 0; i < 32; ++i) v[i] *= g[k0 + 2 * i + (lane >> 5)];
    }
#pragma unroll
    for (int i = 0; i < 32; ++i) scr[(2 * i + (lane >> 5)) * 33 + (lane & 31)] = v[i];
    LDS_WAIT(); asm volatile("" ::: "memory");
    const int c = lane & 7;
#pragma unroll
    for (int j = 0; j < 4; ++j) { const int n = (lane >> 3) + 8 * j; const LAS float* s = scr + (8 * c) * 33 + n;
        v4u o; o.x = pk2(s[0 * 33], s[1 * 33]); o.y = pk2(s[2 * 33], s[3 * 33]); o.z = pk2(s[4 * 33], s[5 * 33]); o.w = pk2(s[6 * 33], s[7 * 33]);
        *(GAS v4u*)(WT + (size_t)(drow0 + n) * K + k0 + 8 * c) = o; }
    LDS_WAIT(); asm volatile("" ::: "memory");
}
__device__ __forceinline__ void tr_item8(const float* W, int ldw, int K, const float* g, float sc, unsigned char* WT8, int k0, int n0, int drow0, LAS float* scr, int lane) {
    float v[32];
#pragma unroll
    for (int i = 0; i < 32; ++i) { const int kk = 2 * i + (lane >> 5); v[i] = W[(size_t)(k0 + kk) * ldw + n0 + (lane & 31)]; }
#pragma unroll
    for (int i = 0; i < 32; ++i) v[i] *= g ? g[k0 + 2 * i + (lane >> 5)] * sc : sc;
#pragma unroll
    for (int i = 0; i < 32; ++i) scr[(2 * i + (lane >> 5)) * 33 + (lane & 31)] = v[i];
    LDS_WAIT(); asm volatile("" ::: "memory");
    const int c = lane & 3;
#pragma unroll
    for (int j = 0; j < 2; ++j) { const int n = (lane >> 2) + 16 * j; const LAS float* s = scr + (16 * c) * 33 + n;
        v4u o; o.x = pg8::pk4_fp8(s[0 * 33], s[1 * 33], s[2 * 33], s[3 * 33]); o.y = pg8::pk4_fp8(s[4 * 33], s[5 * 33], s[6 * 33], s[7 * 33]);
        o.z = pg8::pk4_fp8(s[8 * 33], s[9 * 33], s[10 * 33], s[11 * 33]); o.w = pg8::pk4_fp8(s[12 * 33], s[13 * 33], s[14 * 33], s[15 * 33]);
        *(GAS v4u*)(WT8 + (size_t)(drow0 + n) * K + k0 + 16 * c) = o; }
    LDS_WAIT(); asm volatile("" ::: "memory");
}
__device__ __forceinline__ int t5_bucket(int n) {
    if (n < 16) return n;
    int b = 16;
    b += (n >= 22); b += (n >= 30); b += (n >= 40); b += (n >= 54); b += (n >= 73); b += (n >= 99); b += (n >= 134); b += (n >= 182);
    b += (n >= 246); b += (n >= 332); b += (n >= 450); b += (n >= 609); b += (n >= 825); b += (n >= 1117); b += (n >= 1513);
    return b;
}

struct Ptrs {
    const float *x, *norm1_g, *w_in, *f_bias, *sinks, *mix_g, *w_out, *norm2_g, *w_gate, *w_up, *w_down, *rel_bias, *final_g;
    float* out; unsigned char* ws;
};

__device__ __forceinline__ void phase_prep(const Ptrs& P, LAS unsigned char* lds, int it_lo, int it_hi, bool tables, int gw, int NGW, int wave, int lane) {
    LAS float* scr = (LAS float*)(lds + RING_OFF + wave * 16384);
    constexpr int I_IN = 16 * 88, I_OUT = 16 * 32, I_G = 16 * 88, I_DN = 44 * 32, I_LAYER = I_IN + I_OUT + 2 * I_G + I_DN;
    for (int it = it_lo * I_LAYER + gw; it < it_hi * I_LAYER; it += NGW) {
        const int l = it / I_LAYER; int r = it % I_LAYER;
        if (r < I_IN) { const int kb = r / 88, nb = r % 88; tr_item(P.w_in + (size_t)l * DM * NIN, NIN, DM, P.norm1_g + l * DM, (bf16*)(P.ws + WS_WIN) + (size_t)l * QP * DM, 64 * kb, 32 * nb, 32 * nb, scr, lane); continue; } r -= I_IN;
        if (r < I_OUT) { const int kb = r / 32, nb = r % 32; tr_item(P.w_out + (size_t)l * DM * DM, DM, DM, P.mix_g + l * DM, (bf16*)(P.ws + WS_WOUT) + (size_t)l * DM * DM, 64 * kb, 32 * nb, 32 * nb, scr, lane); continue; } r -= I_OUT;
        if (r < I_G) { const int kb = r / 88, nb = r % 88, n0 = 32 * nb; tr_item8(P.w_gate + (size_t)l * DM * DFF, DFF, DM, P.norm2_g + l * DM, WSCALE, P.ws + WS_WGU + (size_t)l * NGU * DM, 64 * kb, n0, 256 * (n0 / 128) + (n0 % 128), scr, lane); continue; } r -= I_G;
        if (r < I_G) { const int kb = r / 88, nb = r % 88, n0 = 32 * nb; tr_item8(P.w_up + (size_t)l * DM * DFF, DFF, DM, P.norm2_g + l * DM, WSCALE, P.ws + WS_WGU + (size_t)l * NGU * DM, 64 * kb, n0, 256 * (n0 / 128) + 128 + (n0 % 128), scr, lane); continue; } r -= I_G;
        { const int kb = r / 32, nb = r % 32; tr_item8(P.w_down + (size_t)l * DFF * DM, DM, DFF, nullptr, WSCALE, P.ws + WS_WDN + (size_t)l * DM * DFF, 64 * kb, 32 * nb, 32 * nb, scr, lane); }
    }
    if (!tables) return;
    const int gt = gw * 64 + lane, NGT = NGW * 64;
    float* biasT = (float*)(P.ws + WS_BIAST);
    for (int i = gt; i < 12 * 4096; i += NGT) { const int col = i >> 12, dist = i & 4095; biasT[i] = P.rel_bias[t5_bucket(dist) * 12 + col] * LOG2E; }
    float* wfd = (float*)(P.ws + WS_WFD);
    for (int i = gt; i < DEPTH * DM * 4; i += NGT) { const int l = i / (DM * 4), k = (i / 4) % DM, h = i & 3; wfd[i] = P.norm1_g[l * DM + k] * P.w_in[((size_t)l * DM + k) * NIN + 2816 + h]; }
}

template <bool WITH_FD>
__device__ __forceinline__ void row_pass(const float* xin, bf16* xb, float* rstd, const LAS float* wfd, const float* fbias, float* lf, int gw, int NGW, int lane) {
    f32x4 nx[4];
    if (gw < M) { const GAS f32x4* xr = (const GAS f32x4*)(xin + (size_t)gw * DM) + lane;
#pragma unroll
        for (int j = 0; j < 4; ++j) nx[j] = xr[64 * j]; }
    for (int m = gw; m < M; m += NGW) {
        f32x4 v[4]; float s = 0.f;
#pragma unroll
        for (int j = 0; j < 4; ++j) v[j] = nx[j];
        if (m + NGW < M) { const GAS f32x4* xr = (const GAS f32x4*)(xin + (size_t)(m + NGW) * DM) + lane;
#pragma unroll
            for (int j = 0; j < 4; ++j) nx[j] = xr[64 * j]; }
#pragma unroll
        for (int j = 0; j < 4; ++j) s += (v[j].x * v[j].x + v[j].y * v[j].y) + (v[j].z * v[j].z + v[j].w * v[j].w);
        const float wave_sum_keep = wave_sum(s);
        const float rs = 1.0f / sqrtf(wave_sum_keep * (1.0f / DM) + EPS);
        GAS unsigned long long* o8 = (GAS unsigned long long*)(xb + (size_t)m * DM) + lane;
#pragma unroll
        for (int j = 0; j < 4; ++j) o8[64 * j] = (unsigned long long)pk2(v[j].x, v[j].y) | ((unsigned long long)pk2(v[j].z, v[j].w) << 32);
        if (WITH_FD) {
            float f0 = 0.f, f1 = 0.f, f2 = 0.f, f3 = 0.f;
#pragma unroll
            for (int j = 0; j < 4; ++j)
#pragma unroll
                for (int i = 0; i < 4; ++i) { const f32x4 w = *(const LAS f32x4*)(wfd + (4 * lane + 256 * j + i) * 4); const float xv = v[j][i]; f0 += xv * w.x; f1 += xv * w.y; f2 += xv * w.z; f3 += xv * w.w; }
            f0 = wave_sum(f0); f1 = wave_sum(f1); f2 = wave_sum(f2); f3 = wave_sum(f3);
            if (lane < 4) { const float f = lane == 0 ? f0 : lane == 1 ? f1 : lane == 2 ? f2 : f3; const float z = f * rs + fbias[lane];
                lf[(size_t)lane * M + m] = fminf(z, 0.f) - log1pf(expf(-fabsf(z))); }
        }
        if (lane < 16) rstd[(size_t)m * 16 + lane] = (lane == 0) ? wave_sum_keep : 0.f;
    }
}
__device__ __forceinline__ void final_pass(const bf16* xb, float* out, const float* g, const float* ss, int gw, int NGW, int lane) {
    v4u na = {0u, 0u, 0u, 0u}, nb = {0u, 0u, 0u, 0u}; float ns = 0.f;
    if (gw < M) { const GAS v4u* p = (const GAS v4u*)(xb + (size_t)gw * DM) + 2 * lane; na = p[0]; nb = p[1]; ns = lane < 16 ? ss[(size_t)gw * 16 + lane] : 0.f; }
    for (int m = gw; m < M; m += NGW) {
        const v4u a = na, b = nb; const float sv = ns; float f[16];
        if (m + NGW < M) { const GAS v4u* p = (const GAS v4u*)(xb + (size_t)(m + NGW) * DM) + 2 * lane; na = p[0]; nb = p[1]; ns = lane < 16 ? ss[(size_t)(m + NGW) * 16 + lane] : 0.f; }
        f[0] = bflo(a.x); f[1] = bfhi(a.x); f[2] = bflo(a.y); f[3] = bfhi(a.y); f[4] = bflo(a.z); f[5] = bfhi(a.z); f[6] = bflo(a.w); f[7] = bfhi(a.w);
        f[8] = bflo(b.x); f[9] = bfhi(b.x); f[10] = bflo(b.y); f[11] = bfhi(b.y); f[12] = bflo(b.z); f[13] = bfhi(b.z); f[14] = bflo(b.w); f[15] = bfhi(b.w);
        const float s = wave_sum(sv);
        const float rs = 1.0f / sqrtf(s * (1.0f / DM) + EPS);
        GAS f32x4* o = (GAS f32x4*)(out + (size_t)m * DM) + 4 * lane; const f32x4* gv = (const f32x4*)g + 4 * lane;
#pragma unroll
        for (int j = 0; j < 4; ++j) { const f32x4 gg = gv[j]; o[j] = (f32x4){f[4 * j] * rs * gg[0], f[4 * j + 1] * rs * gg[1], f[4 * j + 2] * rs * gg[2], f[4 * j + 3] * rs * gg[3]}; }
    }
}
__device__ __forceinline__ void unpack16(const v4u a, const v4u b, float (&f)[16]) {
    f[0] = bflo(a.x); f[1] = bfhi(a.x); f[2] = bflo(a.y); f[3] = bfhi(a.y); f[4] = bflo(a.z); f[5] = bfhi(a.z); f[6] = bflo(a.w); f[7] = bfhi(a.w);
    f[8] = bflo(b.x); f[9] = bfhi(b.x); f[10] = bflo(b.y); f[11] = bfhi(b.y); f[12] = bflo(b.z); f[13] = bfhi(b.z); f[14] = bflo(b.w); f[15] = bfhi(b.w);
}
__device__ __forceinline__ void mixnorm_pass(bf16* mix, const bf16* pa, const float* lse, int gw, int NGW, int lane) {
    for (int m = gw; m < M; m += NGW) {
        GAS v4u* p = (GAS v4u*)(mix + (size_t)m * DM) + 2 * lane;
        float f[16];
        if ((ATT_MFMA_MASK & 1) && lane < 16) {
            const int hd = lane >> 2;
            const float l0 = lse[(size_t)m * 4 + hd], l1 = lse[((size_t)M + m) * 4 + hd], l2 = lse[((size_t)2 * M + m) * 4 + hd];
            const float mx = fmaxf(l0, fmaxf(l1, l2)); float w0 = EX2(l0 - mx), w1 = EX2(l1 - mx), w2 = EX2(l2 - mx); const float inv = 1.0f / (w0 + w1 + w2); w0 *= inv; w1 *= inv; w2 *= inv;
            float t[16];
            { const GAS v4u* q = (const GAS v4u*)(pa + (size_t)m * 256) + 2 * lane; unpack16(q[0], q[1], t);
#pragma unroll
              for (int i = 0; i < 16; ++i) f[i] = w0 * t[i]; }
            { const GAS v4u* q = (const GAS v4u*)(pa + ((size_t)M + m) * 256) + 2 * lane; unpack16(q[0], q[1], t);
#pragma unroll
              for (int i = 0; i < 16; ++i) f[i] += w1 * t[i]; }
            { const GAS v4u* q = (const GAS v4u*)(pa + ((size_t)2 * M + m) * 256) + 2 * lane; unpack16(q[0], q[1], t);
#pragma unroll
              for (int i = 0; i < 16; ++i) f[i] += w2 * t[i]; }
        } else { const v4u a = p[0], b = p[1]; unpack16(a, b, f); }
        {
        }
        float s = 0.f;
#pragma unroll
        for (int i = 0; i < 16; ++i) s += f[i] * f[i];
        s += __shfl_xor(s, 1); s += __shfl_xor(s, 2); s += __shfl_xor(s, 4); s += __shfl_xor(s, 8);
        const float rs = 1.0f / sqrtf(s * (1.0f / 256.0f) + EPS);
        v4u oa, ob;
        oa.x = pk2(f[0] * rs, f[1] * rs); oa.y = pk2(f[2] * rs, f[3] * rs); oa.z = pk2(f[4] * rs, f[5] * rs); oa.w = pk2(f[6] * rs, f[7] * rs);
        ob.x = pk2(f[8] * rs, f[9] * rs); ob.y = pk2(f[10] * rs, f[11] * rs); ob.z = pk2(f[12] * rs, f[13] * rs); ob.w = pk2(f[14] * rs, f[15] * rs);
        p[0] = oa; p[1] = ob;
    }
}
__device__ __forceinline__ void scan_job(int b, int h, const float* lf_in, const float* ss, const float* fdp, float fbias_h, float* c2, LAS float* scr, int tid, int lane, int wave) {
    const size_t row0 = (size_t)b * S + 8 * tid;
    float v[8];
    if (lf_in) { const f32x4 a = *(const f32x4*)(lf_in + (size_t)h * M + row0), c = *(const f32x4*)(lf_in + (size_t)h * M + row0 + 4); v[0] = a[0]; v[1] = a[1]; v[2] = a[2]; v[3] = a[3]; v[4] = c[0]; v[5] = c[1]; v[6] = c[2]; v[7] = c[3]; }
    else {
#pragma unroll
        for (int i = 0; i < 8; ++i) { const f32x4* sp = (const f32x4*)(ss + (row0 + i) * 16); const f32x4* fp = (const f32x4*)(fdp + (row0 + i) * 64 + h * 16);
            const f32x4 s0 = sp[0], s1 = sp[1], s2 = sp[2], s3 = sp[3], f0 = fp[0], f1 = fp[1], f2 = fp[2], f3 = fp[3];
            const float s = ((s0[0] + s0[1]) + (s0[2] + s0[3])) + ((s1[0] + s1[1]) + (s1[2] + s1[3])) + ((s2[0] + s2[1]) + (s2[2] + s2[3])) + ((s3[0] + s3[1]) + (s3[2] + s3[3]));
            const float fd = ((f0[0] + f0[1]) + (f0[2] + f0[3])) + ((f1[0] + f1[1]) + (f1[2] + f1[3])) + ((f2[0] + f2[1]) + (f2[2] + f2[3])) + ((f3[0] + f3[1]) + (f3[2] + f3[3]));
            const float z = fd * (1.0f / sqrtf(s * (1.0f / DM) + EPS)) + fbias_h;
            v[i] = fminf(z, 0.f) - log1pf(expf(-fabsf(z))); }
    }
#pragma unroll
    for (int i = 1; i < 8; ++i) v[i] += v[i - 1];
    const float tot = v[7]; float inc = tot;
#pragma unroll
    for (int o = 1; o < 64; o <<= 1) { const float y = __shfl_up(inc, o); if (lane >= o) inc += y; }
    if (lane == 63) scr[wave] = inc;
    __syncthreads();
    float pre = inc - tot;
#pragma unroll
    for (int w = 0; w < NWAVES; ++w) pre += (w < wave) ? scr[w] : 0.f;
    f32x4* dst = (f32x4*)(c2 + (size_t)(b * 4 + h) * S + 8 * tid);
    dst[0] = (f32x4){v[0] + pre, v[1] + pre, v[2] + pre, v[3] + pre} * LOG2E; dst[1] = (f32x4){v[4] + pre, v[5] + pre, v[6] + pre, v[7] + pre} * LOG2E;
    __syncthreads();
}

__device__ __forceinline__ float dot_row(const bf16* krow, const float (&q)[64]) {
    const GAS v4u* p = (const GAS v4u*)krow; float s = 0.f;
#pragma unroll
    for (int i = 0; i < 8; ++i) { const v4u w = p[i];
        s = fmaf(q[8 * i + 0], bflo(w.x), s); s = fmaf(q[8 * i + 1], bfhi(w.x), s); s = fmaf(q[8 * i + 2], bflo(w.y), s); s = fmaf(q[8 * i + 3], bfhi(w.y), s);
        s = fmaf(q[8 * i + 4], bflo(w.z), s); s = fmaf(q[8 * i + 5], bfhi(w.z), s); s = fmaf(q[8 * i + 6], bflo(w.w), s); s = fmaf(q[8 * i + 7], bfhi(w.w), s); }
    return s;
}
__device__ __forceinline__ void axpy_row(const bf16* vrow, float a, float p, float (&o)[64]) {
    const GAS v4u* q = (const GAS v4u*)vrow;
#pragma unroll
    for (int i = 0; i < 8; ++i) { const v4u w = q[i];
        o[8 * i + 0] = fmaf(p, bflo(w.x), o[8 * i + 0] * a); o[8 * i + 1] = fmaf(p, bfhi(w.x), o[8 * i + 1] * a); o[8 * i + 2] = fmaf(p, bflo(w.y), o[8 * i + 2] * a); o[8 * i + 3] = fmaf(p, bfhi(w.y), o[8 * i + 3] * a);
        o[8 * i + 4] = fmaf(p, bflo(w.z), o[8 * i + 4] * a); o[8 * i + 5] = fmaf(p, bfhi(w.z), o[8 * i + 5] * a); o[8 * i + 6] = fmaf(p, bflo(w.w), o[8 * i + 6] * a); o[8 * i + 7] = fmaf(p, bfhi(w.w), o[8 * i + 7] * a); }
}
#define NV_STEP(KEY, BIAS2, VALID) do { if (VALID) { \
        const bf16* kr_ = qkv + (rowb + (size_t)(KEY)) * QP; \
        const float s_ = dot_row(kr_ + kcol, q) + (BIAS2); \
        const float mn_ = fmaxf(m, s_), a_ = EX2(m - mn_), p_ = EX2(s_ - mn_); l = l * a_ + p_; m = mn_; \
        axpy_row(kr_ + vcol, a_, p_, o); } } while (0)
__device__ __forceinline__ void attn_naive_item(int type, int b, int h, int chunk, const bf16* qkv, bf16* mix, const float* biasT, const float* c2, const float* kmean, const float* sinks_l, int lane) {
    const int t0 = chunk * 64, t = t0 + lane; const size_t rowb = (size_t)b * S;
    int qcol, kcol, vcol;
    if (type == 0) { qcol = C_QA + 64 * h; kcol = C_KA + 64 * h; vcol = C_VA + 64 * h; }
    else if (type == 1) { qcol = C_QB + 64 * h; kcol = C_KB + 64 * h; vcol = C_VB + 64 * h; }
    else if (type == 2) { qcol = C_QC + 64 * h; kcol = C_KC + 64 * (h >> 1); vcol = C_VC + 64 * (h >> 1); }
    else { qcol = C_QD + 64 * h; kcol = C_KD + 64 * h; vcol = C_VD + 64 * h; }
    float q[64], o[64];
    { const GAS v4u* p = (const GAS v4u*)(qkv + (rowb + t) * QP + qcol);
#pragma unroll
      for (int i = 0; i < 8; ++i) { const v4u w = p[i]; q[8 * i] = bflo(w.x); q[8 * i + 1] = bfhi(w.x); q[8 * i + 2] = bflo(w.y); q[8 * i + 3] = bfhi(w.y); q[8 * i + 4] = bflo(w.z); q[8 * i + 5] = bfhi(w.z); q[8 * i + 6] = bflo(w.w); q[8 * i + 7] = bfhi(w.w); } }
#pragma unroll
    for (int d = 0; d < 64; ++d) o[d] = 0.f;
    float m = -1e30f, l = 0.f;
    if (type == 0) {
        const float* bt = biasT + h * 4096;
        for (int g = 0; g < 3; ++g) { const int dil = g == 0 ? 1 : g == 1 ? 4 : 16;
            for (int jj = 0; jj <= 128; ++jj) { const int key = t - dil * jj; const bool valid = key >= 0; const float b2 = bt[jj * dil]; NV_STEP(valid ? key : 0, b2, valid); } }
    } else if (type == 1) {
        const float* bt = biasT + (4 + h) * 4096; const int own = t0 >> 8;
        float g[16];
#pragma unroll
        for (int n = 0; n < 16; ++n) { g[n] = -INFINITY; if (n < own) { const float* km = kmean + ((size_t)(b * 4 + h) * 16 + n) * 64; float s = 0.f;
#pragma unroll
                for (int d = 0; d < 64; ++d) s = fmaf(q[d], km[d], s);
                g[n] = s; } }
        unsigned sel = 0u;
#pragma unroll
        for (int r = 0; r < 3; ++r) { float best = -INFINITY; int bi = -1;
#pragma unroll
            for (int n = 0; n < 16; ++n) if (n < own && !((sel >> n) & 1u) && g[n] > best) { best = g[n]; bi = n; }
            if (bi >= 0) sel |= 1u << bi; }
        for (int n = 0; n < own; ++n) { const bool pick = (sel >> n) & 1u;
            if (__ballot(pick) != 0ull) for (int i = 0; i < 256; ++i) { const int key = n * 256 + i; NV_STEP(key, bt[t - key], pick); } }
        for (int key = own * 256; key <= t0 + 63; ++key) { const bool valid = key <= t; NV_STEP(key, bt[valid ? t - key : 0], valid); }
    } else if (type == 2) {
        const float* bt = biasT + (8 + h) * 4096; const int jlo = t0 - 127 > 0 ? t0 - 127 : 0;
        for (int key = jlo; key <= t0 + 63; ++key) { const int dist = t - key; const bool valid = dist >= 0 && dist <= 127; NV_STEP(key, bt[valid ? dist : 0], valid); }
        l += EX2(sinks_l[h] * LOG2E - m);
    } else {
        const float* cc = c2 + (size_t)(b * 4 + h) * S; const float ct = cc[t];
        for (int key = 0; key <= t0 + 63; ++key) { const bool valid = key <= t; NV_STEP(key, ct - cc[key], valid); }
    }
    const float inv = 1.0f / l;
    GAS v4u* op = (GAS v4u*)(mix + (rowb + t) * DM + type * 256 + h * 64);
#pragma unroll
    for (int i = 0; i < 8; ++i) { v4u w; w.x = pk2(o[8 * i] * inv, o[8 * i + 1] * inv); w.y = pk2(o[8 * i + 2] * inv, o[8 * i + 3] * inv); w.z = pk2(o[8 * i + 4] * inv, o[8 * i + 5] * inv); w.w = pk2(o[8 * i + 6] * inv, o[8 * i + 7] * inv); op[i] = w; }
}
__device__ __forceinline__ void attn_naive_phase(const bf16* qkv, bf16* mix, const float* biasT, const float* c2, const float* kmean, const float* sinks_l, int gw, int NGW, int lane) {
    for (int idx = gw; idx < 4 * NB * 4 * 64; idx += NGW) {
        const int chunk = 63 - (idx >> 7), rem = idx & 127, type = rem >> 5, bh = rem & 31;
        if ((ATT_MFMA_MASK >> type) & 1) continue;
        attn_naive_item(type, bh >> 2, bh & 3, chunk, qkv, mix, biasT, c2, kmean, sinks_l, lane);
    }
}

__device__ __forceinline__ void attn_mfma_phase(LAS unsigned char* lds, unsigned char* ws, const float* sinks_l, int l, int c, int G) {
    int cur_tab = -1, cur_tab2 = -1, cur_tab3 = -1;
#define ATT_OPAQUE() int b = b0_, h = h0_, hs = hs0_; asm volatile("" : "+s"(b), "+s"(h), "+s"(hs)); \
        const bf16* qkv = (const bf16*)(ws + WS_QKV); bf16* mix = (bf16*)(ws + WS_MIX); const float* biasT = (const float*)(ws + WS_BIAST)
    for (int v = c; v < 256; v += G) {
        const int b0_ = (v & 31) >> 2, h0_ = v & 3, hs0_ = v >> 5;
        for (int j = 0; j < 2; ++j) {
            if ((ATT_MFMA_MASK >> 1) & 1) for (int d_ = 0; d_ < ADUP(1); ++d_) { ATT_OPAQUE(); const int qb = j ? hs : 15 - hs;
                if ((ATT2_MASK >> 1) & 1) att2::attn_unit2<att2::T_B>(lds, qkv, b, h, qb, biasT + (4 + h) * 4096, 4 + h, cur_tab2, nullptr, nullptr, (const float*)(ws + WS_CTL) + CW_KMEAN + (size_t)l * 32768 + (size_t)(b * 4 + h) * 16 * 64, mix + 256 + 64 * h, DM);
                else att::attn_item<att::T_B>(lds, qkv, b, h, qb, 0, 1, 0, 0, 0, 0, biasT + (4 + h) * 4096, 4 + h, cur_tab, nullptr, nullptr, (const float*)(ws + WS_CTL) + CW_KMEAN + (size_t)l * 32768 + (size_t)(b * 4 + h) * 16 * 64, 0.f, mix + 256 + 64 * h, DM, nullptr); }
            if ((ATT_MFMA_MASK >> 3) & 1) for (int d_ = 0; d_ < ADUP(3); ++d_) { ATT_OPAQUE(); const int qb = j ? hs : 15 - hs; if (j) h = (h + 2) & 3;
                if ((ATT2_MASK >> 3) & 1) att2::attn_unit2<att2::T_D>(lds, qkv, b, h, qb, nullptr, -1, cur_tab2, (const float*)(ws + WS_C2) + (size_t)(b * 4 + h) * S, (const unsigned*)(ws + WS_CTL) + CW_NORM + 128 * l + (b * 4 + h) * 4, nullptr, mix + 768 + 64 * h, DM);
                else att::attn_item<att::T_D>(lds, qkv, b, h, qb, 0, 1, 0, 0, 0, 0, nullptr, -1, cur_tab, (const float*)(ws + WS_C2) + (size_t)(b * 4 + h) * S, (const unsigned*)(ws + WS_CTL) + CW_NORM + 128 * l + (b * 4 + h) * 4, nullptr, 0.f, mix + 768 + 64 * h, DM, nullptr); }
        }
        if ((ATT_MFMA_MASK & 5) == 5) for (int d_ = 0; d_ < ADUP(0); ++d_) {
#define A3_GEOM(J) const int cls_ = (J) >> 1, rest_ = 2 * hs + ((J) & 1); const int dil_ = cls_ <= 1 ? 1 : cls_ == 2 ? 4 : 16, qb_ = cls_ <= 1 ? rest_ : cls_ == 2 ? rest_ >> 2 : 0, res_ = cls_ <= 1 ? 0 : cls_ == 2 ? rest_ & 3 : rest_; const bool swa_ = cls_ == 0
#define A3_SRC(J, OUT) do { A3_GEOM(J); const bf16* rb_ = qkv + ((size_t)b * S + res_) * QP; OUT.k = rb_ + (swa_ ? C_KC + 64 * (h >> 1) : C_KA + 64 * h); OUT.v = rb_ + (swa_ ? C_VC + 64 * (h >> 1) : C_VA + 64 * h); OUT.rs = dil_ * QP; OUT.kw = 256 * qb_ - 128; OUT.tmin = qb_ == 0 ? 2 : 0; } while (0)
            att3::BandSrc cur_, nx_; nx_.k = nullptr; nx_.v = nullptr; nx_.rs = 0; nx_.kw = 0; nx_.tmin = 0;
            { ATT_OPAQUE(); A3_SRC(0, cur_); const int wid_ = __builtin_amdgcn_readfirstlane(threadIdx.x >> 6), lane_ = threadIdx.x & 63; const unsigned l0_ = (unsigned)(uintptr_t)lds;
              att3::band_dma(l0_ + att3::L_K, cur_.k, cur_.rs, cur_.kw, cur_.tmin, false, wid_, lane_); att3::band_dma(l0_ + att3::L_V, cur_.v, cur_.rs, cur_.kw, cur_.tmin, true, wid_, lane_); }
            for (int j8 = 0; j8 < 8; ++j8) { ATT_OPAQUE();
                A3_GEOM(j8); const size_t g = (size_t)(cls_ - 1);
                if (j8 < 7) A3_SRC(j8 + 1, nx_);
#define A3_CALL(D) att3::attn_band<D>(lds, qkv, b, h, qb_, res_, swa_ ? 127 : 128, (swa_ ? C_QC : C_QA) + 64 * h, swa_ ? C_KC + 64 * (h >> 1) : C_KA + 64 * h, swa_ ? C_VC + 64 * (h >> 1) : C_VA + 64 * h, \
                    biasT + ((swa_ ? 8 : 0) + h) * 4096, cls_ * 4 + h, cur_tab3, swa_ ? sinks_l[h] * LOG2E : -INFINITY, \
                    swa_ ? mix + 512 + 64 * h : (bf16*)(ws + WS_PA) + g * M * 256 + 64 * h, swa_ ? DM : 256, swa_ ? nullptr : (float*)(ws + WS_LSE) + g * M * 4 + h, nx_, j8 < 7)
                if (dil_ == 1) A3_CALL(1); else if (dil_ == 4) A3_CALL(4); else A3_CALL(16);
#undef A3_CALL
                cur_ = nx_;
            }
#undef A3_GEOM
#undef A3_SRC
        }
    }
#undef ATT_OPAQUE
}

struct Args { const float* in[13]; float* out; unsigned char* ws; int ph_lo, ph_hi, li, pad; };
__global__ void __launch_bounds__(NWAVES * 64, 2) hybrid_fwd(Args args) {
    extern __shared__ __attribute__((aligned(16))) unsigned char lds_raw[];
    LAS unsigned char* lds = (LAS unsigned char*)lds_raw;
    volatile LAS unsigned* MISC = (volatile LAS unsigned*)(lds + MISC_OFF);
    const int tid = threadIdx.x, lane = tid & 63, wave = __builtin_amdgcn_readfirstlane(tid >> 6);
    const int G = gridDim.x; const int bx = blockIdx.x; const int vcu = (G % 8 == 0) ? (bx % 8) * (G / 8) + bx / 8 : bx;
    const int gw = vcu * NWAVES + wave, NGW = G * NWAVES;
    Ptrs P;
    P.x = args.in[0]; P.norm1_g = args.in[1]; P.w_in = args.in[2]; P.f_bias = args.in[3]; P.sinks = args.in[4]; P.mix_g = args.in[5]; P.w_out = args.in[6];
    P.norm2_g = args.in[7]; P.w_gate = args.in[8]; P.w_up = args.in[9]; P.w_down = args.in[10]; P.rel_bias = args.in[11]; P.final_g = args.in[12];
    P.out = args.out; P.ws = args.ws;
    unsigned char* ws = args.ws;
    gu32* ctl = (gu32*)(ws + WS_CTL);
    bf16* XB = (bf16*)(ws + WS_XB); bf16* MIX = (bf16*)(ws + WS_MIX); bf16* QKV = (bf16*)(ws + WS_QKV); bf16* ACT = (bf16*)(ws + WS_QKV);
    float* SSB = (float*)(ws + WS_SS); float* FDB = (float*)(ws + WS_FD); float* LF = (float*)(ws + WS_LF); float* CC2 = (float*)(ws + WS_C2); float* KMEAN = (float*)(ws + WS_KMEAN);
    const float* BIAST = (const float*)(ws + WS_BIAST);
    for (int u = tid; u < (LDS_BYTES - LDSCTL_OFF) / 4; u += NWAVES * 64) ((LAS unsigned*)(lds + LDSCTL_OFF))[u] = 0u;
    __syncthreads();
    XcdBarrier bar; bar.bar = (unsigned*)(ctl + CW_BAR) + args.li * XCD_BAR_WORDS; bar.x = 0; bar.st = nullptr;
    if (N_LAUNCHES == 1) bar = xcd_barrier_post((unsigned*)(ctl + CW_BAR) + args.li * XCD_BAR_WORDS, MISC + 8);
    const int lo = args.ph_lo, hi = args.ph_hi;
#define IN(k) (lo <= (k) && (k) < hi)
#define SEAM(k) do { if (IN(k) && IN((k) + 1)) { if (N_LAUNCHES == 1) xcd_barrier(bar); } } while (0)

    if (IN(0)) {
        phase_prep(P, lds, 0, (G == 256) ? 1 : DEPTH, true, gw, NGW, wave, lane);
        __syncthreads();
        { LAS float* wl = (LAS float*)(lds + RING_OFF); for (int i = tid; i < DM * 4; i += NWAVES * 64) { const int k = i >> 2, h = i & 3; wl[i] = P.norm1_g[k] * P.w_in[(size_t)k * NIN + 2816 + h]; } }
        __syncthreads();
        row_pass<true>(P.x, XB, SSB, (const LAS float*)(lds + RING_OFF), P.f_bias, LF, gw, NGW, lane);
        SEAM(0);
    }

    { constexpr int l = 0;
    {
        const int pb = 1 + PH_PER_LAYER * l;
        if (IN(pb + 0)) {
            pg8::Gemm g{XB, (const bf16*)(ws + WS_WIN) + (size_t)l * QP * DM, M, QP, DM}; pg8::StaticOrder So; So.init(M, QP, G, bx);
            pg8::EpiQKV E{QKV, QP, SSB, C2, (LAS float*)(lds + LDSCTL_OFF + 1024), (float*)(ctl + CW_KMEAN) + (size_t)l * 32768, (unsigned*)(ctl + CW_NORM + 128 * l)};
            pg8::rstd_table((LAS float*)(lds + LDSCTL_OFF + 1024), SSB, So);
            pg8::gemm_phase<pg8::EpiQKV, pg8::StaticOrder, PG8_ALIGN, PG8_SP2>(lds + RING_OFF, g, So, E);
            for (int j = bx; j < 32 + 128; j += G) if (j >= 128) { const int bh = j - 128;
                scan_job(bh >> 2, bh & 3, l == 0 ? LF : nullptr, SSB, FDB, P.f_bias[l * 4 + (bh & 3)], CC2, (LAS float*)(lds + LDSCTL_OFF + 1024), tid, lane, wave); }
            if (l == 0 && G == 256 && bx >= 128) phase_prep(P, lds, 1, DEPTH, false, (bx - 128) * NWAVES + wave, 128 * NWAVES, wave, lane);
            SEAM(pb + 0);
        }
        if (IN(pb + 1)) {
            if (ATT_MFMA_MASK != 15) attn_naive_phase(QKV, MIX, BIAST, CC2, KMEAN, P.sinks + l * 4, gw, NGW, lane);
            if (ATT_MFMA_MASK != 0) { __syncthreads(); attn_mfma_phase(lds + RING_OFF, ws, P.sinks + l * 4, l, bx, G); }
            SEAM(pb + 1); }
        if (IN(pb + 2)) { mixnorm_pass(MIX, (const bf16*)(ws + WS_PA), (const float*)(ws + WS_LSE), gw, NGW, lane); SEAM(pb + 2); }
        if (IN(pb + 3)) {
            pg8::Gemm g{MIX, (const bf16*)(ws + WS_WOUT) + (size_t)l * DM * DM, M, DM, DM}; pg8::StaticOrder So; So.init(M, DM, G, bx);
            pg8::EpiResidX E{XB, SSB, nullptr, nullptr, DM, 1.0f, ws + WS_X8};
            pg8::gemm_phase<pg8::EpiResidX, pg8::StaticOrder, PG8_ALIGN, PG8_SP2>(lds + RING_OFF, g, So, E);
            SEAM(pb + 3);
        }
        if (IN(pb + 4)) {
            pg8::Gemm g{(const bf16*)(ws + WS_X8), (const bf16*)(ws + WS_WGU + (size_t)l * NGU * DM), M, NGU, DM}; pg8::StaticOrder So; So.init(M, NGU, G, bx);
            pg8::EpiSwiGLU E{(unsigned char*)ACT, DFF, SSB, (LAS float*)(lds + LDSCTL_OFF + 1024), 1.0f / WSCALE, ASCALE};
            pg8::rstd_table((LAS float*)(lds + LDSCTL_OFF + 1024), SSB, So);
            pg8::gemm_phase<pg8::EpiSwiGLU, pg8::StaticOrder, PG8_ALIGN, PG8_SP2, true>(lds + RING_OFF, g, So, E);
            SEAM(pb + 4);
        }
        if (IN(pb + 5)) {
            pg8::Gemm g{ACT, (const bf16*)(ws + WS_WDN + (size_t)l * DM * DFF), M, DM, DFF}; pg8::StaticOrder So; So.init(M, DM, G, bx);
            pg8::EpiResidX E{XB, SSB, (l + 1 < DEPTH) ? (const float*)(ws + WS_WFD) + (size_t)(l + 1) * DM * 4 : nullptr, FDB, DM, 1.0f / (WSCALE * ASCALE), nullptr};
            pg8::gemm_phase<pg8::EpiResidX, pg8::StaticOrder, PG8_ALIGN, PG8_SP2, true>(lds + RING_OFF, g, So, E);
            SEAM(pb + 5);
        }
    }
    }
    { constexpr int l = 1;
    {
        const int pb = 1 + PH_PER_LAYER * l;
        if (IN(pb + 0)) {
            pg8::Gemm g{XB, (const bf16*)(ws + WS_WIN) + (size_t)l * QP * DM, M, QP, DM}; pg8::StaticOrder So; So.init(M, QP, G, bx);
            pg8::EpiQKV E{QKV, QP, SSB, C2, (LAS float*)(lds + LDSCTL_OFF + 1024), (float*)(ctl + CW_KMEAN) + (size_t)l * 32768, (unsigned*)(ctl + CW_NORM + 128 * l)};
            pg8::rstd_table((LAS float*)(lds + LDSCTL_OFF + 1024), SSB, So);
            pg8::gemm_phase<pg8::EpiQKV, pg8::StaticOrder, PG8_ALIGN, PG8_SP2>(lds + RING_OFF, g, So, E);
            for (int j = bx; j < 32 + 128; j += G) if (j >= 128) { const int bh = j - 128;
                scan_job(bh >> 2, bh & 3, l == 0 ? LF : nullptr, SSB, FDB, P.f_bias[l * 4 + (bh & 3)], CC2, (LAS float*)(lds + LDSCTL_OFF + 1024), tid, lane, wave); }
            if (l == 0 && G == 256 && bx >= 128) phase_prep(P, lds, 1, DEPTH, false, (bx - 128) * NWAVES + wave, 128 * NWAVES, wave, lane);
            SEAM(pb + 0);
        }
        if (IN(pb + 1)) {
            if (ATT_MFMA_MASK != 15) attn_naive_phase(QKV, MIX, BIAST, CC2, KMEAN, P.sinks + l * 4, gw, NGW, lane);
            if (ATT_MFMA_MASK != 0) { __syncthreads(); attn_mfma_phase(lds + RING_OFF, ws, P.sinks + l * 4, l, bx, G); }
            SEAM(pb + 1); }
        if (IN(pb + 2)) { mixnorm_pass(MIX, (const bf16*)(ws + WS_PA), (const float*)(ws + WS_LSE), gw, NGW, lane); SEAM(pb + 2); }
        if (IN(pb + 3)) {
            pg8::Gemm g{MIX, (const bf16*)(ws + WS_WOUT) + (size_t)l * DM * DM, M, DM, DM}; pg8::StaticOrder So; So.init(M, DM, G, bx);
            pg8::EpiResidX E{XB, SSB, nullptr, nullptr, DM, 1.0f, ws + WS_X8};
            pg8::gemm_phase<pg8::EpiResidX, pg8::StaticOrder, PG8_ALIGN, PG8_SP2>(lds + RING_OFF, g, So, E);
            SEAM(pb + 3);
        }
        if (IN(pb + 4)) {
            pg8::Gemm g{(const bf16*)(ws + WS_X8), (const bf16*)(ws + WS_WGU + (size_t)l * NGU * DM), M, NGU, DM}; pg8::StaticOrder So; So.init(M, NGU, G, bx);
            pg8::EpiSwiGLU E{(unsigned char*)ACT, DFF, SSB, (LAS float*)(lds + LDSCTL_OFF + 1024), 1.0f / WSCALE, ASCALE};
            pg8::rstd_table((LAS float*)(lds + LDSCTL_OFF + 1024), SSB, So);
            pg8::gemm_phase<pg8::EpiSwiGLU, pg8::StaticOrder, PG8_ALIGN, PG8_SP2, true>(lds + RING_OFF, g, So, E);
            SEAM(pb + 4);
        }
        if (IN(pb + 5)) {
            pg8::Gemm g{ACT, (const bf16*)(ws + WS_WDN + (size_t)l * DM * DFF), M, DM, DFF}; pg8::StaticOrder So; So.init(M, DM, G, bx);
            pg8::EpiResidX E{XB, SSB, (l + 1 < DEPTH) ? (const float*)(ws + WS_WFD) + (size_t)(l + 1) * DM * 4 : nullptr, FDB, DM, 1.0f / (WSCALE * ASCALE), nullptr};
            pg8::gemm_phase<pg8::EpiResidX, pg8::StaticOrder, PG8_ALIGN, PG8_SP2, true>(lds + RING_OFF, g, So, E);
            SEAM(pb + 5);
        }
    }
    }
    if (IN(NPHASE - 1)) final_pass(XB, P.out, P.final_g, SSB, gw, NGW, lane);
#undef IN
#undef SEAM
}

extern "C" void kernel_launch(void* const* d_in, const int* in_sizes, int n_in, void* d_out, int out_size, void* d_ws, size_t ws_size, hipStream_t stream) {
    static int grid = 0;
    if (grid == 0) {
        if (n_in != 13 || in_sizes[0] != M * DM || out_size != M * DM || ws_size < WS_END) { fprintf(stderr, "kernel_launch: unexpected shapes (n_in %d, in0 %d, out %d, ws %zu); nothing launched\n", n_in, n_in > 0 ? in_sizes[0] : -1, out_size, ws_size); grid = -1; return; }
        int dev = 0, cus = 0, per_cu = 0;
        if (hipGetDevice(&dev) != hipSuccess || hipDeviceGetAttribute(&cus, hipDeviceAttributeMultiprocessorCount, dev) != hipSuccess) { fprintf(stderr, "kernel_launch: device query failed\n"); grid = -1; return; }
        if (hipFuncSetAttribute((const void*)hybrid_fwd, hipFuncAttributeMaxDynamicSharedMemorySize, LDS_BYTES) != hipSuccess) { fprintf(stderr, "kernel_launch: hipFuncSetAttribute failed\n"); grid = -1; return; }
        if (hipOccupancyMaxActiveBlocksPerMultiprocessor(&per_cu, (const void*)hybrid_fwd, NWAVES * 64, LDS_BYTES) != hipSuccess || per_cu < 1)
            fprintf(stderr, "kernel_launch: note: occupancy query reports %d workgroups per CU\n", per_cu);
        (void)hipGetLastError();
        grid = cus;
    }
    if (grid < 0) return;
    if (hipMemsetAsync((char*)d_ws + WS_CTL, 0, CTL_ZERO_BYTES, stream) != hipSuccess) { fprintf(stderr, "kernel_launch: hipMemsetAsync failed\n"); return; }
    Args a{};
    for (int i = 0; i < 13; ++i) a.in[i] = (const float*)d_in[i];
    a.out = (float*)d_out; a.ws = (unsigned char*)d_ws;
    const int n_l = (PROBE_PHASE >= 0) ? 3 : N_LAUNCHES;
    for (int li = 0; li < n_l; ++li) {
        if (PROBE_PHASE >= 0) { a.ph_lo = li == 0 ? 0 : li == 1 ? PROBE_PHASE : PROBE_PHASE + 1; a.ph_hi = li == 0 ? PROBE_PHASE + 1 : li == 1 ? PROBE_PHASE + 1 : NPHASE; a.li = li; if (a.ph_lo >= a.ph_hi) continue; }
        else { a.ph_lo = (N_LAUNCHES == 1) ? 0 : li; a.ph_hi = (N_LAUNCHES == 1) ? NPHASE : li + 1; a.li = (N_LAUNCHES == 1) ? 0 : li; }
        hipLaunchKernelGGL(hybrid_fwd, dim3(grid), dim3(NWAVES * 64), LDS_BYTES, stream, a);
        const hipError_t le = hipPeekAtLastError();
        if (le != hipSuccess) { fprintf(stderr, "kernel_launch: launch %d failed: %s\n", li, hipGetErrorName(le)); break; }
    }
}
```

```cpp
#include <hip/hip_runtime.h>
#include <cstdio>
#include <cstdint>
#ifndef MK_N_LAUNCHES
#define MK_N_LAUNCHES 1
#endif
#define EX2(x) __builtin_amdgcn_exp2f(x)
#ifndef ATT_MFMA_MASK
#define ATT_MFMA_MASK 15
#endif
#ifndef DUP_MASK
#define DUP_MASK 0
#endif
#define DUPN(k) ((((DUP_MASK) >> (k)) & 1) + 1)
#ifndef ATT_DUP_TYPES
#define ATT_DUP_TYPES 0
#endif
#define ADUP(t) ((((ATT_DUP_TYPES) >> (t)) & 1) + 1)
#ifndef PROBE_PHASE
#define PROBE_PHASE -1
#endif
#ifndef ATT2_MASK
#define ATT2_MASK 10
#endif
#ifndef ATT3_ON
#define ATT3_ON 1
#endif
#ifndef G2_FP8
#define G2_FP8 0
#endif
namespace pg8 {
#define PG8_LAS __attribute__((address_space(3)))
typedef unsigned short bf16_t;
typedef short bf16x8 __attribute__((ext_vector_type(8)));
typedef float f32x4 __attribute__((ext_vector_type(4)));
typedef unsigned u32x4 __attribute__((ext_vector_type(4)));
typedef int i32x4_t __attribute__((ext_vector_type(4)));
typedef int i32x8_t __attribute__((ext_vector_type(8)));
constexpr int BM = 256, BK = 64, HALF = 128, HTB = HALF * BK * 2  , STAGE_BYTES = 8 * HTB, NXCD = 8, WGM = 8;

__host__ __device__ __forceinline__ int lds_byte(int r, int c) { const int st = (r >> 4) * 2 + (c >> 5), rr = r & 15, cc = c & 31, ob = rr * 64 + cc * 2; return st * 1024 + (ob ^ (((ob >> 9) & 1) << 5)); }
__host__ __device__ __forceinline__ void stage_rc(int b, int& R, int& C) { const int st = b / 1024, sb = b % 1024, swz = sb ^ (((sb >> 9) & 1) << 5); R = (st >> 1) * 16 + swz / 64; C = (st & 1) * 32 + (swz % 64) / 2; }
__host__ __device__ __forceinline__ int perm32(int rho) { const int n = rho >> 4, i = rho & 15; return 8 * (i >> 2) + 4 * n + (i & 3); }

struct Unit { int pm, pn, ui; };
struct Gemm { const bf16_t* A; const bf16_t* Bt; int M, N, K; };

struct StaticOrder {
    int nM, nN, nwg, G, c;
    __host__ __device__ void init(int M, int N, int G_, int c_) { nM = M / BM; nN = N / BM; nwg = nM * nN; G = G_; c = c_; }
    __host__ __device__ bool next(int i, Unit& u) const {
        const long L = (long)i * G + c; if (L >= nwg) return false;
        int wgid = (int)L; { const int q = nwg / NXCD, r = nwg % NXCD, xcd = wgid % NXCD, off = wgid / NXCD; wgid = (xcd < r ? xcd * (q + 1) : r * (q + 1) + (xcd - r) * q) + off; }
        const int nig = WGM * nN, gid = wgid / nig, fm = gid * WGM, gsz = (nM - fm) < WGM ? (nM - fm) : WGM;
        u.pm = fm + ((wgid % nig) % gsz); u.pn = (wgid % nig) / gsz; u.ui = i; return true;
    }
    __device__ __forceinline__ void a_ready(const Unit&) const {}
    __device__ __forceinline__ void done(const Unit&) const {}
};

__device__ __forceinline__ unsigned cvt_pk_bf16(float lo, float hi) { unsigned r; asm volatile("v_cvt_pk_bf16_f32 %0, %1, %2" : "=v"(r) : "v"(lo), "v"(hi)); return r; }

#ifndef WT_STORES
#define WT_STORES 0
#endif
__device__ __forceinline__ void st16_wt(void* p, u32x4 v) {
#if WT_STORES
    asm volatile("global_store_dwordx4 %0, %1, off sc1\n\ts_nop 1" :: "v"(p), "v"(v) : "memory");
#else
    *(u32x4*)p = v;
#endif
}
typedef unsigned u32x2_t __attribute__((ext_vector_type(2)));
__device__ __forceinline__ void st8_wt(void* p, u32x2_t v) {
#if WT_STORES
    asm volatile("global_store_dwordx2 %0, %1, off sc1\n\ts_nop 1" :: "v"(p), "v"(v) : "memory");
#else
    *(u32x2_t*)p = v;
#endif
}
__device__ __forceinline__ unsigned pk4_fp8(float a, float b, float c, float d) {
    a = __builtin_amdgcn_fmed3f(a, -448.f, 448.f); b = __builtin_amdgcn_fmed3f(b, -448.f, 448.f); c = __builtin_amdgcn_fmed3f(c, -448.f, 448.f); d = __builtin_amdgcn_fmed3f(d, -448.f, 448.f);
    unsigned w = __builtin_amdgcn_cvt_pk_fp8_f32(a, b, 0u, false); return __builtin_amdgcn_cvt_pk_fp8_f32(c, d, w, true);
}
__device__ __forceinline__ float rstd_from_slots(const float* ss, int r) {
    const f32x4* p = (const f32x4*)(ss + (size_t)r * 16); const f32x4 a = p[0], b = p[1], c = p[2], d = p[3];
    const float s = ((a[0] + a[1]) + (a[2] + a[3])) + ((b[0] + b[1]) + (b[2] + b[3])) + ((c[0] + c[1]) + (c[2] + c[3])) + ((d[0] + d[1]) + (d[2] + d[3]));
    return 1.0f / sqrtf(s * (1.0f / 1024.0f) + 1e-6f);
}

template <class Sched> __device__ __forceinline__ void rstd_table(PG8_LAS float* tbl, const float* ss, const Sched& S) {
    Unit u;
    for (int i = 0; S.next(i, u); ++i) { if (threadIdx.x < 256) tbl[i * 256 + threadIdx.x] = rstd_from_slots(ss, u.pm * BM + (int)threadIdx.x); }
    __syncthreads();
}
struct EpiQKV {
    static constexpr bool PERM = true, AFTER_DRAIN = false;
    bf16_t* O; int ldc; const float* rstd; float qscale; PG8_LAS float* rsl;
    float* kmean; unsigned* nrm;
    __device__ __forceinline__ void operator()(const f32x4 (&acc)[2][2][4][2], const Unit& u, int wr, int wc, int fr, int fq) const {
        const int row0 = u.pm * BM + wr * 64 + fr, col0 = u.pn * BM + wc * 32 + 8 * fq;
        const float ts = (u.pn == 0 || u.pn == 3 || u.pn == 6 || u.pn == 8) ? qscale : 1.0f;
        const PG8_LAS float* sc = rsl + u.ui * 256 + wr * 64;
        const bool do_km = (u.pn == 4);
        const bool do_nrm = (u.pn == 8 || u.pn == 9);
        float cs[2][8]; float nmx[2] = {0.f, 0.f};
#pragma unroll
        for (int bj = 0; bj < 2; ++bj)
#pragma unroll
            for (int j = 0; j < 8; ++j) cs[bj][j] = 0.f;
#pragma unroll
        for (int ai = 0; ai < 2; ++ai)
#pragma unroll
            for (int m = 0; m < 4; ++m) { const int r = row0 + ai * HALF + m * 16; const float s = sc[ai * HALF + m * 16 + fr] * ts; bf16_t* rowp = O + (size_t)r * ldc + col0;
#pragma unroll
                for (int bj = 0; bj < 2; ++bj) { const f32x4 v0 = acc[ai][bj][m][0] * s, v1 = acc[ai][bj][m][1] * s;
                    u32x4 w; w.x = cvt_pk_bf16(v0[0], v0[1]); w.y = cvt_pk_bf16(v0[2], v0[3]); w.z = cvt_pk_bf16(v1[0], v1[1]); w.w = cvt_pk_bf16(v1[2], v1[3]);
                    st16_wt(rowp + bj * HALF, w);
                    if (do_km) {
#pragma unroll
                        for (int i = 0; i < 4; ++i) { cs[bj][i] += v0[i]; cs[bj][4 + i] += v1[i]; } }
                    if (do_nrm) { float q = (v0[0] * v0[0] + v0[1] * v0[1]) + (v0[2] * v0[2] + v0[3] * v0[3]) + (v1[0] * v1[0] + v1[1] * v1[1]) + (v1[2] * v1[2] + v1[3] * v1[3]);
                        q += __shfl_xor(q, 16); q += __shfl_xor(q, 32); nmx[bj] = __builtin_fmaxf(nmx[bj], q); } } }
        if (do_km) {
#pragma unroll
            for (int bj = 0; bj < 2; ++bj)
#pragma unroll
                for (int j = 0; j < 8; ++j) { float v = cs[bj][j]; v += __shfl_xor(v, 1); v += __shfl_xor(v, 2); v += __shfl_xor(v, 4); v += __shfl_xor(v, 8);
                    if (fr == 0) { const int cg = bj * HALF + wc * 32 + 8 * fq + j; atomicAdd(kmean + ((size_t)((u.pm >> 4) * 4 + (cg >> 6)) * 16 + (u.pm & 15)) * 64 + (cg & 63), v * (1.0f / 256.0f)); } }
        }
        if (do_nrm) {
#pragma unroll
            for (int bj = 0; bj < 2; ++bj) { float v = nmx[bj]; v = __builtin_fmaxf(v, __shfl_xor(v, 1)); v = __builtin_fmaxf(v, __shfl_xor(v, 2)); v = __builtin_fmaxf(v, __shfl_xor(v, 4)); v = __builtin_fmaxf(v, __shfl_xor(v, 8));
                if (fr == 0 && fq == 0) atomicMax(nrm + ((u.pm >> 4) * 4 + 2 * bj + (wc >> 1)) * 4 + (u.pn == 9 ? 2 : 0) + (wc & 1), __float_as_uint(v)); }
        }
    }
};
struct EpiResid {
    static constexpr bool PERM = false, AFTER_DRAIN = false;
    const float* base; float* out; int ldc;
    __device__ __forceinline__ void operator()(const f32x4 (&acc)[2][2][4][2], const Unit& u, int wr, int wc, int fr, int fq) const {
        const int row0 = u.pm * BM + wr * 64 + fr, col0 = u.pn * BM + wc * 32 + 4 * fq;
#pragma unroll
        for (int ai = 0; ai < 2; ++ai)
#pragma unroll
            for (int m = 0; m < 4; ++m) { const size_t off = (size_t)(row0 + ai * HALF + m * 16) * ldc + col0;
#pragma unroll
                for (int bj = 0; bj < 2; ++bj)
#pragma unroll
                    for (int n = 0; n < 2; ++n) { const f32x4 b = *(const f32x4*)(base + off + bj * HALF + n * 16); *(f32x4*)(out + off + bj * HALF + n * 16) = b + acc[ai][bj][m][n]; } }
    }
};
struct EpiResidX {
    static constexpr bool PERM = true, AFTER_DRAIN = false;
    bf16_t* xb; float* ss; const float* wfd; float* fdp; int ldc; float ascale; unsigned char* x8;
    __device__ __forceinline__ void operator()(const f32x4 (&acc)[2][2][4][2], const Unit& u, int wr, int wc, int fr, int fq) const {
        const int row0 = u.pm * BM + wr * 64 + fr, col0 = u.pn * BM + wc * 32 + 8 * fq; const int slot = u.pn * 4 + wc;
#pragma unroll
        for (int ai = 0; ai < 2; ++ai)
#pragma unroll
            for (int m = 0; m < 4; ++m) { const int r = row0 + ai * HALF + m * 16; bf16_t* rowp = xb + (size_t)r * ldc + col0;
                float s2 = 0.f, f0 = 0.f, f1 = 0.f, f2 = 0.f, f3 = 0.f;
#pragma unroll
                for (int bj = 0; bj < 2; ++bj) { const u32x4 xw = *(const u32x4*)(rowp + bj * HALF);
                    float v[8];
                    v[0] = fmaf(acc[ai][bj][m][0][0], ascale, __builtin_bit_cast(float, xw.x << 16)); v[1] = fmaf(acc[ai][bj][m][0][1], ascale, __builtin_bit_cast(float, xw.x & 0xffff0000u));
                    v[2] = fmaf(acc[ai][bj][m][0][2], ascale, __builtin_bit_cast(float, xw.y << 16)); v[3] = fmaf(acc[ai][bj][m][0][3], ascale, __builtin_bit_cast(float, xw.y & 0xffff0000u));
                    v[4] = fmaf(acc[ai][bj][m][1][0], ascale, __builtin_bit_cast(float, xw.z << 16)); v[5] = fmaf(acc[ai][bj][m][1][1], ascale, __builtin_bit_cast(float, xw.z & 0xffff0000u));
                    v[6] = fmaf(acc[ai][bj][m][1][2], ascale, __builtin_bit_cast(float, xw.w << 16)); v[7] = fmaf(acc[ai][bj][m][1][3], ascale, __builtin_bit_cast(float, xw.w & 0xffff0000u));
                    u32x4 w; w.x = cvt_pk_bf16(v[0], v[1]); w.y = cvt_pk_bf16(v[2], v[3]); w.z = cvt_pk_bf16(v[4], v[5]); w.w = cvt_pk_bf16(v[6], v[7]);
                    st16_wt(rowp + bj * HALF, w);
                    if (x8) { u32x2_t q; q.x = pk4_fp8(v[0], v[1], v[2], v[3]); q.y = pk4_fp8(v[4], v[5], v[6], v[7]); st8_wt(x8 + (size_t)r * ldc + col0 + bj * HALF, q); }
#pragma unroll
                    for (int i = 0; i < 8; ++i) s2 = fmaf(v[i], v[i], s2);
                    if (wfd) {
#pragma unroll
                        for (int i = 0; i < 8; ++i) { const f32x4 wv = *(const f32x4*)(wfd + (size_t)(col0 + bj * HALF + i) * 4); f0 += v[i] * wv[0]; f1 += v[i] * wv[1]; f2 += v[i] * wv[2]; f3 += v[i] * wv[3]; } } }
                s2 += __shfl_xor(s2, 16); s2 += __shfl_xor(s2, 32);
                if (wfd) { f0 += __shfl_xor(f0, 16); f0 += __shfl_xor(f0, 32); f1 += __shfl_xor(f1, 16); f1 += __shfl_xor(f1, 32); f2 += __shfl_xor(f2, 16); f2 += __shfl_xor(f2, 32); f3 += __shfl_xor(f3, 16); f3 += __shfl_xor(f3, 32); }
                if (fq == 0) { ss[(size_t)r * 16 + slot] = s2; if (wfd) { float* fp = fdp + (size_t)r * 64 + slot; fp[0] = f0; fp[16] = f1; fp[32] = f2; fp[48] = f3; } } }
    }
};
struct EpiSwiGLU {
    static constexpr bool PERM = true, AFTER_DRAIN = false;
    unsigned char* O; int ldc; const float* rstd; PG8_LAS float* rsl; float ascale, oscale;
    __device__ __forceinline__ void operator()(const f32x4 (&acc)[2][2][4][2], const Unit& u, int wr, int wc, int fr, int fq) const {
        const int row0 = u.pm * BM + wr * 64 + fr, col0 = u.pn * HALF + wc * 32 + 8 * fq;
        const PG8_LAS float* sc = rsl + u.ui * 256 + wr * 64;
#pragma unroll
        for (int ai = 0; ai < 2; ++ai)
#pragma unroll
            for (int m = 0; m < 4; ++m) { const int r = row0 + ai * HALF + m * 16; const float s = sc[ai * HALF + m * 16 + fr] * ascale; unsigned char* rowp = O + (size_t)r * ldc + col0;
                const float sn = -1.4426950408889634f * s, su = s * oscale;
                float a[8];
#pragma unroll
                for (int n = 0; n < 2; ++n)
#pragma unroll
                    for (int i = 0; i < 4; ++i) { const float ag = acc[ai][0][m][n][i], au = acc[ai][1][m][n][i];
                        const float sg = __builtin_amdgcn_rcpf(1.0f + __builtin_amdgcn_exp2f(ag * sn)); a[4 * n + i] = (ag * s) * sg * (au * su); }
                u32x2_t w; w.x = pk4_fp8(a[0], a[1], a[2], a[3]); w.y = pk4_fp8(a[4], a[5], a[6], a[7]);
                st8_wt(rowp, w); }
    }
};

template <class Epi, class Sched, bool ALIGN_EPI = false, bool SP2 = false, bool F8 = false>
__device__ __forceinline__ void gemm_phase(PG8_LAS unsigned char* lds, const Gemm g, const Sched& S, const Epi& E) {
    const int tid = threadIdx.x, wid = __builtin_amdgcn_readfirstlane(tid >> 6), lane = tid & 63, wr = wid >> 2, wc = wid & 3, fr = lane & 15, fq = lane >> 4;
    const int KB = F8 ? g.K : 2 * g.K, nt = KB / (BK * 2);
    unsigned voffA[2], voffB[2];
#pragma unroll
    for (int i = 0; i < 2; ++i) { int R, C; stage_rc(tid * 16 + i * 8192, R, C); const int Rb = Epi::PERM ? ((R & ~31) + perm32(R & 31)) : R;
        voffA[i] = (unsigned)(R * KB + C * 2); voffB[i] = (unsigned)(Rb * KB + C * 2); }
    const size_t kstep = (size_t)(BK * 2);
    const size_t hstep = (size_t)HALF * KB;
    const size_t tstep = 2 * hstep;
    const unsigned ldsw = (unsigned)wid * 1024u;
    int aoffk[2], boffk[2];
#pragma unroll
    for (int k = 0; k < 2; ++k) { const int c = F8 ? 16 * fq + 8 * k : fq * 8 + 32 * k; aoffk[k] = lds_byte(wr * 64 + fr, c); boffk[k] = lds_byte(wc * 32 + fr, c); }
#define PG8_SA(b, h) (((b) * 2 + (h)) * HTB)
#define PG8_SB(b, h) ((4 + (b) * 2 + (h)) * HTB)
#define PG8_STAGE(bufoff, gbase, voff) do { _Pragma("unroll") for (int _i = 0; _i < 2; ++_i) \
        __builtin_amdgcn_global_load_lds((const unsigned*)((const char*)(gbase) + (voff)[_i]), (PG8_LAS unsigned*)(lds + (bufoff) + ldsw + _i * 8192), 16, 0, 0); } while (0)
#define PG8_LDA(dst, b, h) do { _Pragma("unroll") for (int m = 0; m < 4; ++m) _Pragma("unroll") for (int k = 0; k < 2; ++k) dst[m][k] = *(const PG8_LAS bf16x8*)(lds + PG8_SA(b, h) + aoffk[k] + m * 2048); } while (0)
#define PG8_LDA8(dst, b, h) do { _Pragma("unroll") for (int m = 0; m < 4; ++m) { const i32x4_t lo_ = *(const PG8_LAS i32x4_t*)(lds + PG8_SA(b, h) + aoffk[0] + m * 2048), hi_ = *(const PG8_LAS i32x4_t*)(lds + PG8_SA(b, h) + aoffk[1] + m * 2048); dst[m] = __builtin_shufflevector(lo_, hi_, 0, 1, 2, 3, 4, 5, 6, 7); } } while (0)
#define PG8_LDB(dst, b, h) do { _Pragma("unroll") for (int n = 0; n < 2; ++n) _Pragma("unroll") for (int k = 0; k < 2; ++k) dst[n][k] = *(const PG8_LAS bf16x8*)(lds + PG8_SB(b, h) + boffk[k] + n * 2048); } while (0)
#define PG8_LDB8(dst, b, h) do { _Pragma("unroll") for (int n = 0; n < 2; ++n) { const i32x4_t lo_ = *(const PG8_LAS i32x4_t*)(lds + PG8_SB(b, h) + boffk[0] + n * 2048), hi_ = *(const PG8_LAS i32x4_t*)(lds + PG8_SB(b, h) + boffk[1] + n * 2048); dst[n] = __builtin_shufflevector(lo_, hi_, 0, 1, 2, 3, 4, 5, 6, 7); } } while (0)
#define PG8_MMA(ai, bj, At, Bt) do { __builtin_amdgcn_s_setprio(1); _Pragma("unroll") for (int m = 0; m < 4; ++m) _Pragma("unroll") for (int n = 0; n < 2; ++n) _Pragma("unroll") for (int k = 0; k < 2; ++k) \
        acc[ai][bj][m][n] = __builtin_amdgcn_mfma_f32_16x16x32_bf16(Bt[n][k], At[m][k], acc[ai][bj][m][n], 0, 0, 0); __builtin_amdgcn_s_setprio(0); } while (0)
#define PG8_MMA8(ai, bj, At, Bt) do { __builtin_amdgcn_sched_barrier(0); __builtin_amdgcn_s_setprio(1); _Pragma("unroll") for (int m = 0; m < 4; ++m) _Pragma("unroll") for (int n = 0; n < 2; ++n) \
        acc[ai][bj][m][n] = __builtin_amdgcn_mfma_scale_f32_16x16x128_f8f6f4(Bt[n], At[m], acc[ai][bj][m][n], 0, 0, 0, 0x7f7f7f7f, 0, 0x7f7f7f7f); __builtin_amdgcn_s_setprio(0); \
        asm volatile("" : "+v"(acc[ai][bj][0][0]), "+v"(acc[ai][bj][0][1]), "+v"(acc[ai][bj][1][0]), "+v"(acc[ai][bj][1][1]), "+v"(acc[ai][bj][2][0]), "+v"(acc[ai][bj][2][1]), "+v"(acc[ai][bj][3][0]), "+v"(acc[ai][bj][3][1])); \
        __builtin_amdgcn_sched_barrier(0); } while (0)
#define PG8_LDAx(b, h) do { if constexpr (F8) PG8_LDA8(At8, b, h); else PG8_LDA(At, b, h); } while (0)
#define PG8_LDBx(w, b, h) do { if constexpr (F8) { if ((w) == 0) PG8_LDB8(B08, b, h); else PG8_LDB8(B18, b, h); } else { if ((w) == 0) PG8_LDB(B0, b, h); else PG8_LDB(B1, b, h); } } while (0)
#define PG8_MMAx(ai, bj, w) do { if constexpr (F8) { if ((w) == 0) PG8_MMA8(ai, bj, At8, B08); else PG8_MMA8(ai, bj, At8, B18); } else { if ((w) == 0) PG8_MMA(ai, bj, At, B0); else PG8_MMA(ai, bj, At, B1); } } while (0)
#define PG8_WAIT_V(n) asm volatile("s_waitcnt vmcnt(" #n ")" ::: "memory")
#define PG8_WAIT_L(n) asm volatile("s_waitcnt lgkmcnt(" #n ")" ::: "memory")
#define PG8_BAR __builtin_amdgcn_s_barrier()
#define PG8_SCHED __builtin_amdgcn_sched_barrier(0)
    Unit cur, nxt; int ui = 0;
    if (!S.next(0, cur)) return;
    f32x4 acc[2][2][4][2];
#pragma unroll
    for (int a = 0; a < 2; ++a)
#pragma unroll
        for (int b = 0; b < 2; ++b)
#pragma unroll
            for (int m = 0; m < 4; ++m)
#pragma unroll
                for (int n = 0; n < 2; ++n) acc[a][b][m][n] = (f32x4){0.f, 0.f, 0.f, 0.f};
    bf16x8 At[4][2], B0[2][2], B1[2][2]; i32x8_t At8[4], B08[2], B18[2];
    const char* cA = (const char*)g.A + (size_t)cur.pm * tstep; const char* cB = (const char*)g.Bt + (size_t)cur.pn * tstep;
    S.a_ready(cur);
    if constexpr (SP2) {
        PG8_STAGE(PG8_SB(0, 0), cB, voffB); PG8_STAGE(PG8_SB(0, 1), cB + hstep, voffB); PG8_STAGE(PG8_SA(0, 0), cA, voffA); PG8_STAGE(PG8_SA(0, 1), cA + hstep, voffA);
        if (wr == 1) PG8_BAR;
        PG8_WAIT_V(2); PG8_BAR;
        PG8_STAGE(PG8_SB(1, 0), cB + kstep, voffB); PG8_STAGE(PG8_SA(1, 0), cA + kstep, voffA); PG8_STAGE(PG8_SB(1, 1), cB + hstep + kstep, voffB);
        PG8_WAIT_V(6); PG8_BAR;
    } else {
        PG8_STAGE(PG8_SB(0, 0), cB, voffB); PG8_STAGE(PG8_SA(0, 0), cA, voffA); PG8_STAGE(PG8_SB(0, 1), cB + hstep, voffB); PG8_STAGE(PG8_SA(0, 1), cA + hstep, voffA);
        if (wr == 1) PG8_BAR;
        PG8_WAIT_V(4); PG8_BAR;
        PG8_STAGE(PG8_SB(1, 0), cB + kstep, voffB); PG8_STAGE(PG8_SA(1, 0), cA + kstep, voffA); PG8_STAGE(PG8_SB(1, 1), cB + hstep + kstep, voffB);
        PG8_WAIT_V(6); PG8_BAR;
    }
    for (;;) {
        const bool has_next = S.next(ui + 1, nxt);
        const char* nA = has_next ? (const char*)g.A + (size_t)nxt.pm * tstep : cA; const char* nB = has_next ? (const char*)g.Bt + (size_t)nxt.pn * tstep : cB;
        for (int t = 0; t < nt; t += 2) {
            const bool last = (t == nt - 2);
            const char* a1 = cA + (size_t)(t + 1) * kstep;
            const char* a2 = last ? nA : cA + (size_t)(t + 2) * kstep; const char* b2 = last ? nB : cB + (size_t)(t + 2) * kstep;
            const char* a3 = a2 + kstep; const char* b3 = b2 + kstep;
            if (last && has_next) S.a_ready(nxt);
            if constexpr (SP2) {
            PG8_LDBx(0, 0, 0); PG8_LDBx(1, 0, 1); PG8_SCHED; PG8_LDAx(0, 0); PG8_STAGE(PG8_SA(1, 1), a1 + hstep, voffA);
            PG8_WAIT_V(8); PG8_WAIT_L(0); PG8_BAR; PG8_MMAx(0, 0, 0); PG8_MMAx(0, 1, 1); PG8_BAR; PG8_SCHED;
            PG8_LDAx(0, 1); PG8_STAGE(PG8_SB(0, 0), b2, voffB); PG8_STAGE(PG8_SB(0, 1), b2 + hstep, voffB); PG8_STAGE(PG8_SA(0, 0), a2, voffA);
            PG8_WAIT_V(8); PG8_WAIT_L(0); PG8_BAR; PG8_MMAx(1, 0, 0); PG8_MMAx(1, 1, 1); PG8_BAR; PG8_SCHED;
            PG8_LDBx(0, 1, 0); PG8_LDBx(1, 1, 1); PG8_SCHED; PG8_LDAx(1, 0); PG8_STAGE(PG8_SA(0, 1), a2 + hstep, voffA);
            PG8_WAIT_V(8); PG8_WAIT_L(0); PG8_BAR; PG8_MMAx(0, 0, 0); PG8_MMAx(0, 1, 1); PG8_BAR; PG8_SCHED;
            PG8_LDAx(1, 1); PG8_STAGE(PG8_SB(1, 0), b3, voffB); PG8_STAGE(PG8_SB(1, 1), b3 + hstep, voffB); PG8_STAGE(PG8_SA(1, 0), a3, voffA);
            PG8_WAIT_V(8); PG8_WAIT_L(0); PG8_BAR; PG8_MMAx(1, 0, 0); PG8_MMAx(1, 1, 1); PG8_BAR; PG8_SCHED;
            } else {
            PG8_LDBx(0, 0, 0); PG8_SCHED; PG8_LDAx(0, 0); PG8_STAGE(PG8_SA(1, 1), a1 + hstep, voffA);
            PG8_WAIT_L(8); PG8_BAR; PG8_WAIT_L(0); PG8_MMAx(0, 0, 0); PG8_BAR; PG8_SCHED;
            PG8_LDBx(1, 0, 1); PG8_STAGE(PG8_SB(0, 0), b2, voffB);
            PG8_BAR; PG8_WAIT_L(0); PG8_MMAx(0, 1, 1); PG8_BAR;
            PG8_LDAx(0, 1); PG8_STAGE(PG8_SA(0, 0), a2, voffA);
            PG8_BAR; PG8_WAIT_L(0); PG8_MMAx(1, 0, 0); PG8_BAR; PG8_SCHED;
            PG8_STAGE(PG8_SB(0, 1), b2 + hstep, voffB);
            PG8_WAIT_V(6); PG8_BAR; PG8_MMAx(1, 1, 1); PG8_BAR;
            PG8_LDBx(0, 1, 0); PG8_SCHED; PG8_LDAx(1, 0); PG8_STAGE(PG8_SA(0, 1), a2 + hstep, voffA);
            PG8_WAIT_L(8); PG8_BAR; PG8_WAIT_L(0); PG8_MMAx(0, 0, 0); PG8_BAR; PG8_SCHED;
            PG8_LDBx(1, 1, 1); PG8_STAGE(PG8_SB(1, 0), b3, voffB);
            PG8_BAR; PG8_WAIT_L(0); PG8_MMAx(0, 1, 1); PG8_BAR;
            PG8_LDAx(1, 1); PG8_STAGE(PG8_SA(1, 0), a3, voffA);
            PG8_BAR; PG8_WAIT_L(0); PG8_MMAx(1, 0, 0); PG8_BAR; PG8_SCHED;
            PG8_STAGE(PG8_SB(1, 1), b3 + hstep, voffB);
            PG8_WAIT_V(6); PG8_BAR; PG8_MMAx(1, 1, 1); PG8_BAR;
            }
        }
        if constexpr (ALIGN_EPI) { if (wr == 0) PG8_BAR; }
        if constexpr (!Epi::AFTER_DRAIN) { E(acc, cur, wr, wc, fr, fq); S.done(cur); }
        if (!has_next) break;
#pragma unroll
        for (int a = 0; a < 2; ++a)
#pragma unroll
            for (int b = 0; b < 2; ++b)
#pragma unroll
                for (int m = 0; m < 4; ++m)
#pragma unroll
                    for (int n = 0; n < 2; ++n) acc[a][b][m][n] = (f32x4){0.f, 0.f, 0.f, 0.f};
        cur = nxt; cA = nA; cB = nB; ++ui;
        if constexpr (ALIGN_EPI) { if (wr == 1) PG8_BAR; }
    }
    PG8_WAIT_V(0);
    if constexpr (!ALIGN_EPI) { if (wr == 0) PG8_BAR; }
    PG8_BAR;
    if constexpr (Epi::AFTER_DRAIN) { E.fused(acc, cur, wr, wc, fr, fq, lds, wid, lane); S.done(cur); }
#undef PG8_SA
#undef PG8_SB
#undef PG8_STAGE
#undef PG8_LDA
#undef PG8_LDB
#undef PG8_MMA
#undef PG8_MMA8
#undef PG8_LDAx
#undef PG8_LDBx
#undef PG8_MMAx
#undef PG8_LDA8
#undef PG8_LDB8
#undef PG8_WAIT_V
#undef PG8_WAIT_L
#undef PG8_BAR
#undef PG8_SCHED
}
}
namespace att {
#define ATT_LAS __attribute__((address_space(3)))
typedef short bf16x8 __attribute__((ext_vector_type(8)));
typedef short s16x4 __attribute__((ext_vector_type(4)));
typedef float f32x16 __attribute__((ext_vector_type(16)));
typedef float f32x4 __attribute__((ext_vector_type(4)));
typedef unsigned u32x4 __attribute__((ext_vector_type(4)));
typedef unsigned short bf16;
enum { T_A = 0, T_B = 1, T_C = 2, T_D = 3 };
constexpr int S = 4096, QP = 2816;
constexpr int SLOTB = 8192;
constexpr int NSLOT = 4;
constexpr int L_K = 0, L_V = NSLOT * SLOTB, L_KB = 2 * NSLOT * SLOTB, L_WS = L_KB + NSLOT * 256 + 256, L_TAB = L_WS + 2048, TAB_N = 5600, L_KM = L_TAB + TAB_N * 4, L_OST = L_KM + 4096, L_END = L_OST + 8 * 4096;
static_assert(L_TAB % 16 == 0 && L_KM % 16 == 0 && L_OST % 16 == 0 && L_END <= 131072, "attention LDS map");
constexpr float THR = 8.0f;
__device__ __forceinline__ constexpr int offr(int r) { return (r & 3) + 8 * (r >> 2); }
__device__ __forceinline__ unsigned cvtpk(float lo, float hi) { typedef float f2 __attribute__((ext_vector_type(2))); typedef __bf16 b2 __attribute__((ext_vector_type(2))); f2 v = {lo, hi}; b2 b = __builtin_convertvector(v, b2); return __builtin_bit_cast(unsigned, b); }
__device__ __forceinline__ s16x4 vtr(const ATT_LAS char* p) { typedef short v4i16_t __attribute__((ext_vector_type(4))); return __builtin_bit_cast(s16x4, __builtin_amdgcn_ds_read_tr16_b64_v4i16((ATT_LAS v4i16_t*)p)); }
__device__ __forceinline__ float xhalf_max(float v) { auto rr = __builtin_amdgcn_permlane32_swap(__float_as_uint(v), __float_as_uint(v), false, false); return fmaxf(__uint_as_float(rr[0]), __uint_as_float(rr[1])); }
__device__ __forceinline__ float xhalf_sum(float v) { auto rr = __builtin_amdgcn_permlane32_swap(__float_as_uint(v), __float_as_uint(v), false, false); return __uint_as_float(rr[0]) + __uint_as_float(rr[1]); }

__device__ __forceinline__ void glds16(const void* gsrc, unsigned lds_dst) { unsigned keep;
    asm volatile("s_mov_b32 %0, m0\n\ts_mov_b32 m0, %2\n\ts_nop 0\n\tglobal_load_lds_dwordx4 %1, off\n\ts_mov_b32 m0, %0" : "=&s"(keep) : "v"(gsrc), "s"(lds_dst) : "memory"); }
__device__ __forceinline__ void glds4(const void* gsrc, unsigned lds_dst) { unsigned keep;
    asm volatile("s_mov_b32 %0, m0\n\ts_mov_b32 m0, %2\n\ts_nop 0\n\tglobal_load_lds_dword %1, off\n\ts_mov_b32 m0, %0" : "=&s"(keep) : "v"(gsrc), "s"(lds_dst) : "memory"); }

template <int TYPE>
__device__ __forceinline__ void attn_item(ATT_LAS unsigned char* lds, const bf16* qkv, int b, int h, int qb, int res, int dil_rt, int W_rt, int qcol_rt, int kcol_rt, int vcol_rt, const float* tabg, int tab_id, int& cur_tab, const float* c2bh, const unsigned* nrm, const float* kmbh, float sink2,
                                          bf16* outp, int ldo, float* lse_out) {
    const int tid = threadIdx.x, lane = tid & 63, r32 = lane & 31, hi = lane >> 5; const int wid = __builtin_amdgcn_readfirstlane(tid >> 6);
    constexpr bool BAND = (TYPE == T_A);
    const int W = W_rt; const int DIL = BAND ? dil_rt : 1;
    const int qcol = BAND ? qcol_rt : (TYPE == T_B ? 768 : 2048) + 64 * h;
    const int kcol = BAND ? kcol_rt : (TYPE == T_B ? 1024 : 2304) + 64 * h;
    const int vcol = BAND ? vcol_rt : (TYPE == T_B ? 1280 : 2560) + 64 * h;
    const size_t rowbase = (size_t)b * S + res;
    const int qf0 = 256 * qb, qfw = qf0 + 32 * wid;
    const int kf0 = BAND ? qf0 - 128 : 0, NT = BAND ? 6 : 4 * (qb + 1);
    int tlo = (BAND && qb == 0) ? 2 : 0;
    if (TYPE == T_D) {
        const float qm = __uint_as_float(nrm[0]) + __uint_as_float(nrm[1]), kmx = __uint_as_float(nrm[2]) + __uint_as_float(nrm[3]);
        const float bound = 2.0f * sqrtf(qm * kmx) * 1.01f + 42.0f;
        const float c0 = c2bh[qf0];
        const bool skip = (lane < 4 * qb) && (c0 - c2bh[64 * (lane < 4 * qb ? lane : 0) + 63] < -bound);
        tlo = __builtin_popcountll(__ballot(skip));
    }
    ATT_LAS float* tab = (ATT_LAS float*)(lds + L_TAB);
    ATT_LAS float* km = (ATT_LAS float*)(lds + L_KM);
    ATT_LAS float* wsf = (ATT_LAS float*)(lds + L_WS) + wid * 64;
    const unsigned lds0 = (unsigned)(uintptr_t)lds;
#define ATT_ISSUE(t) do { const int k0_ = kf0 + 64 * (t); const int sl_ = ((t) - tlo) % NSLOT; int kk_ = k0_ + lane; kk_ = kk_ < 0 ? 0 : kk_; \
        glds16(qkv + (rowbase + (size_t)kk_ * DIL) * QP + kcol + wid * 8, (unsigned)__builtin_amdgcn_readfirstlane(lds0 + L_K + sl_ * SLOTB + wid * 1024)); \
        int kv_ = k0_ + 16 * (wid & 3) + (lane >> 2); kv_ = kv_ < 0 ? 0 : kv_; \
        glds16(qkv + (rowbase + (size_t)kv_ * DIL) * QP + vcol + (wid >> 2) * 32 + (lane & 3) * 8, (unsigned)__builtin_amdgcn_readfirstlane(lds0 + L_V + sl_ * SLOTB + wid * 1024)); \
        if (TYPE == T_D) glds4(c2bh + k0_ + lane, (unsigned)__builtin_amdgcn_readfirstlane(lds0 + L_KB + sl_ * 256)); } while (0)
    if (TYPE != T_D) { if (tab_id != cur_tab) { cur_tab = tab_id;
            for (int i = tid; i < TAB_N; i += 512) tab[i] = (i < 4096) ? tabg[4095 - i] : 0.f; } }
    if (TYPE == T_B) { for (int i = tid; i < 16 * 64; i += 512) km[i] = kmbh[i]; }
    bf16x8 qr[4];
    { const bf16* qrow = qkv + (rowbase + (size_t)(qfw + r32) * DIL) * QP + qcol;
#pragma unroll
      for (int d0 = 0; d0 < 4; ++d0) qr[d0] = *(const bf16x8*)(qrow + 16 * d0 + 8 * hi); }
    const float cq = (TYPE == T_D) ? c2bh[qfw + r32] : 0.f;
    ATT_ISSUE(tlo); if (tlo + 1 < NT) ATT_ISSUE(tlo + 1); if (tlo + 2 < NT) ATT_ISSUE(tlo + 2);
    asm volatile("s_waitcnt vmcnt(0)" ::: "memory");
    __syncthreads();
    unsigned sel = 0u;
    if (TYPE == T_B) {
        float g[16];
#pragma unroll
        for (int n = 0; n < 16; ++n) { g[n] = -INFINITY; if (n < qb) { float s = 0.f;
#pragma unroll
                for (int d0 = 0; d0 < 4; ++d0) { const f32x4 a = *(const ATT_LAS f32x4*)(km + n * 64 + 16 * d0 + 8 * hi), c = *(const ATT_LAS f32x4*)(km + n * 64 + 16 * d0 + 8 * hi + 4);
                    const bf16x8 qv = qr[d0];
                    s = fmaf(__builtin_bit_cast(float, (unsigned)(unsigned short)qv[0] << 16), a[0], s); s = fmaf(__builtin_bit_cast(float, (unsigned)(unsigned short)qv[1] << 16), a[1], s);
                    s = fmaf(__builtin_bit_cast(float, (unsigned)(unsigned short)qv[2] << 16), a[2], s); s = fmaf(__builtin_bit_cast(float, (unsigned)(unsigned short)qv[3] << 16), a[3], s);
                    s = fmaf(__builtin_bit_cast(float, (unsigned)(unsigned short)qv[4] << 16), c[0], s); s = fmaf(__builtin_bit_cast(float, (unsigned)(unsigned short)qv[5] << 16), c[1], s);
                    s = fmaf(__builtin_bit_cast(float, (unsigned)(unsigned short)qv[6] << 16), c[2], s); s = fmaf(__builtin_bit_cast(float, (unsigned)(unsigned short)qv[7] << 16), c[3], s); }
                g[n] = xhalf_sum(s); } }
#pragma unroll
        for (int r = 0; r < 3; ++r) { float best = -INFINITY; int bi = -1;
#pragma unroll
            for (int n = 0; n < 16; ++n) if (n < qb && !((sel >> n) & 1u) && g[n] > best) { best = g[n]; bi = n; }
            if (bi >= 0) sel |= 1u << bi; }
    }
    float m = 0.f, l = 0.f; f32x16 o[2]; o[0] = f32x16{}; o[1] = f32x16{};
    const int vpo = ((lane >> 4) & 1) * 32 + (lane & 3) * 8 + (4 * hi + ((lane & 15) >> 2)) * 64;
    f32x16 p0 = f32x16{}, p1 = f32x16{}; u32x4 pw[4] = {u32x4{}, u32x4{}, u32x4{}, u32x4{}};
    const int hb = wid >> 2;
#define ATT_BAR(N) asm volatile("s_waitcnt vmcnt(" #N ") lgkmcnt(0)\n\ts_barrier" ::: "memory")
#define ATT_ACTIVE(T, ACT, PICK) do { const int k0_ = kf0 + 64 * (T); PICK = true; \
        if (BAND) ACT = (k0_ <= qfw + 31) && (k0_ + 63 >= qfw - W); \
        else if (TYPE == T_B) { const bool past_ = k0_ < qf0; PICK = past_ ? ((sel >> (k0_ >> 8)) & 1u) : true; ACT = past_ ? (__ballot(PICK) != 0ull) : (k0_ <= qfw + 31); } \
        else ACT = (k0_ <= qfw + 31); } while (0)
#define ATT_LDK(T, KF) do { const int sl_ = ((T) - tlo) % NSLOT; const ATT_LAS char* kb_ = (const ATT_LAS char*)(lds + L_K + sl_ * SLOTB) + hi * 1024 + r32 * 16; \
        _Pragma("unroll") for (int d0 = 0; d0 < 4; ++d0) { KF[2 * d0] = *(const ATT_LAS bf16x8*)(kb_ + d0 * 2048); KF[2 * d0 + 1] = *(const ATT_LAS bf16x8*)(kb_ + d0 * 2048 + 512); } } while (0)
#define ATT_LDV(T, D0, VF) do { const int sl_ = ((T) - tlo) % NSLOT; const ATT_LAS char* vp = (const ATT_LAS char*)(lds + L_V + sl_ * SLOTB) + vpo; \
        _Pragma("unroll") for (int ks = 0; ks < 4; ++ks) { const s16x4 lo = vtr(vp + (D0) * 4096 + ks * 1024), hh = vtr(vp + (D0) * 4096 + ks * 1024 + 512); \
            VF[ks] = (bf16x8){lo[0], lo[1], lo[2], lo[3], hh[0], hh[1], hh[2], hh[3]}; } } while (0)
#define ATT_QK(KF, P0, P1, PICK) do { \
        f32x16 ci_; { const float c_ = (TYPE == T_B && !(PICK)) ? -INFINITY : cq - m; _Pragma("unroll") for (int r = 0; r < 16; ++r) ci_[r] = c_; } \
        _Pragma("unroll") for (int d0 = 0; d0 < 4; ++d0) { \
            if (d0 == 0) { P0 = __builtin_amdgcn_mfma_f32_32x32x16_bf16(KF[0], qr[0], ci_, 0, 0, 0); P1 = __builtin_amdgcn_mfma_f32_32x32x16_bf16(KF[1], qr[0], ci_, 0, 0, 0); } \
            else { P0 = __builtin_amdgcn_mfma_f32_32x32x16_bf16(KF[2 * d0], qr[d0], P0, 0, 0, 0); P1 = __builtin_amdgcn_mfma_f32_32x32x16_bf16(KF[2 * d0 + 1], qr[d0], P1, 0, 0, 0); } } } while (0)
#define ATT_MOD(T, P0, P1) do { const int sl_ = ((T) - tlo) % NSLOT; const int k0 = kf0 + 64 * (T); \
        const int d0l = qfw + r32 - k0 - 4 * hi; \
        if (TYPE != T_D) { \
            if (TYPE == T_B && qfw - k0 - 63 >= 1513) { const float bfar = tab[0]; \
                _Pragma("unroll") for (int r = 0; r < 16; ++r) { P0[r] += bfar; P1[r] += bfar; } \
            } else { const ATT_LAS float* tb = tab + (4095 - DIL * d0l); \
                _Pragma("unroll") for (int r = 0; r < 16; ++r) { P0[r] += tb[DIL * offr(r)]; P1[r] += tb[DIL * (offr(r) + 32)]; } } \
        } else { const ATT_LAS float* cb = (const ATT_LAS float*)(lds + L_KB + sl_ * 256) + 4 * hi; \
            _Pragma("unroll") for (int i = 0; i < 4; ++i) { const f32x4 c0 = *(const ATT_LAS f32x4*)(cb + 8 * i), c1 = *(const ATT_LAS f32x4*)(cb + 8 * i + 32); \
                _Pragma("unroll") for (int j = 0; j < 4; ++j) { P0[4 * i + j] -= c0[j]; P1[4 * i + j] -= c1[j]; } } } \
        if (k0 + 63 > qfw) { _Pragma("unroll") for (int r = 0; r < 16; ++r) { if (d0l - offr(r) < 0) P0[r] = -INFINITY; if (d0l - offr(r) - 32 < 0) P1[r] = -INFINITY; } } \
        if (BAND) { if (qfw + 31 - k0 > W) { _Pragma("unroll") for (int r = 0; r < 16; ++r) { if (d0l - offr(r) > W) P0[r] = -INFINITY; if (d0l - offr(r) - 32 > W) P1[r] = -INFINITY; } } } \
        float rm = fmaxf(P0[0], P1[0]), rm2 = fmaxf(P0[1], P1[1]); \
        _Pragma("unroll") for (int r = 2; r < 16; r += 2) { rm = fmaxf(fmaxf(rm, P0[r]), P1[r]); rm2 = fmaxf(fmaxf(rm2, P0[r + 1]), P1[r + 1]); } \
        rm = xhalf_max(fmaxf(rm, rm2)); \
        if (__ballot(rm > THR) != 0ull) { const float dl = fmaxf(rm, 0.f); m += dl; \
            _Pragma("unroll") for (int r = 0; r < 16; ++r) { P0[r] -= dl; P1[r] -= dl; } \
            const float f = EX2(-dl); l *= f; \
            if (hi == 0) wsf[r32] = f; \
            asm volatile("s_waitcnt lgkmcnt(0)" ::: "memory"); \
            _Pragma("unroll") for (int i = 0; i < 4; ++i) { const f32x4 fr = *(const ATT_LAS f32x4*)(wsf + 8 * i + 4 * hi); \
                _Pragma("unroll") for (int j = 0; j < 4; ++j) { o[0][4 * i + j] *= fr[j]; o[1][4 * i + j] *= fr[j]; } } } } while (0)
#define ATT_EXP(P0, P1, PW) do { float sacc = 0.f; \
        _Pragma("unroll") for (int r = 0; r < 16; ++r) { P0[r] = EX2(P0[r]); P1[r] = EX2(P1[r]); sacc += P0[r] + P1[r]; } \
        l += sacc; \
        _Pragma("unroll") for (int i = 0; i < 4; ++i) { PW[0][i] = cvtpk(P0[2 * i], P0[2 * i + 1]); PW[1][i] = cvtpk(P0[8 + 2 * i], P0[9 + 2 * i]); PW[2][i] = cvtpk(P1[2 * i], P1[2 * i + 1]); PW[3][i] = cvtpk(P1[8 + 2 * i], P1[9 + 2 * i]); } } while (0)
#define ATT_PV(D0, VF, PW) do { \
        _Pragma("unroll") for (int ks = 0; ks < 4; ++ks) o[D0] = __builtin_amdgcn_mfma_f32_32x32x16_bf16(__builtin_bit_cast(bf16x8, PW[ks]), VF[ks], o[D0], 0, 0, 0); } while (0)
    bool actC, pick0; ATT_ACTIVE(tlo, actC, pick0);
    if (actC) { bf16x8 kf0_[8]; ATT_LDK(tlo, kf0_); ATT_QK(kf0_, p0, p1, pick0); ATT_MOD(tlo, p0, p1); if (hb == 1) ATT_EXP(p0, p1, pw); }
    for (int t = tlo; t < NT; ++t) {
        const bool more1 = t + 1 < NT, more3 = t + 3 < NT;
        if (more3) ATT_ISSUE(t + 3);
        bool actN = false, pickN = true; if (more1) ATT_ACTIVE(t + 1, actN, pickN);
        bf16x8 kf[8], vf[4], vg[4];
        if (actC) ATT_LDV(t, 0, vf);
        __builtin_amdgcn_sched_barrier(0);
        if (hb == 0) { if (actC) ATT_EXP(p0, p1, pw); }
        if (actN) { ATT_LDK(t + 1, kf); ATT_QK(kf, p0, p1, pickN); }
        if (actC) { ATT_LDV(t, 1, vg); __builtin_amdgcn_sched_barrier(0); ATT_PV(0, vf, pw); ATT_PV(1, vg, pw); }
        if (actN) { ATT_MOD(t + 1, p0, p1); if (hb == 1) ATT_EXP(p0, p1, pw); }
        if (more3) { if (TYPE == T_D) ATT_BAR(3); else ATT_BAR(2); }
        else ATT_BAR(0);
        actC = actN;
    }
#undef ATT_BAR
#undef ATT_ACTIVE
#undef ATT_QK
#undef ATT_LDK
#undef ATT_LDV
#undef ATT_MOD
#undef ATT_EXP
#undef ATT_PV
    l = xhalf_sum(l);
    if (BAND) l += EX2(sink2 - m);
    if (hi == 0) wsf[32 + r32] = 1.0f / l;
    asm volatile("s_waitcnt lgkmcnt(0)" ::: "memory");
    {   ATT_LAS bf16* stg = (ATT_LAS bf16*)(lds + L_OST) + wid * 2048;
#pragma unroll
        for (int i = 0; i < 4; ++i) { const f32x4 rl = *(const ATT_LAS f32x4*)(wsf + 32 + 8 * i + 4 * hi);
#pragma unroll
            for (int j = 0; j < 4; ++j) { const int orow = 8 * i + 4 * hi + j;
#pragma unroll
                for (int d0 = 0; d0 < 2; ++d0) { const unsigned w = cvtpk(o[d0][4 * i + j] * rl[j], 0.f); stg[orow * 64 + d0 * 32 + r32] = (bf16)(w & 0xffffu); } } }
        asm volatile("s_waitcnt lgkmcnt(0)" ::: "memory");
#pragma unroll
        for (int i = 0; i < 4; ++i) { const int row = i * 8 + (lane >> 3), ch = lane & 7; const u32x4 v = *(const ATT_LAS u32x4*)(stg + row * 64 + ch * 8);
            *(u32x4*)(outp + (rowbase + (size_t)(qfw + row) * DIL) * ldo + ch * 8) = v; }
    }
    if (BAND) { if (lse_out != nullptr && hi == 0) lse_out[(rowbase + (size_t)(qfw + r32) * DIL) * 4] = m + __builtin_amdgcn_logf(l); }
    __syncthreads();
#undef ATT_ISSUE
}
}

namespace att2 {
#define A2_LAS __attribute__((address_space(3)))
typedef att::bf16x8 bf16x8; typedef att::s16x4 s16x4; typedef att::f32x16 f32x16; typedef att::f32x4 f32x4; typedef att::u32x4 u32x4; typedef unsigned short bf16;
enum { T_B = 1, T_D = 3 };
constexpr int S = 4096, QP = 2816, NW = 8, QBLK = 32, QB = 256, KVBLK = 64;
constexpr int NSLOT = 3, SLOTB = 8192;
constexpr int L_K = 0, L_V = NSLOT * SLOTB, L_WS = 2 * NSLOT * SLOTB, L_OST = L_WS + NW * 64 * 4, L_TAB = L_OST + NW * 4096, TAB_N = 5600, TAB_PADN = 96, L_KM = L_TAB + (TAB_N + TAB_PADN) * 4, L_END = L_KM + 4096;
static_assert(L_TAB % 16 == 0 && L_KM % 16 == 0 && L_END <= 131072, "attention engine 2 LDS map");
constexpr float THR = 8.0f;
typedef A2_LAS const char* lds_cptr;
#define A2_MX3(a, b, c) __builtin_fmaxf(__builtin_fmaxf((a), (b)), (c))
__device__ __forceinline__ void kload8(bf16x8* kf, lds_cptr kp) {
    kf[0] = *(const A2_LAS bf16x8*)(kp);        kf[1] = *(const A2_LAS bf16x8*)(kp + 512);  kf[2] = *(const A2_LAS bf16x8*)(kp + 2048); kf[3] = *(const A2_LAS bf16x8*)(kp + 2560);
    kf[4] = *(const A2_LAS bf16x8*)(kp + 4096); kf[5] = *(const A2_LAS bf16x8*)(kp + 4608); kf[6] = *(const A2_LAS bf16x8*)(kp + 6144); kf[7] = *(const A2_LAS bf16x8*)(kp + 6656);
}
__device__ __forceinline__ void kload2(bf16x8* kf, lds_cptr kp, int j) { kf[2 * j] = *(const A2_LAS bf16x8*)(kp + j * 2048); kf[2 * j + 1] = *(const A2_LAS bf16x8*)(kp + j * 2048 + 512); }
#define A2_SBAR() __builtin_amdgcn_sched_barrier(0)
#define A2_WAIT_BAR(N) asm volatile("s_waitcnt vmcnt(" #N ") lgkmcnt(0)\n\ts_barrier" ::: "memory")
#define A2_MFMA(a, b, c) __builtin_amdgcn_mfma_f32_32x32x16_bf16(a, b, c, 0, 0, 0)

template <int TYPE>
__device__ __forceinline__ void attn_unit2(A2_LAS unsigned char* lds, const bf16* qkv, int b, int h, int qb, const float* tabg, int tab_id, int& cur_tab, const float* c2bh, const unsigned* nrm, const float* kmbh,
                                           bf16* outp, int ldo) {
    int tid_ = threadIdx.x; asm volatile("" : "+v"(tid_));
    const int tid = tid_, lane = tid & 63, r32 = lane & 31, hi = lane >> 5; const int wid = __builtin_amdgcn_readfirstlane(tid >> 6);
    const int qcol = (TYPE == T_B ? 768 : 2048) + 64 * h, kcol = (TYPE == T_B ? 1024 : 2304) + 64 * h, vcol = (TYPE == T_B ? 1280 : 2560) + 64 * h;
    const size_t rowbase = (size_t)b * S; const int q0 = QB * qb, qrel = wid * QBLK + r32, qrow = q0 + qrel;
    int tlo = 0;
    if (TYPE == T_D) {
        const float qm = __uint_as_float(nrm[0]) + __uint_as_float(nrm[1]), kmx = __uint_as_float(nrm[2]) + __uint_as_float(nrm[3]);
        const float bound = 2.0f * sqrtf(qm * kmx) * 1.01f + 42.0f;
        const float c0 = c2bh[q0];
        const bool skip = (lane < 4 * qb) && (c0 - c2bh[64 * (lane < 4 * qb ? lane : 0) + 63] < -bound);
        tlo = __builtin_popcountll(__ballot(skip)) & ~1;
    }
    const int NT = 4 * (qb + 1) - tlo, key0 = 64 * tlo;
    A2_LAS float* tab = (A2_LAS float*)(lds + L_TAB);
    A2_LAS float* km = (A2_LAS float*)(lds + L_KM);
    A2_LAS float* wsf = (A2_LAS float*)(lds + L_WS) + wid * 64;
    const unsigned lds0 = (unsigned)(uintptr_t)lds;
    if (TYPE == T_B) { if (tab_id != cur_tab) { cur_tab = tab_id; for (int i = tid; i < TAB_N + TAB_PADN; i += 512) tab[i] = (i < 4096) ? tabg[4095 - i] : (i < TAB_N ? 0.f : -INFINITY); }
        for (int i = tid; i < 16 * 64; i += 512) km[i] = kmbh[i]; }
    else { cur_tab = -1; for (int i = tid; i < NT * 64; i += 512) tab[i] = c2bh[key0 + i]; }
    const bf16* ksrc = qkv + (rowbase + key0 + lane) * QP + kcol + wid * 8;
    const bf16* vsrc = qkv + (rowbase + key0 + 16 * (wid & 3) + (lane >> 2)) * QP + vcol + (wid >> 2) * 32 + (lane & 3) * 8;
    const unsigned kdst = lds0 + L_K + wid * 1024, vdst = lds0 + L_V + wid * 1024;
#define A2_DMA_K(t, slot) att::glds16(ksrc + (size_t)(t) * KVBLK * QP, (unsigned)__builtin_amdgcn_readfirstlane(kdst + (slot)))
#define A2_DMA_V(t, slot) att::glds16(vsrc + (size_t)(t) * KVBLK * QP, (unsigned)__builtin_amdgcn_readfirstlane(vdst + (slot)))
    const lds_cptr shm3 = (lds_cptr)lds; const lds_cptr kp0 = shm3 + L_K + hi * 1024 + r32 * 16; const lds_cptr vp0 = shm3 + L_V + ((lane >> 4) & 1) * 32 + (lane & 3) * 8 + (4 * hi + ((lane & 15) >> 2)) * 64;
    bf16x8 kf[8];
    A2_DMA_K(0, 0); A2_DMA_V(0, 0); A2_DMA_K(1, SLOTB);
    bf16x8 qr[4];
    { const bf16* qp = qkv + (rowbase + qrow) * QP + qcol;
#pragma unroll
      for (int d0 = 0; d0 < 4; ++d0) qr[d0] = *(const bf16x8*)(qp + d0 * 16 + hi * 8); }
    const float cq = (TYPE == T_D) ? c2bh[qrow] : 0.f;
    float mhat = 0.f, l_reg = 0.f; f32x16 o[2]; o[0] = f32x16{}; o[1] = f32x16{};
    bool resc = false;
    A2_DMA_K(2, 2 * SLOTB);
    A2_WAIT_BAR(3);
    unsigned sel = 0u;
    if (TYPE == T_B) {
        float g[16];
#pragma unroll
        for (int n = 0; n < 16; ++n) { g[n] = -INFINITY; if (n < qb) { float s = 0.f;
#pragma unroll
                for (int d0 = 0; d0 < 4; ++d0) { const f32x4 a = *(const A2_LAS f32x4*)(km + n * 64 + 16 * d0 + 8 * hi), c = *(const A2_LAS f32x4*)(km + n * 64 + 16 * d0 + 8 * hi + 4);
                    const bf16x8 qv = qr[d0];
                    s = fmaf(__builtin_bit_cast(float, (unsigned)(unsigned short)qv[0] << 16), a[0], s); s = fmaf(__builtin_bit_cast(float, (unsigned)(unsigned short)qv[1] << 16), a[1], s);
                    s = fmaf(__builtin_bit_cast(float, (unsigned)(unsigned short)qv[2] << 16), a[2], s); s = fmaf(__builtin_bit_cast(float, (unsigned)(unsigned short)qv[3] << 16), a[3], s);
                    s = fmaf(__builtin_bit_cast(float, (unsigned)(unsigned short)qv[4] << 16), c[0], s); s = fmaf(__builtin_bit_cast(float, (unsigned)(unsigned short)qv[5] << 16), c[1], s);
                    s = fmaf(__builtin_bit_cast(float, (unsigned)(unsigned short)qv[6] << 16), c[2], s); s = fmaf(__builtin_bit_cast(float, (unsigned)(unsigned short)qv[7] << 16), c[3], s); }
                g[n] = att::xhalf_sum(s); } }
#pragma unroll
        for (int r = 0; r < 3; ++r) { float best = -INFINITY; int bi = -1;
#pragma unroll
            for (int n = 0; n < 16; ++n) if (n < qb && !((sel >> n) & 1u) && g[n] > best) { best = g[n]; bi = n; }
            if (bi >= 0) sel |= 1u << bi; }
    }
#define A2_CB(tau, CB0, CB1) do { const float base_ = cq - mhat; \
        if (TYPE == T_D) { const A2_LAS float* cp_ = tab + 64 * (tau) + 4 * hi; \
            _Pragma("unroll") for (int r = 0; r < 16; ++r) { CB0[r] = base_ - cp_[att::offr(r)]; CB1[r] = base_ - cp_[att::offr(r) + 32]; } \
        } else { const int k0_ = key0 + 64 * (tau); const bool pick_ = (k0_ < q0) ? ((sel >> (k0_ >> 8)) & 1u) : true; \
            const A2_LAS float* tb_ = pick_ ? tab + (4095 - (qrow - k0_ - 4 * hi)) : tab + TAB_N; \
            _Pragma("unroll") for (int r = 0; r < 16; ++r) { CB0[r] = tb_[att::offr(r)] + base_; CB1[r] = tb_[att::offr(r) + 32] + base_; } } } while (0)
#define A2_CMASK(P0, P1, t) do { const int jb_ = (t) - (NT - 4); if (jb_ >= 0) { const int kb_ = 64 * jb_ + 4 * hi; \
        _Pragma("unroll") for (int r = 0; r < 16; ++r) { const int kv_ = kb_ + att::offr(r); if (kv_ > qrel) P0[r] = -INFINITY; if (kv_ + 32 > qrel) P1[r] = -INFINITY; } } } while (0)
#define A2_DECIDE(C0, C1) do { float a_ = A2_MX3(C0[0], C0[1], C1[0]), b_ = A2_MX3(C0[2], C0[3], C1[1]); a_ = A2_MX3(a_, C1[2], C1[3]); \
        _Pragma("unroll") for (int r = 4; r < 16; r += 4) { a_ = A2_MX3(a_, C0[r], C0[r + 1]); b_ = A2_MX3(b_, C0[r + 2], C0[r + 3]); a_ = A2_MX3(a_, C1[r], C1[r + 1]); b_ = A2_MX3(b_, C1[r + 2], C1[r + 3]); } \
        const float rm_ = att::xhalf_max(__builtin_fmaxf(a_, b_)); \
        resc = false; \
        if (__builtin_expect(__ballot(rm_ > THR) != 0ull, 0)) { const float dl_ = __builtin_fmaxf(rm_, 0.f); mhat += dl_; \
            _Pragma("unroll") for (int r = 0; r < 16; ++r) { C0[r] -= dl_; C1[r] -= dl_; } \
            const float f_ = EX2(-dl_); l_reg *= f_; if (hi == 0) wsf[r32] = f_; resc = true; } } while (0)
#define A2_RESC() do { if (resc) { asm volatile("s_waitcnt lgkmcnt(0)" ::: "memory"); \
        _Pragma("unroll") for (int i = 0; i < 4; ++i) { const f32x4 fr_ = *(const A2_LAS f32x4*)(wsf + 8 * i + 4 * hi); \
            _Pragma("unroll") for (int j = 0; j < 4; ++j) { o[0][4 * i + j] *= fr_[j]; o[1][4 * i + j] *= fr_[j]; } } } } while (0)
    f32x16 pA0, pA1, pB0, pB1;
    int sl_prev = 0, sl_cur = 0, sl_next = SLOTB;
#define A2_ROT() do { sl_prev = sl_cur; sl_cur = sl_next; sl_next = (sl_next == (NSLOT - 1) * SLOTB) ? 0 : sl_next + SLOTB; } while (0)
    { A2_CB(0, pA0, pA1); kload8(kf, kp0);
#pragma unroll
      for (int d0 = 0; d0 < 4; ++d0) { pA0 = A2_MFMA(kf[2 * d0], qr[d0], pA0); pA1 = A2_MFMA(kf[2 * d0 + 1], qr[d0], pA1); } }
    A2_CMASK(pA0, pA1, 0);
    A2_DECIDE(pA0, pA1);
#pragma unroll
    for (int r = 0; r < 16; ++r) { pA0[r] = EX2(pA0[r]); pA1[r] = EX2(pA1[r]); }
    A2_WAIT_BAR(0);
    A2_RESC();
    A2_DMA_K(3, 0); A2_DMA_V(1, SLOTB);
    A2_ROT();
    kload8(kf, kp0 + sl_cur);
    A2_WAIT_BAR(2);
    s16x4 vlo[8], vhi[8]; u32x4 pw0, pw1, pw2, pw3;
#define A2_PKW(P, B) att::cvtpk(P[B], P[B + 1])
#define A2_PAF(k) __builtin_bit_cast(bf16x8, pw##k)
#define A2_VFR(i) (bf16x8){vlo[i][0], vlo[i][1], vlo[i][2], vlo[i][3], vhi[i][0], vhi[i][1], vhi[i][2], vhi[i][3]}
#define A2_PIN(x) asm volatile("" : "+v"(x))
#define A2_GAPA(MF, A0, A1, A2, A3, W0, W1, PW) do { MF; sacc += A0; sacc += A1; sacc += A2; sacc += A3; A2_PIN(sacc); W0; W1; A2_PIN(PW); A2_SBAR(); } while (0)
#define A2_GAPB(MF, X, B) do { MF; X[B] = EX2(X[B]); X[B + 1] = EX2(X[B + 1]); X[B + 2] = EX2(X[B + 2]); X[B + 3] = EX2(X[B + 3]); A2_PIN(X); A2_SBAR(); } while (0)
#define A2_VRD(i) do { vlo[i] = att::vtr(vp_ + (((i) >> 2) * 4096 + ((i) & 3) * 1024)); vhi[i] = att::vtr(vp_ + (((i) >> 2) * 4096 + ((i) & 3) * 1024 + 512)); } while (0)
#define A2_KRD(G, j) do { if (G) { kload2(kf, kp0 + sl_next, j); A2_SBAR(); } } while (0)
#define A2_STEP(C0, C1, P0, P1, t, GK, GV, GL, MASKED) do { A2_SBAR(); \
        A2_CB(t, C0, C1); A2_SBAR();     \
        const lds_cptr vp_ = vp0 + sl_prev; \
        A2_VRD(0); A2_SBAR(); float sacc = (P0[0] + P0[1]); \
        A2_GAPA(C0 = A2_MFMA(kf[0], qr[0], C0), P0[2], P0[3], P0[4], P0[5],     pw0[0] = A2_PKW(P0, 0),  pw0[1] = A2_PKW(P0, 2),  pw0); \
        A2_VRD(4); A2_SBAR(); A2_GAPA(C1 = A2_MFMA(kf[1], qr[0], C1), P0[6], P0[7], P0[8], P0[9],     pw0[2] = A2_PKW(P0, 4),  pw0[3] = A2_PKW(P0, 6),  pw0); \
        A2_VRD(1); A2_SBAR(); A2_GAPA(C0 = A2_MFMA(kf[2], qr[1], C0),   P0[10], P0[11], P0[12], P0[13], pw1[0] = A2_PKW(P0, 8),  pw1[1] = A2_PKW(P0, 10), pw1); \
        A2_VRD(5); A2_SBAR(); A2_GAPA(C1 = A2_MFMA(kf[3], qr[1], C1),   P0[14], P0[15], P1[0], P1[1],   pw1[2] = A2_PKW(P0, 12), pw1[3] = A2_PKW(P0, 14), pw1); \
        A2_VRD(2); A2_SBAR(); A2_GAPA(C0 = A2_MFMA(kf[4], qr[2], C0),   P1[2], P1[3], P1[4], P1[5],     pw2[0] = A2_PKW(P1, 0),  pw2[1] = A2_PKW(P1, 2),  pw2); \
        A2_VRD(6); A2_SBAR(); A2_GAPA(C1 = A2_MFMA(kf[5], qr[2], C1),   P1[6], P1[7], P1[8], P1[9],     pw2[2] = A2_PKW(P1, 4),  pw2[3] = A2_PKW(P1, 6),  pw2); \
        A2_VRD(3); A2_SBAR(); A2_GAPA(C0 = A2_MFMA(kf[6], qr[3], C0),   P1[10], P1[11], P1[12], P1[13], pw3[0] = A2_PKW(P1, 8),  pw3[1] = A2_PKW(P1, 10), pw3); \
        A2_VRD(7); A2_SBAR(); A2_GAPA(C1 = A2_MFMA(kf[7], qr[3], C1),   P1[14], P1[15], 0.f, 0.f,       pw3[2] = A2_PKW(P1, 12), pw3[3] = A2_PKW(P1, 14), pw3); \
        l_reg += sacc; \
        if (GK) { A2_DMA_K((t) + 3, sl_cur); } if (GV) { A2_DMA_V((t) + 1, sl_next); } \
        if (MASKED) A2_CMASK(C0, C1, t); \
        A2_DECIDE(C0, C1); \
        A2_SBAR(); \
        A2_GAPB(o[0] = A2_MFMA(A2_PAF(0), A2_VFR(0), o[0]), C0, 0); \
        A2_GAPB(o[1] = A2_MFMA(A2_PAF(0), A2_VFR(4), o[1]), C0, 4); \
        A2_KRD(GL, 0); A2_GAPB(o[0] = A2_MFMA(A2_PAF(1), A2_VFR(1), o[0]), C0, 8); \
        A2_KRD(GL, 1); A2_GAPB(o[1] = A2_MFMA(A2_PAF(1), A2_VFR(5), o[1]), C0, 12); \
        A2_KRD(GL, 2); A2_GAPB(o[0] = A2_MFMA(A2_PAF(2), A2_VFR(2), o[0]), C1, 0); \
        A2_KRD(GL, 3); A2_GAPB(o[1] = A2_MFMA(A2_PAF(2), A2_VFR(6), o[1]), C1, 4); \
        A2_GAPB(o[0] = A2_MFMA(A2_PAF(3), A2_VFR(3), o[0]), C1, 8); \
        A2_GAPB(o[1] = A2_MFMA(A2_PAF(3), A2_VFR(7), o[1]), C1, 12); \
    } while (0)
    int t = 1;
    for (; t + 5 < NT; t += 2) {
        A2_STEP(pB0, pB1, pA0, pA1, t, true, true, true, false);     A2_WAIT_BAR(2); A2_RESC(); A2_ROT();
        A2_STEP(pA0, pA1, pB0, pB1, t + 1, true, true, true, false); A2_WAIT_BAR(2); A2_RESC(); A2_ROT();
    }
#define A2_ENDW(tt) do { if ((tt) + 3 < NT) { A2_WAIT_BAR(2); } else if ((tt) + 2 < NT) { A2_WAIT_BAR(1); } else { A2_WAIT_BAR(0); } } while (0)
    for (; t + 1 < NT; t += 2) {
        A2_STEP(pB0, pB1, pA0, pA1, t, (t + 3 < NT), (t + 1 < NT), (t + 1 < NT), true);         A2_ENDW(t);     A2_RESC(); A2_ROT();
        A2_STEP(pA0, pA1, pB0, pB1, t + 1, (t + 4 < NT), (t + 2 < NT), (t + 2 < NT), true);     A2_ENDW(t + 1); A2_RESC(); A2_ROT();
    }
    A2_STEP(pB0, pB1, pA0, pA1, NT - 1, false, false, false, true); A2_RESC();
    { float sacc = pB0[0] + pB0[1];
#pragma unroll
      for (int r = 2; r < 16; ++r) sacc += pB0[r];
#pragma unroll
      for (int r = 0; r < 16; ++r) sacc += pB1[r];
      l_reg += sacc;
      pw0 = (u32x4){A2_PKW(pB0, 0), A2_PKW(pB0, 2), A2_PKW(pB0, 4), A2_PKW(pB0, 6)}; pw1 = (u32x4){A2_PKW(pB0, 8), A2_PKW(pB0, 10), A2_PKW(pB0, 12), A2_PKW(pB0, 14)};
      pw2 = (u32x4){A2_PKW(pB1, 0), A2_PKW(pB1, 2), A2_PKW(pB1, 4), A2_PKW(pB1, 6)}; pw3 = (u32x4){A2_PKW(pB1, 8), A2_PKW(pB1, 10), A2_PKW(pB1, 12), A2_PKW(pB1, 14)};
      A2_SBAR();
      const lds_cptr vp_ = vp0 + sl_cur;
#pragma unroll
      for (int i = 0; i < 8; ++i) A2_VRD(i);
      o[0] = A2_MFMA(A2_PAF(0), A2_VFR(0), o[0]); o[0] = A2_MFMA(A2_PAF(1), A2_VFR(1), o[0]); o[0] = A2_MFMA(A2_PAF(2), A2_VFR(2), o[0]); o[0] = A2_MFMA(A2_PAF(3), A2_VFR(3), o[0]);
      o[1] = A2_MFMA(A2_PAF(0), A2_VFR(4), o[1]); o[1] = A2_MFMA(A2_PAF(1), A2_VFR(5), o[1]); o[1] = A2_MFMA(A2_PAF(2), A2_VFR(6), o[1]); o[1] = A2_MFMA(A2_PAF(3), A2_VFR(7), o[1]); }
    l_reg = att::xhalf_sum(l_reg);
    if (hi == 0) wsf[32 + r32] = 1.0f / l_reg;
    asm volatile("s_waitcnt lgkmcnt(0)" ::: "memory");
    {   A2_LAS bf16* stg = (A2_LAS bf16*)(lds + L_OST) + wid * 2048;
#pragma unroll
        for (int i = 0; i < 4; ++i) { const f32x4 rl = *(const A2_LAS f32x4*)(wsf + 32 + 8 * i + 4 * hi);
#pragma unroll
            for (int j = 0; j < 4; ++j) { const int orow = 8 * i + 4 * hi + j;
#pragma unroll
                for (int d0 = 0; d0 < 2; ++d0) { const unsigned w = att::cvtpk(o[d0][4 * i + j] * rl[j], 0.f); stg[orow * 64 + d0 * 32 + r32] = (bf16)(w & 0xffffu); } } }
        asm volatile("s_waitcnt lgkmcnt(0)" ::: "memory");
#pragma unroll
        for (int i = 0; i < 4; ++i) { const int row = i * 8 + (lane >> 3), ch = lane & 7; const u32x4 v = *(const A2_LAS u32x4*)(stg + row * 64 + ch * 8);
            *(u32x4*)(outp + (rowbase + q0 + wid * QBLK + row) * ldo + ch * 8) = v; }
    }
    asm volatile("s_waitcnt lgkmcnt(0)\n\ts_barrier" ::: "memory");
#undef A2_DMA_K
#undef A2_DMA_V
#undef A2_CB
#undef A2_CMASK
#undef A2_DECIDE
#undef A2_RESC
#undef A2_ROT
#undef A2_PKW
#undef A2_PAF
#undef A2_VFR
#undef A2_PIN
#undef A2_GAPA
#undef A2_GAPB
#undef A2_VRD
#undef A2_KRD
#undef A2_STEP
#undef A2_ENDW
}
}

namespace att3 {
#define A3_LAS __attribute__((address_space(3)))
typedef att::bf16x8 bf16x8; typedef att::s16x4 s16x4; typedef att::f32x16 f32x16; typedef att::f32x4 f32x4; typedef att::u32x4 u32x4; typedef unsigned short bf16;
constexpr int S = 4096, QP = 2816, SLOTB = 8192;
constexpr int L_K = 0, L_V = 6 * SLOTB, L_WS = 12 * SLOTB, L_TAB = L_WS + 2048, TAB_N = 5600, L_END = L_TAB + TAB_N * 4;
static_assert(L_TAB % 16 == 0 && L_END <= 131072, "attention engine 3 LDS map");
#define A3_MFMA(a, b, c) __builtin_amdgcn_mfma_f32_32x32x16_bf16(a, b, c, 0, 0, 0)

struct BandSrc { const bf16* k; const bf16* v; int rs, kw, tmin; };
__device__ __forceinline__ void band_dma(unsigned lds_region, const bf16* src, int rs, int kw, int tmin, bool isV, int wid, int lane) {
    for (int t = tmin; t < 6; ++t) { const int k0 = kw + 64 * t;
        if (!isV) att::glds16(src + (size_t)(k0 + lane) * rs + wid * 8, (unsigned)__builtin_amdgcn_readfirstlane(lds_region + t * SLOTB + wid * 1024));
        else att::glds16(src + (size_t)(k0 + 16 * (wid & 3) + (lane >> 2)) * rs + (wid >> 2) * 32 + (lane & 3) * 8, (unsigned)__builtin_amdgcn_readfirstlane(lds_region + t * SLOTB + wid * 1024)); }
}
#define A3_WAITV(n4, n6) do { if (n4) asm volatile("s_waitcnt vmcnt(4)" ::: "memory"); else if (n6) asm volatile("s_waitcnt vmcnt(6)" ::: "memory"); else asm volatile("s_waitcnt vmcnt(0)" ::: "memory"); } while (0)
template <int DIL>
__device__ __forceinline__ void attn_band(A3_LAS unsigned char* lds, const bf16* qkv, int b, int h, int qb, int res, int W, int qcol, int kcol, int vcol,
                                          const float* tabg, int tab_id, int& cur_tab, float sink2, bf16* outp, int ldo, float* lse_out, const BandSrc nx, const bool nxt) {
    int tid_ = threadIdx.x; asm volatile("" : "+v"(tid_));
    const int tid = tid_, lane = tid & 63, r32 = lane & 31, hi = lane >> 5; const int wid = __builtin_amdgcn_readfirstlane(tid >> 6);
    const size_t rowbase = (size_t)b * S + res;
    const int q0 = 256 * qb, kw = q0 - 128, tmin = (qb == 0) ? 2 : 0, ta = wid >> 1;
    A3_LAS float* tab = (A3_LAS float*)(lds + L_TAB);
    A3_LAS float* wsf = (A3_LAS float*)(lds + L_WS) + wid * 64;
    const unsigned lds0 = (unsigned)(uintptr_t)lds;
    if (tab_id != cur_tab) { cur_tab = tab_id; for (int i = tid; i < TAB_N; i += 512) tab[i] = (i < 4096 && 4095 - i <= W * DIL) ? tabg[4095 - i] : -INFINITY; }
    const int qfw = q0 + 32 * wid;
    bf16x8 qr[4];
    { const bf16* qrow = qkv + (rowbase + (size_t)(qfw + r32) * DIL) * QP + qcol;
#pragma unroll
      for (int d0 = 0; d0 < 4; ++d0) qr[d0] = *(const bf16x8*)(qrow + 16 * d0 + 8 * hi); }
    A3_WAITV(tmin == 2, tmin == 0);
    __syncthreads();
    f32x16 p[3][2];
#pragma unroll
    for (int i = 0; i < 3; ++i) {
        const int t = ta + i;
        if (t >= tmin) {
            const A3_LAS char* kb = (const A3_LAS char*)(lds + L_K + t * SLOTB) + hi * 1024 + r32 * 16;
            f32x16& a0 = p[i][0]; f32x16& a1 = p[i][1];
#pragma unroll
            for (int d0 = 0; d0 < 4; ++d0) { const bf16x8 b0 = *(const A3_LAS bf16x8*)(kb + d0 * 2048), b1 = *(const A3_LAS bf16x8*)(kb + d0 * 2048 + 512);
                if (d0 == 0) { a0 = A3_MFMA(b0, qr[0], f32x16{}); a1 = A3_MFMA(b1, qr[0], f32x16{}); } else { a0 = A3_MFMA(b0, qr[d0], a0); a1 = A3_MFMA(b1, qr[d0], a1); } }
            const int d0l = qfw + r32 - (kw + 64 * t) - 4 * hi;
            const A3_LAS float* tb = tab + (4095 - DIL * d0l);
#pragma unroll
            for (int r = 0; r < 16; ++r) { a0[r] += tb[DIL * att::offr(r)]; a1[r] += tb[DIL * (att::offr(r) + 32)]; }
        }
    }
    __syncthreads();
    if (nxt) band_dma(lds0 + L_K, nx.k, nx.rs, nx.kw, nx.tmin, false, wid, lane);
    float m = -INFINITY, m2 = -INFINITY;
#pragma unroll
    for (int i = 0; i < 3; ++i) { if (ta + i >= tmin) {
#pragma unroll
        for (int r = 0; r < 16; r += 2) { m = __builtin_fmaxf(__builtin_fmaxf(m, p[i][0][r]), p[i][0][r + 1]); m2 = __builtin_fmaxf(__builtin_fmaxf(m2, p[i][1][r]), p[i][1][r + 1]); } } }
    m = __builtin_fmaxf(m, m2);
    m = att::xhalf_max(m);
    const float negm = -m;
    if (nxt) A3_WAITV(nx.tmin == 2, nx.tmin == 0); else A3_WAITV(false, false);
    __syncthreads();
    float l = 0.f; f32x16 o[2]; o[0] = f32x16{}; o[1] = f32x16{};
    const int vpo = ((lane >> 4) & 1) * 32 + (lane & 3) * 8 + (4 * hi + ((lane & 15) >> 2)) * 64;
#pragma unroll
    for (int i = 0; i < 3; ++i) {
        const int t = ta + i;
        if (t >= tmin) {
            float sacc = 0.f;
#pragma unroll
            for (int r = 0; r < 16; ++r) { p[i][0][r] = EX2(p[i][0][r] + negm); p[i][1][r] = EX2(p[i][1][r] + negm); sacc += p[i][0][r] + p[i][1][r]; }
            l += sacc;
            u32x4 pw[4];
#pragma unroll
            for (int j = 0; j < 4; ++j) { pw[0][j] = att::cvtpk(p[i][0][2 * j], p[i][0][2 * j + 1]); pw[1][j] = att::cvtpk(p[i][0][8 + 2 * j], p[i][0][9 + 2 * j]); pw[2][j] = att::cvtpk(p[i][1][2 * j], p[i][1][2 * j + 1]); pw[3][j] = att::cvtpk(p[i][1][8 + 2 * j], p[i][1][9 + 2 * j]); }
            const A3_LAS char* vp = (const A3_LAS char*)(lds + L_V + t * SLOTB) + vpo;
#pragma unroll
            for (int d0 = 0; d0 < 2; ++d0)
#pragma unroll
                for (int ks = 0; ks < 4; ++ks) { const s16x4 lo = att::vtr(vp + d0 * 4096 + ks * 1024), hh = att::vtr(vp + d0 * 4096 + ks * 1024 + 512);
                    const bf16x8 vf = (bf16x8){lo[0], lo[1], lo[2], lo[3], hh[0], hh[1], hh[2], hh[3]};
                    o[d0] = A3_MFMA(__builtin_bit_cast(bf16x8, pw[ks]), vf, o[d0]); }
        }
    }
    l = att::xhalf_sum(l);
    l += EX2(sink2 - m);
    if (hi == 0) wsf[32 + r32] = 1.0f / l;
    __syncthreads();
    {   A3_LAS bf16* stg = (A3_LAS bf16*)(lds + L_V) + wid * 2048;
#pragma unroll
        for (int i = 0; i < 4; ++i) { const f32x4 rl = *(const A3_LAS f32x4*)(wsf + 32 + 8 * i + 4 * hi);
#pragma unroll
            for (int j = 0; j < 4; ++j) { const int orow = 8 * i + 4 * hi + j;
#pragma unroll
                for (int d0 = 0; d0 < 2; ++d0) { const unsigned w = att::cvtpk(o[d0][4 * i + j] * rl[j], 0.f); stg[orow * 64 + d0 * 32 + r32] = (bf16)(w & 0xffffu); } } }
        asm volatile("s_waitcnt lgkmcnt(0)" ::: "memory");
#pragma unroll
        for (int i = 0; i < 4; ++i) { const int row = i * 8 + (lane >> 3), ch = lane & 7; const u32x4 v = *(const A3_LAS u32x4*)(stg + row * 64 + ch * 8);
            *(u32x4*)(outp + (rowbase + (size_t)(qfw + row) * DIL) * ldo + ch * 8) = v; }
    }
    if (lse_out != nullptr && hi == 0) lse_out[(rowbase + (size_t)(qfw + r32) * DIL) * 4] = m + __builtin_amdgcn_logf(l);
    asm volatile("s_waitcnt lgkmcnt(0)" ::: "memory"); __syncthreads();
    if (nxt) band_dma(lds0 + L_V, nx.v, nx.rs, nx.kw, nx.tmin, true, wid, lane);
}
}

#ifndef PG8_SP2
#define PG8_SP2 true
#endif
#ifndef PG8_ALIGN
#define PG8_ALIGN true
#endif

constexpr int NWAVES = 8;
constexpr int NB = 8, S = 4096, DM = 1024, M = NB * S, HD = 64, QP = 2816, NIN = 2820, DFF = 2816, NGU = 5632, DEPTH = 2;
constexpr float LOG2E = 1.4426950408889634f, C2 = 0.125f * LOG2E, EPS = 1e-6f;
constexpr int C_QA = 0, C_KA = 256, C_VA = 512, C_QB = 768, C_KB = 1024, C_VB = 1280, C_QC = 1536, C_KC = 1792, C_VC = 1920, C_QD = 2048, C_KD = 2304, C_VD = 2560;
constexpr int NPHASE = 14, PH_PER_LAYER = 6;
constexpr int N_LAUNCHES = MK_N_LAUNCHES;

constexpr size_t MiB = 1u << 20;
constexpr size_t WS_CTL = 0, CTL_ZERO_BYTES = 1 * MiB;
constexpr size_t WS_WIN = 1 * MiB;
constexpr size_t WS_WOUT = 12 * MiB;
constexpr size_t WS_WGU = 16 * MiB;
constexpr size_t WS_WDN = 38 * MiB;
constexpr size_t WS_SMALL = 49 * MiB;
constexpr size_t WS_WFD = WS_SMALL;
constexpr size_t WS_BIAST = WS_SMALL + 64 * 1024;
constexpr size_t WS_RSTD = WS_SMALL + 256 * 1024;
constexpr size_t WS_LF = WS_SMALL + 512 * 1024;
constexpr size_t WS_C2 = WS_SMALL + 1024 * 1024;
constexpr size_t WS_KMEAN = WS_SMALL + 1536 * 1024;
constexpr size_t WS_XB = 52 * MiB;
constexpr size_t WS_MIX = 116 * MiB;
constexpr size_t WS_QKV = 180 * MiB;
constexpr size_t WS_PA = 356 * MiB;
constexpr size_t WS_LSE = 404 * MiB;
constexpr size_t WS_SS = 406 * MiB;
constexpr size_t WS_FD = 408 * MiB;
constexpr size_t WS_X8 = 416 * MiB;
constexpr size_t WS_MIX8 = 448 * MiB;
constexpr size_t WS_END = 480 * MiB;
constexpr float WSCALE = 64.0f, ASCALE = 8.0f;
constexpr int CW_BAR = 4096, CW_NORM = 16384, CW_KMEAN = 65536;
constexpr int CW_UNUSED_ = 0;

constexpr int RING_OFF = 0, RING_BYTES = 131072;
constexpr int LDSCTL_OFF = RING_BYTES, MISC_OFF = LDSCTL_OFF + 320;
constexpr int LDS_BYTES = 147456;

#define GAS __attribute__((address_space(1)))
#define LAS __attribute__((address_space(3)))
typedef unsigned short bf16;
typedef unsigned v4u __attribute__((ext_vector_type(4)));
typedef float f32x4 __attribute__((ext_vector_type(4)));
typedef GAS unsigned gu32;
#define RLX_AGENT __ATOMIC_RELAXED, __HIP_MEMORY_SCOPE_AGENT
#define LDS_WAIT() asm volatile("s_waitcnt lgkmcnt(0)" ::: "memory")
__device__ __forceinline__ unsigned f2bf(float f) { unsigned u = __builtin_bit_cast(unsigned, f); return (u + 0x7fffu + ((u >> 16) & 1u)) >> 16; }
__device__ __forceinline__ unsigned pk2(float lo, float hi) { return f2bf(lo) | (f2bf(hi) << 16); }
__device__ __forceinline__ float bflo(unsigned w) { return __builtin_bit_cast(float, w << 16); }
__device__ __forceinline__ float bfhi(unsigned w) { return __builtin_bit_cast(float, w & 0xffff0000u); }

#define XB_TMO      128
#define XB_XCNT(j)  (256  + 64 * (j))
#define XB_XSUB(j)  (1280 + 64 * (j))
#define XB_XGEN(j)  (2304 + 64 * (j))
#define XB_TOP      3328
#define XB_TOPGEN   3392
#define XCD_BAR_WORDS 3456
#define XB_SPIN_CAP (1u << 18)

__device__ __forceinline__ unsigned xb_ld(unsigned* p)              { return __hip_atomic_load(p, __ATOMIC_RELAXED, __HIP_MEMORY_SCOPE_AGENT); }
__device__ __forceinline__ unsigned xb_add(unsigned* p, unsigned v) { return __hip_atomic_fetch_add(p, v, __ATOMIC_RELAXED, __HIP_MEMORY_SCOPE_AGENT); }
__device__ __forceinline__ unsigned xb_xcc_id() { return (unsigned)__builtin_amdgcn_s_getreg((3 << 11) | 20) & 0xFu; }
#define XB_SPIN(cond, bar) do { unsigned _sp = 0; while (cond) { __builtin_amdgcn_s_sleep(1); \
    if ((++_sp & 255u) == 0u) { if (xb_ld(&(bar)[XB_TMO])) break; if (_sp > XB_SPIN_CAP) { atomicAdd(&(bar)[XB_TMO], 1u); break; } } } } while (0)

struct XcdBarrier {
    unsigned* bar; unsigned x;
    volatile LAS unsigned* st;
};

__device__ __forceinline__ XcdBarrier xcd_barrier_post(unsigned* bar, volatile LAS unsigned* st) {
    XcdBarrier b; b.bar = bar; b.x = xb_xcc_id(); b.st = st;
    if (threadIdx.x == 0) (void)xb_add(&bar[XB_XCNT(b.x)], 1u);
    return b;
}
__device__ __forceinline__ void xcd_barrier_complete(unsigned* bar, unsigned x, unsigned& nloc, unsigned& nx) {
    const unsigned G = gridDim.x * gridDim.y * gridDim.z;
    unsigned sum, cnt, mine, sp = 0u;
    for (;;) {
        sum = 0u; cnt = 0u; mine = 0u;
#pragma unroll
        for (unsigned j = 0; j < 16; ++j) { const unsigned c = xb_ld(&bar[XB_XCNT(j)]); sum += c; cnt += (c > 0u) ? 1u : 0u; mine = (j == x) ? c : mine; }
        if (sum == G) break;
        __builtin_amdgcn_s_sleep(1);
        if ((++sp & 255u) == 0u) { if (xb_ld(&bar[XB_TMO])) break; if (sp > XB_SPIN_CAP) { atomicAdd(&bar[XB_TMO], 1u); break; } }
    }
    nloc = mine > 0u ? mine : 1u; nx = cnt > 0u ? cnt : 1u;
}

__device__ __forceinline__ void xcd_barrier(const XcdBarrier& b) {
    asm volatile("s_waitcnt vmcnt(0)" ::: "memory");
    __syncthreads();
    if (threadIdx.x == 0) {
        unsigned* bar = b.bar;
        __builtin_amdgcn_s_waitcnt(0);
        unsigned nloc = b.st[0], nx = b.st[1];
        if (nloc == 0u) { xcd_barrier_complete(bar, b.x, nloc, nx); b.st[0] = nloc; b.st[1] = nx; }
        const unsigned old = xb_add(&bar[XB_XSUB(b.x)], 1u);
        const unsigned gen = old / nloc;
        if (old + 1u == (gen + 1u) * nloc) {
            __builtin_amdgcn_fence(__ATOMIC_RELEASE, "agent");
            asm volatile("s_waitcnt vmcnt(0)" ::: "memory");
            const unsigned og = xb_add(&bar[XB_TOP], 1u);
            const unsigned tg = og / nx;
            if (og + 1u == (tg + 1u) * nx) xb_add(&bar[XB_TOPGEN], 1u);
            else XB_SPIN(xb_ld(&bar[XB_TOPGEN]) == tg, bar);
            __builtin_amdgcn_fence(__ATOMIC_ACQUIRE, "agent");
            xb_add(&bar[XB_XGEN(b.x)], 1u);
            asm volatile("s_waitcnt vmcnt(0)" ::: "memory");
        } else {
            XB_SPIN(xb_ld(&bar[XB_XGEN(b.x)]) == gen, bar);
            __builtin_amdgcn_fence(__ATOMIC_ACQUIRE, "agent");
            asm volatile("s_waitcnt vmcnt(0)" ::: "memory");
        }
    }
    __syncthreads();
}


__device__ __forceinline__ float wave_sum(float v) {
#pragma unroll
    for (int o = 1; o < 64; o <<= 1) v += __shfl_xor(v, o);
    return v;
}

__device__ __forceinline__ void tr_item(const float* W, int ldw, int K, const float* g, bf16* WT, int k0, int n0, int drow0, LAS float* scr, int lane) {
    float v[32];
#pragma unroll
    for (int i = 0; i < 32; ++i) { const int kk = 2 * i + (lane >> 5); v[i] = W[(size_t)(k0 + kk) * ldw + n0 + (lane & 31)]; }
    if (g) {
#pragma unroll
        for (int i = 0; i < 32; ++i) v[i] *= g[k0 + 2 * i + (lane >> 5)];
    }
#pragma unroll
    for (int i = 0; i < 32; ++i) scr[(2 * i + (lane >> 5)) * 33 + (lane & 31)] = v[i];
    LDS_WAIT(); asm volatile("" ::: "memory");
    const int c = lane & 7;
#pragma unroll
    for (int j = 0; j < 4; ++j) { const int n = (lane >> 3) + 8 * j; const LAS float* s = scr + (8 * c) * 33 + n;
        v4u o; o.x = pk2(s[0 * 33], s[1 * 33]); o.y = pk2(s[2 * 33], s[3 * 33]); o.z = pk2(s[4 * 33], s[5 * 33]); o.w = pk2(s[6 * 33], s[7 * 33]);
        *(GAS v4u*)(WT + (size_t)(drow0 + n) * K + k0 + 8 * c) = o; }
    LDS_WAIT(); asm volatile("" ::: "memory");
}
__device__ __forceinline__ void tr_item8(const float* W, int ldw, int K, const float* g, float sc, unsigned char* WT8, int k0, int n0, int drow0, LAS float* scr, int lane) {
    float v[32];
#pragma unroll
    for (int i = 0; i < 32; ++i) { const int kk = 2 * i + (lane >> 5); v[i] = W[(size_t)(k0 + kk) * ldw + n0 + (lane & 31)]; }
#pragma unroll
    for (int i = 0; i < 32; ++i) v[i] *= g ? g[k0 + 2 * i + (lane >> 5)] * sc : sc;
#pragma unroll
    for (int i = 0; i < 32; ++i) scr[(2 * i + (lane >> 5)) * 33 + (lane & 31)] = v[i];
    LDS_WAIT(); asm volatile("" ::: "memory");
    const int c = lane & 3;
#pragma unroll
    for (int j = 0; j < 2; ++j) { const int n = (lane >> 2) + 16 * j; const LAS float* s = scr + (16 * c) * 33 + n;
        v4u o; o.x = pg8::pk4_fp8(s[0 * 33], s[1 * 33], s[2 * 33], s[3 * 33]); o.y = pg8::pk4_fp8(s[4 * 33], s[5 * 33], s[6 * 33], s[7 * 33]);
        o.z = pg8::pk4_fp8(s[8 * 33], s[9 * 33], s[10 * 33], s[11 * 33]); o.w = pg8::pk4_fp8(s[12 * 33], s[13 * 33], s[14 * 33], s[15 * 33]);
        *(GAS v4u*)(WT8 + (size_t)(drow0 + n) * K + k0 + 16 * c) = o; }
    LDS_WAIT(); asm volatile("" ::: "memory");
}
__device__ __forceinline__ int t5_bucket(int n) {
    if (n < 16) return n;
    int b = 16;
    b += (n >= 22); b += (n >= 30); b += (n >= 40); b += (n >= 54); b += (n >= 73); b += (n >= 99); b += (n >= 134); b += (n >= 182);
    b += (n >= 246); b += (n >= 332); b += (n >= 450); b += (n >= 609); b += (n >= 825); b += (n >= 1117); b += (n >= 1513);
    return b;
}

struct Ptrs {
    const float *x, *norm1_g, *w_in, *f_bias, *sinks, *mix_g, *w_out, *norm2_g, *w_gate, *w_up, *w_down, *rel_bias, *final_g;
    float* out; unsigned char* ws;
};

__device__ __forceinline__ void phase_prep(const Ptrs& P, LAS unsigned char* lds, int it_lo, int it_hi, bool tables, int gw, int NGW, int wave, int lane) {
    LAS float* scr = (LAS float*)(lds + RING_OFF + wave * 16384);
    constexpr int I_IN = 16 * 88, I_OUT = 16 * 32, I_G = 16 * 88, I_DN = 44 * 32, I_LAYER = I_IN + I_OUT + 2 * I_G + I_DN;
    for (int it = it_lo * I_LAYER + gw; it < it_hi * I_LAYER; it += NGW) {
        const int l = it / I_LAYER; int r = it % I_LAYER;
        if (r < I_IN) { const int kb = r / 88, nb = r % 88; tr_item(P.w_in + (size_t)l * DM * NIN, NIN, DM, P.norm1_g + l * DM, (bf16*)(P.ws + WS_WIN) + (size_t)l * QP * DM, 64 * kb, 32 * nb, 32 * nb, scr, lane); continue; } r -= I_IN;
        if (r < I_OUT) { const int kb = r / 32, nb = r % 32;
            if (G2_FP8) tr_item8(P.w_out + (size_t)l * DM * DM, DM, DM, P.mix_g + l * DM, WSCALE, P.ws + WS_WOUT + (size_t)l * DM * DM, 64 * kb, 32 * nb, 32 * nb, scr, lane);
            else tr_item(P.w_out + (size_t)l * DM * DM, DM, DM, P.mix_g + l * DM, (bf16*)(P.ws + WS_WOUT) + (size_t)l * DM * DM, 64 * kb, 32 * nb, 32 * nb, scr, lane);
            continue; } r -= I_OUT;
        if (r < I_G) { const int kb = r / 88, nb = r % 88, n0 = 32 * nb; tr_item8(P.w_gate + (size_t)l * DM * DFF, DFF, DM, P.norm2_g + l * DM, WSCALE, P.ws + WS_WGU + (size_t)l * NGU * DM, 64 * kb, n0, 256 * (n0 / 128) + (n0 % 128), scr, lane); continue; } r -= I_G;
        if (r < I_G) { const int kb = r / 88, nb = r % 88, n0 = 32 * nb; tr_item8(P.w_up + (size_t)l * DM * DFF, DFF, DM, P.norm2_g + l * DM, WSCALE, P.ws + WS_WGU + (size_t)l * NGU * DM, 64 * kb, n0, 256 * (n0 / 128) + 128 + (n0 % 128), scr, lane); continue; } r -= I_G;
        { const int kb = r / 32, nb = r % 32; tr_item8(P.w_down + (size_t)l * DFF * DM, DM, DFF, nullptr, WSCALE, P.ws + WS_WDN + (size_t)l * DM * DFF, 64 * kb, 32 * nb, 32 * nb, scr, lane); }
    }
    if (!tables) return;
    const int gt = gw * 64 + lane, NGT = NGW * 64;
    float* biasT = (float*)(P.ws + WS_BIAST);
    for (int i = gt; i < 12 * 4096; i += NGT) { const int col = i >> 12, dist = i & 4095; biasT[i] = P.rel_bias[t5_bucket(dist) * 12 + col] * LOG2E; }
    float* wfd = (float*)(P.ws + WS_WFD);
    for (int i = gt; i < DEPTH * DM * 4; i += NGT) { const int l = i / (DM * 4), k = (i / 4) % DM, h = i & 3; wfd[i] = P.norm1_g[l * DM + k] * P.w_in[((size_t)l * DM + k) * NIN + 2816 + h]; }
}

template <bool WITH_FD>
__device__ __forceinline__ void row_pass(const float* xin, bf16* xb, float* rstd, const LAS float* wfd, const float* fbias, float* lf, int gw, int NGW, int lane) {
    f32x4 nx[4];
    if (gw < M) { const GAS f32x4* xr = (const GAS f32x4*)(xin + (size_t)gw * DM) + lane;
#pragma unroll
        for (int j = 0; j < 4; ++j) nx[j] = xr[64 * j]; }
    for (int m = gw; m < M; m += NGW) {
        f32x4 v[4]; float s = 0.f;
#pragma unroll
        for (int j = 0; j < 4; ++j) v[j] = nx[j];
        if (m + NGW < M) { const GAS f32x4* xr = (const GAS f32x4*)(xin + (size_t)(m + NGW) * DM) + lane;
#pragma unroll
            for (int j = 0; j < 4; ++j) nx[j] = xr[64 * j]; }
#pragma unroll
        for (int j = 0; j < 4; ++j) s += (v[j].x * v[j].x + v[j].y * v[j].y) + (v[j].z * v[j].z + v[j].w * v[j].w);
        const float wave_sum_keep = wave_sum(s);
        const float rs = 1.0f / sqrtf(wave_sum_keep * (1.0f / DM) + EPS);
        GAS unsigned long long* o8 = (GAS unsigned long long*)(xb + (size_t)m * DM) + lane;
#pragma unroll
        for (int j = 0; j < 4; ++j) o8[64 * j] = (unsigned long long)pk2(v[j].x, v[j].y) | ((unsigned long long)pk2(v[j].z, v[j].w) << 32);
        if (WITH_FD) {
            float f0 = 0.f, f1 = 0.f, f2 = 0.f, f3 = 0.f;
#pragma unroll
            for (int j = 0; j < 4; ++j)
#pragma unroll
                for (int i = 0; i < 4; ++i) { const f32x4 w = *(const LAS f32x4*)(wfd + (4 * lane + 256 * j + i) * 4); const float xv = v[j][i]; f0 += xv * w.x; f1 += xv * w.y; f2 += xv * w.z; f3 += xv * w.w; }
            f0 = wave_sum(f0); f1 = wave_sum(f1); f2 = wave_sum(f2); f3 = wave_sum(f3);
            if (lane < 4) { const float f = lane == 0 ? f0 : lane == 1 ? f1 : lane == 2 ? f2 : f3; const float z = f * rs + fbias[lane];
                lf[(size_t)lane * M + m] = fminf(z, 0.f) - log1pf(expf(-fabsf(z))); }
        }
        if (lane < 16) rstd[(size_t)m * 16 + lane] = (lane == 0) ? wave_sum_keep : 0.f;
    }
}
__device__ __forceinline__ void final_pass(const bf16* xb, float* out, const float* g, const float* ss, int gw, int NGW, int lane) {
    v4u na = {0u, 0u, 0u, 0u}, nb = {0u, 0u, 0u, 0u}; float ns = 0.f;
    if (gw < M) { const GAS v4u* p = (const GAS v4u*)(xb + (size_t)gw * DM) + 2 * lane; na = p[0]; nb = p[1]; ns = lane < 16 ? ss[(size_t)gw * 16 + lane] : 0.f; }
    for (int m = gw; m < M; m += NGW) {
        const v4u a = na, b = nb; const float sv = ns; float f[16];
        if (m + NGW < M) { const GAS v4u* p = (const GAS v4u*)(xb + (size_t)(m + NGW) * DM) + 2 * lane; na = p[0]; nb = p[1]; ns = lane < 16 ? ss[(size_t)(m + NGW) * 16 + lane] : 0.f; }
        f[0] = bflo(a.x); f[1] = bfhi(a.x); f[2] = bflo(a.y); f[3] = bfhi(a.y); f[4] = bflo(a.z); f[5] = bfhi(a.z); f[6] = bflo(a.w); f[7] = bfhi(a.w);
        f[8] = bflo(b.x); f[9] = bfhi(b.x); f[10] = bflo(b.y); f[11] = bfhi(b.y); f[12] = bflo(b.z); f[13] = bfhi(b.z); f[14] = bflo(b.w); f[15] = bfhi(b.w);
        const float s = wave_sum(sv);
        const float rs = 1.0f / sqrtf(s * (1.0f / DM) + EPS);
        GAS f32x4* o = (GAS f32x4*)(out + (size_t)m * DM) + 4 * lane; const f32x4* gv = (const f32x4*)g + 4 * lane;
#pragma unroll
        for (int j = 0; j < 4; ++j) { const f32x4 gg = gv[j]; o[j] = (f32x4){f[4 * j] * rs * gg[0], f[4 * j + 1] * rs * gg[1], f[4 * j + 2] * rs * gg[2], f[4 * j + 3] * rs * gg[3]}; }
    }
}
__device__ __forceinline__ void unpack16(const v4u a, const v4u b, float (&f)[16]) {
    f[0] = bflo(a.x); f[1] = bfhi(a.x); f[2] = bflo(a.y); f[3] = bfhi(a.y); f[4] = bflo(a.z); f[5] = bfhi(a.z); f[6] = bflo(a.w); f[7] = bfhi(a.w);
    f[8] = bflo(b.x); f[9] = bfhi(b.x); f[10] = bflo(b.y); f[11] = bfhi(b.y); f[12] = bflo(b.z); f[13] = bfhi(b.z); f[14] = bflo(b.w); f[15] = bfhi(b.w);
}
__device__ __forceinline__ void mixnorm_pass(bf16* mix, unsigned char* mix8, const bf16* pa, const float* lse, int gw, int NGW, int lane) {
    for (int m = gw; m < M; m += NGW) {
        GAS v4u* p = (GAS v4u*)(mix + (size_t)m * DM) + 2 * lane;
        float f[16];
        if ((ATT_MFMA_MASK & 1) && lane < 16) {
            const int hd = lane >> 2;
            const float l0 = lse[(size_t)m * 4 + hd], l1 = lse[((size_t)M + m) * 4 + hd], l2 = lse[((size_t)2 * M + m) * 4 + hd];
            const float mx = fmaxf(l0, fmaxf(l1, l2)); float w0 = EX2(l0 - mx), w1 = EX2(l1 - mx), w2 = EX2(l2 - mx); const float inv = 1.0f / (w0 + w1 + w2); w0 *= inv; w1 *= inv; w2 *= inv;
            float t[16];
            { const GAS v4u* q = (const GAS v4u*)(pa + (size_t)m * 256) + 2 * lane; unpack16(q[0], q[1], t);
#pragma unroll
              for (int i = 0; i < 16; ++i) f[i] = w0 * t[i]; }
            { const GAS v4u* q = (const GAS v4u*)(pa + ((size_t)M + m) * 256) + 2 * lane; unpack16(q[0], q[1], t);
#pragma unroll
              for (int i = 0; i < 16; ++i) f[i] += w1 * t[i]; }
            { const GAS v4u* q = (const GAS v4u*)(pa + ((size_t)2 * M + m) * 256) + 2 * lane; unpack16(q[0], q[1], t);
#pragma unroll
              for (int i = 0; i < 16; ++i) f[i] += w2 * t[i]; }
        } else { const v4u a = p[0], b = p[1]; unpack16(a, b, f); }
        {
        }
        float s = 0.f;
#pragma unroll
        for (int i = 0; i < 16; ++i) s += f[i] * f[i];
        s += __shfl_xor(s, 1); s += __shfl_xor(s, 2); s += __shfl_xor(s, 4); s += __shfl_xor(s, 8);
        const float rs = 1.0f / sqrtf(s * (1.0f / 256.0f) + EPS);
        v4u oa, ob;
        oa.x = pk2(f[0] * rs, f[1] * rs); oa.y = pk2(f[2] * rs, f[3] * rs); oa.z = pk2(f[4] * rs, f[5] * rs); oa.w = pk2(f[6] * rs, f[7] * rs);
        ob.x = pk2(f[8] * rs, f[9] * rs); ob.y = pk2(f[10] * rs, f[11] * rs); ob.z = pk2(f[12] * rs, f[13] * rs); ob.w = pk2(f[14] * rs, f[15] * rs);
        if (G2_FP8) { v4u q; q.x = pg8::pk4_fp8(f[0] * rs, f[1] * rs, f[2] * rs, f[3] * rs); q.y = pg8::pk4_fp8(f[4] * rs, f[5] * rs, f[6] * rs, f[7] * rs); q.z = pg8::pk4_fp8(f[8] * rs, f[9] * rs, f[10] * rs, f[11] * rs); q.w = pg8::pk4_fp8(f[12] * rs, f[13] * rs, f[14] * rs, f[15] * rs);
            *((GAS v4u*)(mix8 + (size_t)m * DM) + lane) = q; }
        else { p[0] = oa; p[1] = ob; }
    }
}
__device__ __forceinline__ void scan_job(int b, int h, const float* lf_in, const float* ss, const float* fdp, float fbias_h, float* c2, LAS float* scr, int tid, int lane, int wave) {
    const size_t row0 = (size_t)b * S + 8 * tid;
    float v[8];
    if (lf_in) { const f32x4 a = *(const f32x4*)(lf_in + (size_t)h * M + row0), c = *(const f32x4*)(lf_in + (size_t)h * M + row0 + 4); v[0] = a[0]; v[1] = a[1]; v[2] = a[2]; v[3] = a[3]; v[4] = c[0]; v[5] = c[1]; v[6] = c[2]; v[7] = c[3]; }
    else {
#pragma unroll
        for (int i = 0; i < 8; ++i) { const f32x4* sp = (const f32x4*)(ss + (row0 + i) * 16); const f32x4* fp = (const f32x4*)(fdp + (row0 + i) * 64 + h * 16);
            const f32x4 s0 = sp[0], s1 = sp[1], s2 = sp[2], s3 = sp[3], f0 = fp[0], f1 = fp[1], f2 = fp[2], f3 = fp[3];
            const float s = ((s0[0] + s0[1]) + (s0[2] + s0[3])) + ((s1[0] + s1[1]) + (s1[2] + s1[3])) + ((s2[0] + s2[1]) + (s2[2] + s2[3])) + ((s3[0] + s3[1]) + (s3[2] + s3[3]));
            const float fd = ((f0[0] + f0[1]) + (f0[2] + f0[3])) + ((f1[0] + f1[1]) + (f1[2] + f1[3])) + ((f2[0] + f2[1]) + (f2[2] + f2[3])) + ((f3[0] + f3[1]) + (f3[2] + f3[3]));
            const float z = fd * (1.0f / sqrtf(s * (1.0f / DM) + EPS)) + fbias_h;
            v[i] = fminf(z, 0.f) - log1pf(expf(-fabsf(z))); }
    }
#pragma unroll
    for (int i = 1; i < 8; ++i) v[i] += v[i - 1];
    const float tot = v[7]; float inc = tot;
#pragma unroll
    for (int o = 1; o < 64; o <<= 1) { const float y = __shfl_up(inc, o); if (lane >= o) inc += y; }
    if (lane == 63) scr[wave] = inc;
    __syncthreads();
    float pre = inc - tot;
#pragma unroll
    for (int w = 0; w < NWAVES; ++w) pre += (w < wave) ? scr[w] : 0.f;
    f32x4* dst = (f32x4*)(c2 + (size_t)(b * 4 + h) * S + 8 * tid);
    dst[0] = (f32x4){v[0] + pre, v[1] + pre, v[2] + pre, v[3] + pre} * LOG2E; dst[1] = (f32x4){v[4] + pre, v[5] + pre, v[6] + pre, v[7] + pre} * LOG2E;
    __syncthreads();
}

__device__ __forceinline__ float dot_row(const bf16* krow, const float (&q)[64]) {
    const GAS v4u* p = (const GAS v4u*)krow; float s = 0.f;
#pragma unroll
    for (int i = 0; i < 8; ++i) { const v4u w = p[i];
        s = fmaf(q[8 * i + 0], bflo(w.x), s); s = fmaf(q[8 * i + 1], bfhi(w.x), s); s = fmaf(q[8 * i + 2], bflo(w.y), s); s = fmaf(q[8 * i + 3], bfhi(w.y), s);
        s = fmaf(q[8 * i + 4], bflo(w.z), s); s = fmaf(q[8 * i + 5], bfhi(w.z), s); s = fmaf(q[8 * i + 6], bflo(w.w), s); s = fmaf(q[8 * i + 7], bfhi(w.w), s); }
    return s;
}
__device__ __forceinline__ void axpy_row(const bf16* vrow, float a, float p, float (&o)[64]) {
    const GAS v4u* q = (const GAS v4u*)vrow;
#pragma unroll
    for (int i = 0; i < 8; ++i) { const v4u w = q[i];
        o[8 * i + 0] = fmaf(p, bflo(w.x), o[8 * i + 0] * a); o[8 * i + 1] = fmaf(p, bfhi(w.x), o[8 * i + 1] * a); o[8 * i + 2] = fmaf(p, bflo(w.y), o[8 * i + 2] * a); o[8 * i + 3] = fmaf(p, bfhi(w.y), o[8 * i + 3] * a);
        o[8 * i + 4] = fmaf(p, bflo(w.z), o[8 * i + 4] * a); o[8 * i + 5] = fmaf(p, bfhi(w.z), o[8 * i + 5] * a); o[8 * i + 6] = fmaf(p, bflo(w.w), o[8 * i + 6] * a); o[8 * i + 7] = fmaf(p, bfhi(w.w), o[8 * i + 7] * a); }
}
#define NV_STEP(KEY, BIAS2, VALID) do { if (VALID) { \
        const bf16* kr_ = qkv + (rowb + (size_t)(KEY)) * QP; \
        const float s_ = dot_row(kr_ + kcol, q) + (BIAS2); \
        const float mn_ = fmaxf(m, s_), a_ = EX2(m - mn_), p_ = EX2(s_ - mn_); l = l * a_ + p_; m = mn_; \
        axpy_row(kr_ + vcol, a_, p_, o); } } while (0)
__device__ __forceinline__ void attn_naive_item(int type, int b, int h, int chunk, const bf16* qkv, bf16* mix, const float* biasT, const float* c2, const float* kmean, const float* sinks_l, int lane) {
    const int t0 = chunk * 64, t = t0 + lane; const size_t rowb = (size_t)b * S;
    int qcol, kcol, vcol;
    if (type == 0) { qcol = C_QA + 64 * h; kcol = C_KA + 64 * h; vcol = C_VA + 64 * h; }
    else if (type == 1) { qcol = C_QB + 64 * h; kcol = C_KB + 64 * h; vcol = C_VB + 64 * h; }
    else if (type == 2) { qcol = C_QC + 64 * h; kcol = C_KC + 64 * (h >> 1); vcol = C_VC + 64 * (h >> 1); }
    else { qcol = C_QD + 64 * h; kcol = C_KD + 64 * h; vcol = C_VD + 64 * h; }
    float q[64], o[64];
    { const GAS v4u* p = (const GAS v4u*)(qkv + (rowb + t) * QP + qcol);
#pragma unroll
      for (int i = 0; i < 8; ++i) { const v4u w = p[i]; q[8 * i] = bflo(w.x); q[8 * i + 1] = bfhi(w.x); q[8 * i + 2] = bflo(w.y); q[8 * i + 3] = bfhi(w.y); q[8 * i + 4] = bflo(w.z); q[8 * i + 5] = bfhi(w.z); q[8 * i + 6] = bflo(w.w); q[8 * i + 7] = bfhi(w.w); } }
#pragma unroll
    for (int d = 0; d < 64; ++d) o[d] = 0.f;
    float m = -1e30f, l = 0.f;
    if (type == 0) {
        const float* bt = biasT + h * 4096;
        for (int g = 0; g < 3; ++g) { const int dil = g == 0 ? 1 : g == 1 ? 4 : 16;
            for (int jj = 0; jj <= 128; ++jj) { const int key = t - dil * jj; const bool valid = key >= 0; const float b2 = bt[jj * dil]; NV_STEP(valid ? key : 0, b2, valid); } }
    } else if (type == 1) {
        const float* bt = biasT + (4 + h) * 4096; const int own = t0 >> 8;
        float g[16];
#pragma unroll
        for (int n = 0; n < 16; ++n) { g[n] = -INFINITY; if (n < own) { const float* km = kmean + ((size_t)(b * 4 + h) * 16 + n) * 64; float s = 0.f;
#pragma unroll
                for (int d = 0; d < 64; ++d) s = fmaf(q[d], km[d], s);
                g[n] = s; } }
        unsigned sel = 0u;
#pragma unroll
        for (int r = 0; r < 3; ++r) { float best = -INFINITY; int bi = -1;
#pragma unroll
            for (int n = 0; n < 16; ++n) if (n < own && !((sel >> n) & 1u) && g[n] > best) { best = g[n]; bi = n; }
            if (bi >= 0) sel |= 1u << bi; }
        for (int n = 0; n < own; ++n) { const bool pick = (sel >> n) & 1u;
            if (__ballot(pick) != 0ull) for (int i = 0; i < 256; ++i) { const int key = n * 256 + i; NV_STEP(key, bt[t - key], pick); } }
        for (int key = own * 256; key <= t0 + 63; ++key) { const bool valid = key <= t; NV_STEP(key, bt[valid ? t - key : 0], valid); }
    } else if (type == 2) {
        const float* bt = biasT + (8 + h) * 4096; const int jlo = t0 - 127 > 0 ? t0 - 127 : 0;
        for (int key = jlo; key <= t0 + 63; ++key) { const int dist = t - key; const bool valid = dist >= 0 && dist <= 127; NV_STEP(key, bt[valid ? dist : 0], valid); }
        l += EX2(sinks_l[h] * LOG2E - m);
    } else {
        const float* cc = c2 + (size_t)(b * 4 + h) * S; const float ct = cc[t];
        for (int key = 0; key <= t0 + 63; ++key) { const bool valid = key <= t; NV_STEP(key, ct - cc[key], valid); }
    }
    const float inv = 1.0f / l;
    GAS v4u* op = (GAS v4u*)(mix + (rowb + t) * DM + type * 256 + h * 64);
#pragma unroll
    for (int i = 0; i < 8; ++i) { v4u w; w.x = pk2(o[8 * i] * inv, o[8 * i + 1] * inv); w.y = pk2(o[8 * i + 2] * inv, o[8 * i + 3] * inv); w.z = pk2(o[8 * i + 4] * inv, o[8 * i + 5] * inv); w.w = pk2(o[8 * i + 6] * inv, o[8 * i + 7] * inv); op[i] = w; }
}
__device__ __forceinline__ void attn_naive_phase(const bf16* qkv, bf16* mix, const float* biasT, const float* c2, const float* kmean, const float* sinks_l, int gw, int NGW, int lane) {
    for (int idx = gw; idx < 4 * NB * 4 * 64; idx += NGW) {
        const int chunk = 63 - (idx >> 7), rem = idx & 127, type = rem >> 5, bh = rem & 31;
        if ((ATT_MFMA_MASK >> type) & 1) continue;
        attn_naive_item(type, bh >> 2, bh & 3, chunk, qkv, mix, biasT, c2, kmean, sinks_l, lane);
    }
}

__device__ __forceinline__ void attn_mfma_phase(LAS unsigned char* lds, unsigned char* ws, const float* sinks_l, int l, int c, int G) {
    int cur_tab = -1, cur_tab2 = -1, cur_tab3 = -1;
#define ATT_OPAQUE() int b = b0_, h = h0_, hs = hs0_; asm volatile("" : "+s"(b), "+s"(h), "+s"(hs)); \
        const bf16* qkv = (const bf16*)(ws + WS_QKV); bf16* mix = (bf16*)(ws + WS_MIX); const float* biasT = (const float*)(ws + WS_BIAST)
    for (int v = c; v < 256; v += G) {
        const int b0_ = (v & 31) >> 2, h0_ = v & 3, hs0_ = v >> 5;
        for (int j = 0; j < 2; ++j) {
            if ((ATT_MFMA_MASK >> 1) & 1) for (int d_ = 0; d_ < ADUP(1); ++d_) { ATT_OPAQUE(); const int qb = j ? hs : 15 - hs;
                if ((ATT2_MASK >> 1) & 1) att2::attn_unit2<att2::T_B>(lds, qkv, b, h, qb, biasT + (4 + h) * 4096, 4 + h, cur_tab2, nullptr, nullptr, (const float*)(ws + WS_CTL) + CW_KMEAN + (size_t)l * 32768 + (size_t)(b * 4 + h) * 16 * 64, mix + 256 + 64 * h, DM);
                else att::attn_item<att::T_B>(lds, qkv, b, h, qb, 0, 1, 0, 0, 0, 0, biasT + (4 + h) * 4096, 4 + h, cur_tab, nullptr, nullptr, (const float*)(ws + WS_CTL) + CW_KMEAN + (size_t)l * 32768 + (size_t)(b * 4 + h) * 16 * 64, 0.f, mix + 256 + 64 * h, DM, nullptr); }
            if ((ATT_MFMA_MASK >> 3) & 1) for (int d_ = 0; d_ < ADUP(3); ++d_) { ATT_OPAQUE(); const int qb = j ? hs : 15 - hs; if (j) h = (h + 2) & 3;
                if ((ATT2_MASK >> 3) & 1) att2::attn_unit2<att2::T_D>(lds, qkv, b, h, qb, nullptr, -1, cur_tab2, (const float*)(ws + WS_C2) + (size_t)(b * 4 + h) * S, (const unsigned*)(ws + WS_CTL) + CW_NORM + 128 * l + (b * 4 + h) * 4, nullptr, mix + 768 + 64 * h, DM);
                else att::attn_item<att::T_D>(lds, qkv, b, h, qb, 0, 1, 0, 0, 0, 0, nullptr, -1, cur_tab, (const float*)(ws + WS_C2) + (size_t)(b * 4 + h) * S, (const unsigned*)(ws + WS_CTL) + CW_NORM + 128 * l + (b * 4 + h) * 4, nullptr, 0.f, mix + 768 + 64 * h, DM, nullptr); }
        }
        if ((ATT_MFMA_MASK & 5) == 5) for (int d_ = 0; d_ < ADUP(0); ++d_) {
#define A3_GEOM(J) const int cls_ = (J) >> 1, rest_ = 2 * hs + ((J) & 1); const int dil_ = cls_ <= 1 ? 1 : cls_ == 2 ? 4 : 16, qb_ = cls_ <= 1 ? rest_ : cls_ == 2 ? rest_ >> 2 : 0, res_ = cls_ <= 1 ? 0 : cls_ == 2 ? rest_ & 3 : rest_; const bool swa_ = cls_ == 0
#define A3_SRC(J, OUT) do { A3_GEOM(J); const bf16* rb_ = qkv + ((size_t)b * S + res_) * QP; OUT.k = rb_ + (swa_ ? C_KC + 64 * (h >> 1) : C_KA + 64 * h); OUT.v = rb_ + (swa_ ? C_VC + 64 * (h >> 1) : C_VA + 64 * h); OUT.rs = dil_ * QP; OUT.kw = 256 * qb_ - 128; OUT.tmin = qb_ == 0 ? 2 : 0; } while (0)
            att3::BandSrc cur_, nx_; nx_.k = nullptr; nx_.v = nullptr; nx_.rs = 0; nx_.kw = 0; nx_.tmin = 0;
            { ATT_OPAQUE(); A3_SRC(0, cur_); const int wid_ = __builtin_amdgcn_readfirstlane(threadIdx.x >> 6), lane_ = threadIdx.x & 63; const unsigned l0_ = (unsigned)(uintptr_t)lds;
              att3::band_dma(l0_ + att3::L_K, cur_.k, cur_.rs, cur_.kw, cur_.tmin, false, wid_, lane_); att3::band_dma(l0_ + att3::L_V, cur_.v, cur_.rs, cur_.kw, cur_.tmin, true, wid_, lane_); }
            for (int j8 = 0; j8 < 8; ++j8) { ATT_OPAQUE();
                A3_GEOM(j8); const size_t g = (size_t)(cls_ - 1);
                if (j8 < 7) A3_SRC(j8 + 1, nx_);
#define A3_CALL(D) att3::attn_band<D>(lds, qkv, b, h, qb_, res_, swa_ ? 127 : 128, (swa_ ? C_QC : C_QA) + 64 * h, swa_ ? C_KC + 64 * (h >> 1) : C_KA + 64 * h, swa_ ? C_VC + 64 * (h >> 1) : C_VA + 64 * h, \
                    biasT + ((swa_ ? 8 : 0) + h) * 4096, cls_ * 4 + h, cur_tab3, swa_ ? sinks_l[h] * LOG2E : -INFINITY, \
                    swa_ ? mix + 512 + 64 * h : (bf16*)(ws + WS_PA) + g * M * 256 + 64 * h, swa_ ? DM : 256, swa_ ? nullptr : (float*)(ws + WS_LSE) + g * M * 4 + h, nx_, j8 < 7)
                if (dil_ == 1) A3_CALL(1); else if (dil_ == 4) A3_CALL(4); else A3_CALL(16);
#undef A3_CALL
                cur_ = nx_;
            }
#undef A3_GEOM
#undef A3_SRC
        }
    }
#undef ATT_OPAQUE
}

struct Args { const float* in[13]; float* out; unsigned char* ws; int ph_lo, ph_hi, li, pad; };
__global__ void __launch_bounds__(NWAVES * 64, 2) hybrid_fwd(Args args) {
    extern __shared__ __attribute__((aligned(16))) unsigned char lds_raw[];
    LAS unsigned char* lds = (LAS unsigned char*)lds_raw;
    volatile LAS unsigned* MISC = (volatile LAS unsigned*)(lds + MISC_OFF);
    const int tid = threadIdx.x, lane = tid & 63, wave = __builtin_amdgcn_readfirstlane(tid >> 6);
    const int G = gridDim.x; const int bx = blockIdx.x; const int vcu = (G % 8 == 0) ? (bx % 8) * (G / 8) + bx / 8 : bx;
    const int gw = vcu * NWAVES + wave, NGW = G * NWAVES;
    Ptrs P;
    P.x = args.in[0]; P.norm1_g = args.in[1]; P.w_in = args.in[2]; P.f_bias = args.in[3]; P.sinks = args.in[4]; P.mix_g = args.in[5]; P.w_out = args.in[6];
    P.norm2_g = args.in[7]; P.w_gate = args.in[8]; P.w_up = args.in[9]; P.w_down = args.in[10]; P.rel_bias = args.in[11]; P.final_g = args.in[12];
    P.out = args.out; P.ws = args.ws;
    unsigned char* ws = args.ws;
    gu32* ctl = (gu32*)(ws + WS_CTL);
    bf16* XB = (bf16*)(ws + WS_XB); bf16* MIX = (bf16*)(ws + WS_MIX); bf16* QKV = (bf16*)(ws + WS_QKV); bf16* ACT = (bf16*)(ws + WS_QKV);
    float* SSB = (float*)(ws + WS_SS); float* FDB = (float*)(ws + WS_FD); float* LF = (float*)(ws + WS_LF); float* CC2 = (float*)(ws + WS_C2); float* KMEAN = (float*)(ws + WS_KMEAN);
    const float* BIAST = (const float*)(ws + WS_BIAST);
    for (int u = tid; u < (LDS_BYTES - LDSCTL_OFF) / 4; u += NWAVES * 64) ((LAS unsigned*)(lds + LDSCTL_OFF))[u] = 0u;
    __syncthreads();
    XcdBarrier bar; bar.bar = (unsigned*)(ctl + CW_BAR) + args.li * XCD_BAR_WORDS; bar.x = 0; bar.st = nullptr;
    if (N_LAUNCHES == 1) bar = xcd_barrier_post((unsigned*)(ctl + CW_BAR) + args.li * XCD_BAR_WORDS, MISC + 8);
    const int lo = args.ph_lo, hi = args.ph_hi;
#define IN(k) (lo <= (k) && (k) < hi)
#define SEAM(k) do { if (IN(k) && IN((k) + 1)) { if (N_LAUNCHES == 1) xcd_barrier(bar); } } while (0)

    if (IN(0)) {
        phase_prep(P, lds, 0, (G == 256) ? 1 : DEPTH, true, gw, NGW, wave, lane);
        __syncthreads();
        { LAS float* wl = (LAS float*)(lds + RING_OFF); for (int i = tid; i < DM * 4; i += NWAVES * 64) { const int k = i >> 2, h = i & 3; wl[i] = P.norm1_g[k] * P.w_in[(size_t)k * NIN + 2816 + h]; } }
        __syncthreads();
        row_pass<true>(P.x, XB, SSB, (const LAS float*)(lds + RING_OFF), P.f_bias, LF, gw, NGW, lane);
        SEAM(0);
    }

    { constexpr int l = 0;
    {
        const int pb = 1 + PH_PER_LAYER * l;
        if (IN(pb + 0)) {
            pg8::Gemm g{XB, (const bf16*)(ws + WS_WIN) + (size_t)l * QP * DM, M, QP, DM}; pg8::StaticOrder So; So.init(M, QP, G, bx);
            pg8::EpiQKV E{QKV, QP, SSB, C2, (LAS float*)(lds + LDSCTL_OFF + 1024), (float*)(ctl + CW_KMEAN) + (size_t)l * 32768, (unsigned*)(ctl + CW_NORM + 128 * l)};
            pg8::rstd_table((LAS float*)(lds + LDSCTL_OFF + 1024), SSB, So);
            pg8::gemm_phase<pg8::EpiQKV, pg8::StaticOrder, PG8_ALIGN, PG8_SP2>(lds + RING_OFF, g, So, E);
            for (int j = bx; j < 32 + 128; j += G) if (j >= 128) { const int bh = j - 128;
                scan_job(bh >> 2, bh & 3, l == 0 ? LF : nullptr, SSB, FDB, P.f_bias[l * 4 + (bh & 3)], CC2, (LAS float*)(lds + LDSCTL_OFF + 1024), tid, lane, wave); }
            if (l == 0 && G == 256 && bx >= 128) phase_prep(P, lds, 1, DEPTH, false, (bx - 128) * NWAVES + wave, 128 * NWAVES, wave, lane);
            SEAM(pb + 0);
        }
        if (IN(pb + 1)) {
            if (ATT_MFMA_MASK != 15) attn_naive_phase(QKV, MIX, BIAST, CC2, KMEAN, P.sinks + l * 4, gw, NGW, lane);
            if (ATT_MFMA_MASK != 0) { __syncthreads(); attn_mfma_phase(lds + RING_OFF, ws, P.sinks + l * 4, l, bx, G); }
            SEAM(pb + 1); }
        if (IN(pb + 2)) { mixnorm_pass(MIX, ws + WS_MIX8, (const bf16*)(ws + WS_PA), (const float*)(ws + WS_LSE), gw, NGW, lane); SEAM(pb + 2); }
        if (IN(pb + 3)) {
            pg8::Gemm g{G2_FP8 ? (const bf16*)(ws + WS_MIX8) : MIX, G2_FP8 ? (const bf16*)(ws + WS_WOUT + (size_t)l * DM * DM) : (const bf16*)(ws + WS_WOUT) + (size_t)l * DM * DM, M, DM, DM}; pg8::StaticOrder So; So.init(M, DM, G, bx);
            pg8::EpiResidX E{XB, SSB, nullptr, nullptr, DM, G2_FP8 ? 1.0f / WSCALE : 1.0f, ws + WS_X8};
            pg8::gemm_phase<pg8::EpiResidX, pg8::StaticOrder, PG8_ALIGN, PG8_SP2, (G2_FP8 != 0)>(lds + RING_OFF, g, So, E);
            SEAM(pb + 3);
        }
        if (IN(pb + 4)) {
            pg8::Gemm g{(const bf16*)(ws + WS_X8), (const bf16*)(ws + WS_WGU + (size_t)l * NGU * DM), M, NGU, DM}; pg8::StaticOrder So; So.init(M, NGU, G, bx);
            pg8::EpiSwiGLU E{(unsigned char*)ACT, DFF, SSB, (LAS float*)(lds + LDSCTL_OFF + 1024), 1.0f / WSCALE, ASCALE};
            pg8::rstd_table((LAS float*)(lds + LDSCTL_OFF + 1024), SSB, So);
            pg8::gemm_phase<pg8::EpiSwiGLU, pg8::StaticOrder, PG8_ALIGN, PG8_SP2, true>(lds + RING_OFF, g, So, E);
            SEAM(pb + 4);
        }
        if (IN(pb + 5)) {
            pg8::Gemm g{ACT, (const bf16*)(ws + WS_WDN + (size_t)l * DM * DFF), M, DM, DFF}; pg8::StaticOrder So; So.init(M, DM, G, bx);
            pg8::EpiResidX E{XB, SSB, (l + 1 < DEPTH) ? (const float*)(ws + WS_WFD) + (size_t)(l + 1) * DM * 4 : nullptr, FDB, DM, 1.0f / (WSCALE * ASCALE), nullptr};
            pg8::gemm_phase<pg8::EpiResidX, pg8::StaticOrder, PG8_ALIGN, PG8_SP2, true>(lds + RING_OFF, g, So, E);
            SEAM(pb + 5);
        }
    }
    }
    { constexpr int l = 1;
    {
        const int pb = 1 + PH_PER_LAYER * l;
        if (IN(pb + 0)) {
            pg8::Gemm g{XB, (const bf16*)(ws + WS_WIN) + (size_t)l * QP * DM, M, QP, DM}; pg8::StaticOrder So; So.init(M, QP, G, bx);
            pg8::EpiQKV E{QKV, QP, SSB, C2, (LAS float*)(lds + LDSCTL_OFF + 1024), (float*)(ctl + CW_KMEAN) + (size_t)l * 32768, (unsigned*)(ctl + CW_NORM + 128 * l)};
            pg8::rstd_table((LAS float*)(lds + LDSCTL_OFF + 1024), SSB, So);
            pg8::gemm_phase<pg8::EpiQKV, pg8::StaticOrder, PG8_ALIGN, PG8_SP2>(lds + RING_OFF, g, So, E);
            for (int j = bx; j < 32 + 128; j += G) if (j >= 128) { const int bh = j - 128;
                scan_job(bh >> 2, bh & 3, l == 0 ? LF : nullptr, SSB, FDB, P.f_bias[l * 4 + (bh & 3)], CC2, (LAS float*)(lds + LDSCTL_OFF + 1024), tid, lane, wave); }
            if (l == 0 && G == 256 && bx >= 128) phase_prep(P, lds, 1, DEPTH, false, (bx - 128) * NWAVES + wave, 128 * NWAVES, wave, lane);
            SEAM(pb + 0);
        }
        if (IN(pb + 1)) {
            if (ATT_MFMA_MASK != 15) attn_naive_phase(QKV, MIX, BIAST, CC2, KMEAN, P.sinks + l * 4, gw, NGW, lane);
            if (ATT_MFMA_MASK != 0) { __syncthreads(); attn_mfma_phase(lds + RING_OFF, ws, P.sinks + l * 4, l, bx, G); }
            SEAM(pb + 1); }
        if (IN(pb + 2)) { mixnorm_pass(MIX, ws + WS_MIX8, (const bf16*)(ws + WS_PA), (const float*)(ws + WS_LSE), gw, NGW, lane); SEAM(pb + 2); }
        if (IN(pb + 3)) {
            pg8::Gemm g{G2_FP8 ? (const bf16*)(ws + WS_MIX8) : MIX, G2_FP8 ? (const bf16*)(ws + WS_WOUT + (size_t)l * DM * DM) : (const bf16*)(ws + WS_WOUT) + (size_t)l * DM * DM, M, DM, DM}; pg8::StaticOrder So; So.init(M, DM, G, bx);
            pg8::EpiResidX E{XB, SSB, nullptr, nullptr, DM, G2_FP8 ? 1.0f / WSCALE : 1.0f, ws + WS_X8};
            pg8::gemm_phase<pg8::EpiResidX, pg8::StaticOrder, PG8_ALIGN, PG8_SP2, (G2_FP8 != 0)>(lds + RING_OFF, g, So, E);
            SEAM(pb + 3);
        }
        if (IN(pb + 4)) {
            pg8::Gemm g{(const bf16*)(ws + WS_X8), (const bf16*)(ws + WS_WGU + (size_t)l * NGU * DM), M, NGU, DM}; pg8::StaticOrder So; So.init(M, NGU, G, bx);
            pg8::EpiSwiGLU E{(unsigned char*)ACT, DFF, SSB, (LAS float*)(lds + LDSCTL_OFF + 1024), 1.0f / WSCALE, ASCALE};
            pg8::rstd_table((LAS float*)(lds + LDSCTL_OFF + 1024), SSB, So);
            pg8::gemm_phase<pg8::EpiSwiGLU, pg8::StaticOrder, PG8_ALIGN, PG8_SP2, true>(lds + RING_OFF, g, So, E);
            SEAM(pb + 4);
        }
        if (IN(pb + 5)) {
            pg8::Gemm g{ACT, (const bf16*)(ws + WS_WDN + (size_t)l * DM * DFF), M, DM, DFF}; pg8::StaticOrder So; So.init(M, DM, G, bx);
            pg8::EpiResidX E{XB, SSB, (l + 1 < DEPTH) ? (const float*)(ws + WS_WFD) + (size_t)(l + 1) * DM * 4 : nullptr, FDB, DM, 1.0f / (WSCALE * ASCALE), nullptr};
            pg8::gemm_phase<pg8::EpiResidX, pg8::StaticOrder, PG8_ALIGN, PG8_SP2, true>(lds + RING_OFF, g, So, E);
            SEAM(pb + 5);
        }
    }
    }
    if (IN(NPHASE - 1)) final_pass(XB, P.out, P.final_g, SSB, gw, NGW, lane);
#undef IN
#undef SEAM
}

extern "C" void kernel_launch(void* const* d_in, const int* in_sizes, int n_in, void* d_out, int out_size, void* d_ws, size_t ws_size, hipStream_t stream) {
    static int grid = 0;
    if (grid == 0) {
        if (n_in != 13 || in_sizes[0] != M * DM || out_size != M * DM || ws_size < WS_END) { fprintf(stderr, "kernel_launch: unexpected shapes (n_in %d, in0 %d, out %d, ws %zu); nothing launched\n", n_in, n_in > 0 ? in_sizes[0] : -1, out_size, ws_size); grid = -1; return; }
        int dev = 0, cus = 0, per_cu = 0;
        if (hipGetDevice(&dev) != hipSuccess || hipDeviceGetAttribute(&cus, hipDeviceAttributeMultiprocessorCount, dev) != hipSuccess) { fprintf(stderr, "kernel_launch: device query failed\n"); grid = -1; return; }
        if (hipFuncSetAttribute((const void*)hybrid_fwd, hipFuncAttributeMaxDynamicSharedMemorySize, LDS_BYTES) != hipSuccess) { fprintf(stderr, "kernel_launch: hipFuncSetAttribute failed\n"); grid = -1; return; }
        if (hipOccupancyMaxActiveBlocksPerMultiprocessor(&per_cu, (const void*)hybrid_fwd, NWAVES * 64, LDS_BYTES) != hipSuccess || per_cu < 1)
            fprintf(stderr, "kernel_launch: note: occupancy query reports %d workgroups per CU\n", per_cu);
        (void)hipGetLastError();
        grid = cus;
    }
    if (grid < 0) return;
    if (hipMemsetAsync((char*)d_ws + WS_CTL, 0, CTL_ZERO_BYTES, stream) != hipSuccess) { fprintf(stderr, "kernel_launch: hipMemsetAsync failed\n"); return; }
    Args a{};
    for (int i = 0; i < 13; ++i) a.in[i] = (const float*)d_in[i];
    a.out = (float*)d_out; a.ws = (unsigned char*)d_ws;
    const int n_l = (PROBE_PHASE >= 0) ? 3 : N_LAUNCHES;
    for (int li = 0; li < n_l; ++li) {
        if (PROBE_PHASE >= 0) { a.ph_lo = li == 0 ? 0 : li == 1 ? PROBE_PHASE : PROBE_PHASE + 1; a.ph_hi = li == 0 ? PROBE_PHASE + 1 : li == 1 ? PROBE_PHASE + 1 : NPHASE; a.li = li; if (a.ph_lo >= a.ph_hi) continue; }
        else { a.ph_lo = (N_LAUNCHES == 1) ? 0 : li; a.ph_hi = (N_LAUNCHES == 1) ? NPHASE : li + 1; a.li = (N_LAUNCHES == 1) ? 0 : li; }
        hipLaunchKernelGGL(hybrid_fwd, dim3(grid), dim3(NWAVES * 64), LDS_BYTES, stream, a);
        const hipError_t le = hipPeekAtLastError();
        if (le != hipSuccess) { fprintf(stderr, "kernel_launch: launch %d failed: %s\n", li, hipGetErrorName(le)); break; }
    }
}
```

```cpp
#include <hip/hip_runtime.h>
#include <cstdio>
#include <cstdint>
#ifndef MK_N_LAUNCHES
#define MK_N_LAUNCHES 1
#endif
#define EX2(x) __builtin_amdgcn_exp2f(x)
#ifndef ATT_MFMA_MASK
#define ATT_MFMA_MASK 15
#endif
#ifndef DUP_MASK
#define DUP_MASK 0
#endif
#define DUPN(k) ((((DUP_MASK) >> (k)) & 1) + 1)
#ifndef ATT_DUP_TYPES
#define ATT_DUP_TYPES 0
#endif
#define ADUP(t) ((((ATT_DUP_TYPES) >> (t)) & 1) + 1)
#ifndef PROBE_PHASE
#define PROBE_PHASE -1
#endif
#ifndef ATT2_MASK
#define ATT2_MASK 10
#endif
#ifndef ATT3_ON
#define ATT3_ON 1
#endif
#ifndef G2_FP8
#define G2_FP8 0
#endif
namespace pg8 {
#define PG8_LAS __attribute__((address_space(3)))
typedef unsigned short bf16_t;
typedef short bf16x8 __attribute__((ext_vector_type(8)));
typedef float f32x4 __attribute__((ext_vector_type(4)));
typedef unsigned u32x4 __attribute__((ext_vector_type(4)));
typedef int i32x4_t __attribute__((ext_vector_type(4)));
typedef int i32x8_t __attribute__((ext_vector_type(8)));
constexpr int BM = 256, BK = 64, HALF = 128, HTB = HALF * BK * 2  , STAGE_BYTES = 8 * HTB, NXCD = 8, WGM = 8;

__host__ __device__ __forceinline__ int lds_byte(int r, int c) { const int st = (r >> 4) * 2 + (c >> 5), rr = r & 15, cc = c & 31, ob = rr * 64 + cc * 2; return st * 1024 + (ob ^ (((ob >> 9) & 1) << 5)); }
__host__ __device__ __forceinline__ void stage_rc(int b, int& R, int& C) { const int st = b / 1024, sb = b % 1024, swz = sb ^ (((sb >> 9) & 1) << 5); R = (st >> 1) * 16 + swz / 64; C = (st & 1) * 32 + (swz % 64) / 2; }
__host__ __device__ __forceinline__ int perm32(int rho) { const int n = rho >> 4, i = rho & 15; return 8 * (i >> 2) + 4 * n + (i & 3); }

struct Unit { int pm, pn, ui; };
struct Gemm { const bf16_t* A; const bf16_t* Bt; int M, N, K; };

struct StaticOrder {
    int nM, nN, nwg, G, c;
    __host__ __device__ void init(int M, int N, int G_, int c_) { nM = M / BM; nN = N / BM; nwg = nM * nN; G = G_; c = c_; }
    __host__ __device__ bool next(int i, Unit& u) const {
        const long L = (long)i * G + c; if (L >= nwg) return false;
        int wgid = (int)L; { const int q = nwg / NXCD, r = nwg % NXCD, xcd = wgid % NXCD, off = wgid / NXCD; wgid = (xcd < r ? xcd * (q + 1) : r * (q + 1) + (xcd - r) * q) + off; }
        const int nig = WGM * nN, gid = wgid / nig, fm = gid * WGM, gsz = (nM - fm) < WGM ? (nM - fm) : WGM;
        u.pm = fm + ((wgid % nig) % gsz); u.pn = (wgid % nig) / gsz; u.ui = i; return true;
    }
    __device__ __forceinline__ void a_ready(const Unit&) const {}
    __device__ __forceinline__ void done(const Unit&) const {}
};

__device__ __forceinline__ unsigned cvt_pk_bf16(float lo, float hi) { unsigned r; asm volatile("v_cvt_pk_bf16_f32 %0, %1, %2" : "=v"(r) : "v"(lo), "v"(hi)); return r; }

#ifndef WT_STORES
#define WT_STORES 0
#endif
__device__ __forceinline__ void st16_wt(void* p, u32x4 v) {
#if WT_STORES
    asm volatile("global_store_dwordx4 %0, %1, off sc1\n\ts_nop 1" :: "v"(p), "v"(v) : "memory");
#else
    *(u32x4*)p = v;
#endif
}
typedef unsigned u32x2_t __attribute__((ext_vector_type(2)));
__device__ __forceinline__ void st8_wt(void* p, u32x2_t v) {
#if WT_STORES
    asm volatile("global_store_dwordx2 %0, %1, off sc1\n\ts_nop 1" :: "v"(p), "v"(v) : "memory");
#else
    *(u32x2_t*)p = v;
#endif
}
__device__ __forceinline__ unsigned pk4_fp8(float a, float b, float c, float d) {
    a = __builtin_amdgcn_fmed3f(a, -448.f, 448.f); b = __builtin_amdgcn_fmed3f(b, -448.f, 448.f); c = __builtin_amdgcn_fmed3f(c, -448.f, 448.f); d = __builtin_amdgcn_fmed3f(d, -448.f, 448.f);
    unsigned w = __builtin_amdgcn_cvt_pk_fp8_f32(a, b, 0u, false); return __builtin_amdgcn_cvt_pk_fp8_f32(c, d, w, true);
}
__device__ __forceinline__ float rstd_from_slots(const float* ss, int r) {
    const f32x4* p = (const f32x4*)(ss + (size_t)r * 16); const f32x4 a = p[0], b = p[1], c = p[2], d = p[3];
    const float s = ((a[0] + a[1]) + (a[2] + a[3])) + ((b[0] + b[1]) + (b[2] + b[3])) + ((c[0] + c[1]) + (c[2] + c[3])) + ((d[0] + d[1]) + (d[2] + d[3]));
    return 1.0f / sqrtf(s * (1.0f / 1024.0f) + 1e-6f);
}

template <class Sched> __device__ __forceinline__ void rstd_table(PG8_LAS float* tbl, const float* ss, const Sched& S) {
    Unit u;
    for (int i = 0; S.next(i, u); ++i) { if (threadIdx.x < 256) tbl[i * 256 + threadIdx.x] = rstd_from_slots(ss, u.pm * BM + (int)threadIdx.x); }
    __syncthreads();
}
struct EpiQKV {
    static constexpr bool PERM = true, AFTER_DRAIN = false;
    bf16_t* O; int ldc; const float* rstd; float qscale; PG8_LAS float* rsl;
    float* kmean; unsigned* nrm;
    __device__ __forceinline__ void operator()(const f32x4 (&acc)[2][2][4][2], const Unit& u, int wr, int wc, int fr, int fq) const {
        const int row0 = u.pm * BM + wr * 64 + fr, col0 = u.pn * BM + wc * 32 + 8 * fq;
        const float ts = (u.pn == 0 || u.pn == 3 || u.pn == 6 || u.pn == 8) ? qscale : 1.0f;
        const PG8_LAS float* sc = rsl + u.ui * 256 + wr * 64;
        const bool do_km = (u.pn == 4);
        const bool do_nrm = (u.pn == 8 || u.pn == 9);
        float cs[2][8]; float nmx[2] = {0.f, 0.f};
#pragma unroll
        for (int bj = 0; bj < 2; ++bj)
#pragma unroll
            for (int j = 0; j < 8; ++j) cs[bj][j] = 0.f;
#pragma unroll
        for (int ai = 0; ai < 2; ++ai)
#pragma unroll
            for (int m = 0; m < 4; ++m) { const int r = row0 + ai * HALF + m * 16; const float s = sc[ai * HALF + m * 16 + fr] * ts; bf16_t* rowp = O + (size_t)r * ldc + col0;
#pragma unroll
                for (int bj = 0; bj < 2; ++bj) { const f32x4 v0 = acc[ai][bj][m][0] * s, v1 = acc[ai][bj][m][1] * s;
                    u32x4 w; w.x = cvt_pk_bf16(v0[0], v0[1]); w.y = cvt_pk_bf16(v0[2], v0[3]); w.z = cvt_pk_bf16(v1[0], v1[1]); w.w = cvt_pk_bf16(v1[2], v1[3]);
                    st16_wt(rowp + bj * HALF, w);
                    if (do_km) {
#pragma unroll
                        for (int i = 0; i < 4; ++i) { cs[bj][i] += v0[i]; cs[bj][4 + i] += v1[i]; } }
                    if (do_nrm) { float q = (v0[0] * v0[0] + v0[1] * v0[1]) + (v0[2] * v0[2] + v0[3] * v0[3]) + (v1[0] * v1[0] + v1[1] * v1[1]) + (v1[2] * v1[2] + v1[3] * v1[3]);
                        q += __shfl_xor(q, 16); q += __shfl_xor(q, 32); nmx[bj] = __builtin_fmaxf(nmx[bj], q); } } }
        if (do_km) {
#pragma unroll
            for (int bj = 0; bj < 2; ++bj)
#pragma unroll
                for (int j = 0; j < 8; ++j) { float v = cs[bj][j]; v += __shfl_xor(v, 1); v += __shfl_xor(v, 2); v += __shfl_xor(v, 4); v += __shfl_xor(v, 8);
                    if (fr == 0) { const int cg = bj * HALF + wc * 32 + 8 * fq + j; atomicAdd(kmean + ((size_t)((u.pm >> 4) * 4 + (cg >> 6)) * 16 + (u.pm & 15)) * 64 + (cg & 63), v * (1.0f / 256.0f)); } }
        }
        if (do_nrm) {
#pragma unroll
            for (int bj = 0; bj < 2; ++bj) { float v = nmx[bj]; v = __builtin_fmaxf(v, __shfl_xor(v, 1)); v = __builtin_fmaxf(v, __shfl_xor(v, 2)); v = __builtin_fmaxf(v, __shfl_xor(v, 4)); v = __builtin_fmaxf(v, __shfl_xor(v, 8));
                if (fr == 0 && fq == 0) atomicMax(nrm + ((u.pm >> 4) * 4 + 2 * bj + (wc >> 1)) * 4 + (u.pn == 9 ? 2 : 0) + (wc & 1), __float_as_uint(v)); }
        }
    }
};
struct EpiResid {
    static constexpr bool PERM = false, AFTER_DRAIN = false;
    const float* base; float* out; int ldc;
    __device__ __forceinline__ void operator()(const f32x4 (&acc)[2][2][4][2], const Unit& u, int wr, int wc, int fr, int fq) const {
        const int row0 = u.pm * BM + wr * 64 + fr, col0 = u.pn * BM + wc * 32 + 4 * fq;
#pragma unroll
        for (int ai = 0; ai < 2; ++ai)
#pragma unroll
            for (int m = 0; m < 4; ++m) { const size_t off = (size_t)(row0 + ai * HALF + m * 16) * ldc + col0;
#pragma unroll
                for (int bj = 0; bj < 2; ++bj)
#pragma unroll
                    for (int n = 0; n < 2; ++n) { const f32x4 b = *(const f32x4*)(base + off + bj * HALF + n * 16); *(f32x4*)(out + off + bj * HALF + n * 16) = b + acc[ai][bj][m][n]; } }
    }
};
typedef __bf16 bf16x2_t __attribute__((ext_vector_type(2)));
__device__ __forceinline__ float dot2_bf16(unsigned a, unsigned b, float acc) { return __builtin_amdgcn_fdot2_f32_bf16(__builtin_bit_cast(bf16x2_t, a), __builtin_bit_cast(bf16x2_t, b), acc, false); }
struct EpiResidX {
    static constexpr bool PERM = true, AFTER_DRAIN = false;
    bf16_t* xb; float* ss; const unsigned* wfd; float* fdp; int ldc; float ascale; unsigned char* x8;
    __device__ __forceinline__ void operator()(const f32x4 (&acc)[2][2][4][2], const Unit& u, int wr, int wc, int fr, int fq) const {
        const int row0 = u.pm * BM + wr * 64 + fr, col0 = u.pn * BM + wc * 32 + 8 * fq; const int slot = u.pn * 4 + wc;
        u32x4 wp0[4];
        if (wfd) {
#pragma unroll
            for (int p = 0; p < 4; ++p) wp0[p] = *(const u32x4*)(wfd + (size_t)(col0 / 2 + p) * 4); }
#pragma unroll
        for (int ai = 0; ai < 2; ++ai)
#pragma unroll
            for (int m = 0; m < 4; ++m) { const int r = row0 + ai * HALF + m * 16; bf16_t* rowp = xb + (size_t)r * ldc + col0;
                float s2 = 0.f, f0 = 0.f, f1 = 0.f, f2 = 0.f, f3 = 0.f;
#pragma unroll
                for (int bj = 0; bj < 2; ++bj) { const u32x4 xw = *(const u32x4*)(rowp + bj * HALF);
                    float v[8];
                    v[0] = fmaf(acc[ai][bj][m][0][0], ascale, __builtin_bit_cast(float, xw.x << 16)); v[1] = fmaf(acc[ai][bj][m][0][1], ascale, __builtin_bit_cast(float, xw.x & 0xffff0000u));
                    v[2] = fmaf(acc[ai][bj][m][0][2], ascale, __builtin_bit_cast(float, xw.y << 16)); v[3] = fmaf(acc[ai][bj][m][0][3], ascale, __builtin_bit_cast(float, xw.y & 0xffff0000u));
                    v[4] = fmaf(acc[ai][bj][m][1][0], ascale, __builtin_bit_cast(float, xw.z << 16)); v[5] = fmaf(acc[ai][bj][m][1][1], ascale, __builtin_bit_cast(float, xw.z & 0xffff0000u));
                    v[6] = fmaf(acc[ai][bj][m][1][2], ascale, __builtin_bit_cast(float, xw.w << 16)); v[7] = fmaf(acc[ai][bj][m][1][3], ascale, __builtin_bit_cast(float, xw.w & 0xffff0000u));
                    u32x4 w; w.x = cvt_pk_bf16(v[0], v[1]); w.y = cvt_pk_bf16(v[2], v[3]); w.z = cvt_pk_bf16(v[4], v[5]); w.w = cvt_pk_bf16(v[6], v[7]);
                    st16_wt(rowp + bj * HALF, w);
                    if (x8) { u32x2_t q; q.x = pk4_fp8(v[0], v[1], v[2], v[3]); q.y = pk4_fp8(v[4], v[5], v[6], v[7]); st8_wt(x8 + (size_t)r * ldc + col0 + bj * HALF, q); }
#pragma unroll
                    for (int i = 0; i < 8; ++i) s2 = fmaf(v[i], v[i], s2);
                    if (wfd) {
#pragma unroll
                        for (int p = 0; p < 4; ++p) { const unsigned vp = p == 0 ? w.x : p == 1 ? w.y : p == 2 ? w.z : w.w; const u32x4 wq = bj == 0 ? wp0[p] : *(const u32x4*)(wfd + (size_t)((col0 + HALF) / 2 + p) * 4);
                            f0 = dot2_bf16(vp, wq.x, f0); f1 = dot2_bf16(vp, wq.y, f1); f2 = dot2_bf16(vp, wq.z, f2); f3 = dot2_bf16(vp, wq.w, f3); } } }
                s2 += __shfl_xor(s2, 16); s2 += __shfl_xor(s2, 32);
                if (wfd) { f0 += __shfl_xor(f0, 16); f0 += __shfl_xor(f0, 32); f1 += __shfl_xor(f1, 16); f1 += __shfl_xor(f1, 32); f2 += __shfl_xor(f2, 16); f2 += __shfl_xor(f2, 32); f3 += __shfl_xor(f3, 16); f3 += __shfl_xor(f3, 32); }
                if (fq == 0) { ss[(size_t)r * 16 + slot] = s2; if (wfd) { float* fp = fdp + (size_t)r * 64 + slot; fp[0] = f0; fp[16] = f1; fp[32] = f2; fp[48] = f3; } } }
    }
};
typedef float f32x2 __attribute__((ext_vector_type(2)));
struct EpiSwiGLU {
    static constexpr bool PERM = true, AFTER_DRAIN = false;
    unsigned char* O; int ldc; const float* rstd; PG8_LAS float* rsl; float ascale, oscale;
    __device__ __forceinline__ void operator()(const f32x4 (&acc)[2][2][4][2], const Unit& u, int wr, int wc, int fr, int fq) const {
        const int row0 = u.pm * BM + wr * 64 + fr, col0 = u.pn * HALF + wc * 32 + 8 * fq;
        const PG8_LAS float* sc = rsl + u.ui * 256 + wr * 64;
#pragma unroll
        for (int ai = 0; ai < 2; ++ai)
#pragma unroll
            for (int m = 0; m < 4; ++m) { const int r = row0 + ai * HALF + m * 16; const float s = sc[ai * HALF + m * 16 + fr] * ascale; unsigned char* rowp = O + (size_t)r * ldc + col0;
                const float sn = -1.4426950408889634f * s, ikk = __builtin_amdgcn_rcpf(s * s * oscale);
                const f32x2 sn2 = {sn, sn}, ik2 = {ikk, ikk};
                u32x2_t w;
#pragma unroll
                for (int n = 0; n < 2; ++n) { const f32x4 g4 = acc[ai][0][m][n], u4 = acc[ai][1][m][n];
                    const f32x2 g01 = {g4[0], g4[1]}, g23 = {g4[2], g4[3]}, u01 = {u4[0], u4[1]}, u23 = {u4[2], u4[3]};
                    const f32x2 t01 = g01 * sn2, t23 = g23 * sn2;
                    f32x2 e01, e23; e01.x = __builtin_amdgcn_exp2f(t01.x); e01.y = __builtin_amdgcn_exp2f(t01.y); e23.x = __builtin_amdgcn_exp2f(t23.x); e23.y = __builtin_amdgcn_exp2f(t23.y);
                    const f32x2 d01 = __builtin_elementwise_fma(e01, ik2, ik2), d23 = __builtin_elementwise_fma(e23, ik2, ik2);
                    f32x2 r01, r23; r01.x = __builtin_amdgcn_rcpf(d01.x); r01.y = __builtin_amdgcn_rcpf(d01.y); r23.x = __builtin_amdgcn_rcpf(d23.x); r23.y = __builtin_amdgcn_rcpf(d23.y);
                    const f32x2 a01 = (g01 * u01) * r01, a23 = (g23 * u23) * r23;
                    const unsigned q = pk4_fp8(a01.x, a01.y, a23.x, a23.y); if (n == 0) w.x = q; else w.y = q; }
                st8_wt(rowp, w); }
    }
};

template <class Epi, class Sched, bool ALIGN_EPI = false, bool SP2 = false, bool F8 = false>
__device__ __forceinline__ void gemm_phase(PG8_LAS unsigned char* lds, const Gemm g, const Sched& S, const Epi& E) {
    const int tid = threadIdx.x, wid = __builtin_amdgcn_readfirstlane(tid >> 6), lane = tid & 63, wr = wid >> 2, wc = wid & 3, fr = lane & 15, fq = lane >> 4;
    const int KB = F8 ? g.K : 2 * g.K, nt = KB / (BK * 2);
    unsigned voffA[2], voffB[2];
#pragma unroll
    for (int i = 0; i < 2; ++i) { int R, C; stage_rc(tid * 16 + i * 8192, R, C); const int Rb = Epi::PERM ? ((R & ~31) + perm32(R & 31)) : R;
        voffA[i] = (unsigned)(R * KB + C * 2); voffB[i] = (unsigned)(Rb * KB + C * 2); }
    const size_t kstep = (size_t)(BK * 2);
    const size_t hstep = (size_t)HALF * KB;
    const size_t tstep = 2 * hstep;
    const unsigned ldsw = (unsigned)wid * 1024u;
    int aoffk[2], boffk[2];
#pragma unroll
    for (int k = 0; k < 2; ++k) { const int c = F8 ? 16 * fq + 8 * k : fq * 8 + 32 * k; aoffk[k] = lds_byte(wr * 64 + fr, c); boffk[k] = lds_byte(wc * 32 + fr, c); }
#define PG8_SA(b, h) (((b) * 2 + (h)) * HTB)
#define PG8_SB(b, h) ((4 + (b) * 2 + (h)) * HTB)
#define PG8_STAGE(bufoff, gbase, voff) do { _Pragma("unroll") for (int _i = 0; _i < 2; ++_i) \
        __builtin_amdgcn_global_load_lds((const unsigned*)((const char*)(gbase) + (voff)[_i]), (PG8_LAS unsigned*)(lds + (bufoff) + ldsw + _i * 8192), 16, 0, 0); } while (0)
#define PG8_LDA(dst, b, h) do { _Pragma("unroll") for (int m = 0; m < 4; ++m) _Pragma("unroll") for (int k = 0; k < 2; ++k) dst[m][k] = *(const PG8_LAS bf16x8*)(lds + PG8_SA(b, h) + aoffk[k] + m * 2048); } while (0)
#define PG8_LDA8(dst, b, h) do { _Pragma("unroll") for (int m = 0; m < 4; ++m) { const i32x4_t lo_ = *(const PG8_LAS i32x4_t*)(lds + PG8_SA(b, h) + aoffk[0] + m * 2048), hi_ = *(const PG8_LAS i32x4_t*)(lds + PG8_SA(b, h) + aoffk[1] + m * 2048); dst[m] = __builtin_shufflevector(lo_, hi_, 0, 1, 2, 3, 4, 5, 6, 7); } } while (0)
#define PG8_LDB(dst, b, h) do { _Pragma("unroll") for (int n = 0; n < 2; ++n) _Pragma("unroll") for (int k = 0; k < 2; ++k) dst[n][k] = *(const PG8_LAS bf16x8*)(lds + PG8_SB(b, h) + boffk[k] + n * 2048); } while (0)
#define PG8_LDB8(dst, b, h) do { _Pragma("unroll") for (int n = 0; n < 2; ++n) { const i32x4_t lo_ = *(const PG8_LAS i32x4_t*)(lds + PG8_SB(b, h) + boffk[0] + n * 2048), hi_ = *(const PG8_LAS i32x4_t*)(lds + PG8_SB(b, h) + boffk[1] + n * 2048); dst[n] = __builtin_shufflevector(lo_, hi_, 0, 1, 2, 3, 4, 5, 6, 7); } } while (0)
#define PG8_MMA(ai, bj, At, Bt) do { __builtin_amdgcn_s_setprio(1); _Pragma("unroll") for (int m = 0; m < 4; ++m) _Pragma("unroll") for (int n = 0; n < 2; ++n) _Pragma("unroll") for (int k = 0; k < 2; ++k) \
        acc[ai][bj][m][n] = __builtin_amdgcn_mfma_f32_16x16x32_bf16(Bt[n][k], At[m][k], acc[ai][bj][m][n], 0, 0, 0); __builtin_amdgcn_s_setprio(0); } while (0)
#define PG8_MMA8(ai, bj, At, Bt) do { __builtin_amdgcn_sched_barrier(0); __builtin_amdgcn_s_setprio(1); _Pragma("unroll") for (int m = 0; m < 4; ++m) _Pragma("unroll") for (int n = 0; n < 2; ++n) \
        acc[ai][bj][m][n] = __builtin_amdgcn_mfma_scale_f32_16x16x128_f8f6f4(Bt[n], At[m], acc[ai][bj][m][n], 0, 0, 0, 0x7f7f7f7f, 0, 0x7f7f7f7f); __builtin_amdgcn_s_setprio(0); \
        asm volatile("" : "+v"(acc[ai][bj][0][0]), "+v"(acc[ai][bj][0][1]), "+v"(acc[ai][bj][1][0]), "+v"(acc[ai][bj][1][1]), "+v"(acc[ai][bj][2][0]), "+v"(acc[ai][bj][2][1]), "+v"(acc[ai][bj][3][0]), "+v"(acc[ai][bj][3][1])); \
        __builtin_amdgcn_sched_barrier(0); } while (0)
#define PG8_LDAx(b, h) do { if constexpr (F8) PG8_LDA8(At8, b, h); else PG8_LDA(At, b, h); } while (0)
#define PG8_LDBx(w, b, h) do { if constexpr (F8) { if ((w) == 0) PG8_LDB8(B08, b, h); else PG8_LDB8(B18, b, h); } else { if ((w) == 0) PG8_LDB(B0, b, h); else PG8_LDB(B1, b, h); } } while (0)
#define PG8_MMAx(ai, bj, w) do { if constexpr (F8) { if ((w) == 0) PG8_MMA8(ai, bj, At8, B08); else PG8_MMA8(ai, bj, At8, B18); } else { if ((w) == 0) PG8_MMA(ai, bj, At, B0); else PG8_MMA(ai, bj, At, B1); } } while (0)
#define PG8_WAIT_V(n) asm volatile("s_waitcnt vmcnt(" #n ")" ::: "memory")
#define PG8_WAIT_L(n) asm volatile("s_waitcnt lgkmcnt(" #n ")" ::: "memory")
#define PG8_BAR __builtin_amdgcn_s_barrier()
#define PG8_SCHED __builtin_amdgcn_sched_barrier(0)
    Unit cur, nxt; int ui = 0;
    if (!S.next(0, cur)) return;
    f32x4 acc[2][2][4][2];
#pragma unroll
    for (int a = 0; a < 2; ++a)
#pragma unroll
        for (int b = 0; b < 2; ++b)
#pragma unroll
            for (int m = 0; m < 4; ++m)
#pragma unroll
                for (int n = 0; n < 2; ++n) acc[a][b][m][n] = (f32x4){0.f, 0.f, 0.f, 0.f};
    bf16x8 At[4][2], B0[2][2], B1[2][2]; i32x8_t At8[4], B08[2], B18[2];
    const char* cA = (const char*)g.A + (size_t)cur.pm * tstep; const char* cB = (const char*)g.Bt + (size_t)cur.pn * tstep;
    S.a_ready(cur);
    if constexpr (SP2) {
        PG8_STAGE(PG8_SB(0, 0), cB, voffB); PG8_STAGE(PG8_SB(0, 1), cB + hstep, voffB); PG8_STAGE(PG8_SA(0, 0), cA, voffA); PG8_STAGE(PG8_SA(0, 1), cA + hstep, voffA);
        if (wr == 1) PG8_BAR;
        PG8_WAIT_V(2); PG8_BAR;
        PG8_STAGE(PG8_SB(1, 0), cB + kstep, voffB); PG8_STAGE(PG8_SA(1, 0), cA + kstep, voffA); PG8_STAGE(PG8_SB(1, 1), cB + hstep + kstep, voffB);
        PG8_WAIT_V(6); PG8_BAR;
    } else {
        PG8_STAGE(PG8_SB(0, 0), cB, voffB); PG8_STAGE(PG8_SA(0, 0), cA, voffA); PG8_STAGE(PG8_SB(0, 1), cB + hstep, voffB); PG8_STAGE(PG8_SA(0, 1), cA + hstep, voffA);
        if (wr == 1) PG8_BAR;
        PG8_WAIT_V(4); PG8_BAR;
        PG8_STAGE(PG8_SB(1, 0), cB + kstep, voffB); PG8_STAGE(PG8_SA(1, 0), cA + kstep, voffA); PG8_STAGE(PG8_SB(1, 1), cB + hstep + kstep, voffB);
        PG8_WAIT_V(6); PG8_BAR;
    }
    for (;;) {
        const bool has_next = S.next(ui + 1, nxt);
        const char* nA = has_next ? (const char*)g.A + (size_t)nxt.pm * tstep : cA; const char* nB = has_next ? (const char*)g.Bt + (size_t)nxt.pn * tstep : cB;
        for (int t = 0; t < nt; t += 2) {
            const bool last = (t == nt - 2);
            const char* a1 = cA + (size_t)(t + 1) * kstep;
            const char* a2 = last ? nA : cA + (size_t)(t + 2) * kstep; const char* b2 = last ? nB : cB + (size_t)(t + 2) * kstep;
            const char* a3 = a2 + kstep; const char* b3 = b2 + kstep;
            if (last && has_next) S.a_ready(nxt);
            if constexpr (SP2) {
            PG8_LDBx(0, 0, 0); PG8_LDBx(1, 0, 1); PG8_SCHED; PG8_LDAx(0, 0); PG8_STAGE(PG8_SA(1, 1), a1 + hstep, voffA);
            PG8_WAIT_V(8); PG8_WAIT_L(0); PG8_BAR; PG8_MMAx(0, 0, 0); PG8_MMAx(0, 1, 1); PG8_BAR; PG8_SCHED;
            PG8_LDAx(0, 1); PG8_STAGE(PG8_SB(0, 0), b2, voffB); PG8_STAGE(PG8_SB(0, 1), b2 + hstep, voffB); PG8_STAGE(PG8_SA(0, 0), a2, voffA);
            PG8_WAIT_V(8); PG8_WAIT_L(0); PG8_BAR; PG8_MMAx(1, 0, 0); PG8_MMAx(1, 1, 1); PG8_BAR; PG8_SCHED;
            PG8_LDBx(0, 1, 0); PG8_LDBx(1, 1, 1); PG8_SCHED; PG8_LDAx(1, 0); PG8_STAGE(PG8_SA(0, 1), a2 + hstep, voffA);
            PG8_WAIT_V(8); PG8_WAIT_L(0); PG8_BAR; PG8_MMAx(0, 0, 0); PG8_MMAx(0, 1, 1); PG8_BAR; PG8_SCHED;
            PG8_LDAx(1, 1); PG8_STAGE(PG8_SB(1, 0), b3, voffB); PG8_STAGE(PG8_SB(1, 1), b3 + hstep, voffB); PG8_STAGE(PG8_SA(1, 0), a3, voffA);
            PG8_WAIT_V(8); PG8_WAIT_L(0); PG8_BAR; PG8_MMAx(1, 0, 0); PG8_MMAx(1, 1, 1); PG8_BAR; PG8_SCHED;
            } else {
            PG8_LDBx(0, 0, 0); PG8_SCHED; PG8_LDAx(0, 0); PG8_STAGE(PG8_SA(1, 1), a1 + hstep, voffA);
            PG8_WAIT_L(8); PG8_BAR; PG8_WAIT_L(0); PG8_MMAx(0, 0, 0); PG8_BAR; PG8_SCHED;
            PG8_LDBx(1, 0, 1); PG8_STAGE(PG8_SB(0, 0), b2, voffB);
            PG8_BAR; PG8_WAIT_L(0); PG8_MMAx(0, 1, 1); PG8_BAR;
            PG8_LDAx(0, 1); PG8_STAGE(PG8_SA(0, 0), a2, voffA);
            PG8_BAR; PG8_WAIT_L(0); PG8_MMAx(1, 0, 0); PG8_BAR; PG8_SCHED;
            PG8_STAGE(PG8_SB(0, 1), b2 + hstep, voffB);
            PG8_WAIT_V(6); PG8_BAR; PG8_MMAx(1, 1, 1); PG8_BAR;
            PG8_LDBx(0, 1, 0); PG8_SCHED; PG8_LDAx(1, 0); PG8_STAGE(PG8_SA(0, 1), a2 + hstep, voffA);
            PG8_WAIT_L(8); PG8_BAR; PG8_WAIT_L(0); PG8_MMAx(0, 0, 0); PG8_BAR; PG8_SCHED;
            PG8_LDBx(1, 1, 1); PG8_STAGE(PG8_SB(1, 0), b3, voffB);
            PG8_BAR; PG8_WAIT_L(0); PG8_MMAx(0, 1, 1); PG8_BAR;
            PG8_LDAx(1, 1); PG8_STAGE(PG8_SA(1, 0), a3, voffA);
            PG8_BAR; PG8_WAIT_L(0); PG8_MMAx(1, 0, 0); PG8_BAR; PG8_SCHED;
            PG8_STAGE(PG8_SB(1, 1), b3 + hstep, voffB);
            PG8_WAIT_V(6); PG8_BAR; PG8_MMAx(1, 1, 1); PG8_BAR;
            }
        }
        if constexpr (ALIGN_EPI) { if (wr == 0) PG8_BAR; }
        if constexpr (!Epi::AFTER_DRAIN) { E(acc, cur, wr, wc, fr, fq); S.done(cur); }
        if (!has_next) break;
#pragma unroll
        for (int a = 0; a < 2; ++a)
#pragma unroll
            for (int b = 0; b < 2; ++b)
#pragma unroll
                for (int m = 0; m < 4; ++m)
#pragma unroll
                    for (int n = 0; n < 2; ++n) acc[a][b][m][n] = (f32x4){0.f, 0.f, 0.f, 0.f};
        cur = nxt; cA = nA; cB = nB; ++ui;
        if constexpr (ALIGN_EPI) { if (wr == 1) PG8_BAR; }
    }
    PG8_WAIT_V(0);
    if constexpr (!ALIGN_EPI) { if (wr == 0) PG8_BAR; }
    PG8_BAR;
    if constexpr (Epi::AFTER_DRAIN) { E.fused(acc, cur, wr, wc, fr, fq, lds, wid, lane); S.done(cur); }
#undef PG8_SA
#undef PG8_SB
#undef PG8_STAGE
#undef PG8_LDA
#undef PG8_LDB
#undef PG8_MMA
#undef PG8_MMA8
#undef PG8_LDAx
#undef PG8_LDBx
#undef PG8_MMAx
#undef PG8_LDA8
#undef PG8_LDB8
#undef PG8_WAIT_V
#undef PG8_WAIT_L
#undef PG8_BAR
#undef PG8_SCHED
}
}
namespace att {
#define ATT_LAS __attribute__((address_space(3)))
typedef short bf16x8 __attribute__((ext_vector_type(8)));
typedef short s16x4 __attribute__((ext_vector_type(4)));
typedef float f32x16 __attribute__((ext_vector_type(16)));
typedef float f32x4 __attribute__((ext_vector_type(4)));
typedef unsigned u32x4 __attribute__((ext_vector_type(4)));
typedef unsigned short bf16;
enum { T_A = 0, T_B = 1, T_C = 2, T_D = 3 };
constexpr int S = 4096, QP = 2816;
constexpr int SLOTB = 8192;
constexpr int NSLOT = 4;
constexpr int L_K = 0, L_V = NSLOT * SLOTB, L_KB = 2 * NSLOT * SLOTB, L_WS = L_KB + NSLOT * 256 + 256, L_TAB = L_WS + 2048, TAB_N = 5600, L_KM = L_TAB + TAB_N * 4, L_OST = L_KM + 4096, L_END = L_OST + 8 * 4096;
static_assert(L_TAB % 16 == 0 && L_KM % 16 == 0 && L_OST % 16 == 0 && L_END <= 131072, "attention LDS map");
constexpr float THR = 8.0f;
__device__ __forceinline__ constexpr int offr(int r) { return (r & 3) + 8 * (r >> 2); }
__device__ __forceinline__ unsigned cvtpk(float lo, float hi) { typedef float f2 __attribute__((ext_vector_type(2))); typedef __bf16 b2 __attribute__((ext_vector_type(2))); f2 v = {lo, hi}; b2 b = __builtin_convertvector(v, b2); return __builtin_bit_cast(unsigned, b); }
__device__ __forceinline__ s16x4 vtr(const ATT_LAS char* p) { typedef short v4i16_t __attribute__((ext_vector_type(4))); return __builtin_bit_cast(s16x4, __builtin_amdgcn_ds_read_tr16_b64_v4i16((ATT_LAS v4i16_t*)p)); }
__device__ __forceinline__ float xhalf_max(float v) { auto rr = __builtin_amdgcn_permlane32_swap(__float_as_uint(v), __float_as_uint(v), false, false); return fmaxf(__uint_as_float(rr[0]), __uint_as_float(rr[1])); }
__device__ __forceinline__ float xhalf_sum(float v) { auto rr = __builtin_amdgcn_permlane32_swap(__float_as_uint(v), __float_as_uint(v), false, false); return __uint_as_float(rr[0]) + __uint_as_float(rr[1]); }

__device__ __forceinline__ void glds16(const void* gsrc, unsigned lds_dst) { unsigned keep;
    asm volatile("s_mov_b32 %0, m0\n\ts_mov_b32 m0, %2\n\ts_nop 0\n\tglobal_load_lds_dwordx4 %1, off\n\ts_mov_b32 m0, %0" : "=&s"(keep) : "v"(gsrc), "s"(lds_dst) : "memory"); }
__device__ __forceinline__ void glds4(const void* gsrc, unsigned lds_dst) { unsigned keep;
    asm volatile("s_mov_b32 %0, m0\n\ts_mov_b32 m0, %2\n\ts_nop 0\n\tglobal_load_lds_dword %1, off\n\ts_mov_b32 m0, %0" : "=&s"(keep) : "v"(gsrc), "s"(lds_dst) : "memory"); }

template <int TYPE>
__device__ __forceinline__ void attn_item(ATT_LAS unsigned char* lds, const bf16* qkv, int b, int h, int qb, int res, int dil_rt, int W_rt, int qcol_rt, int kcol_rt, int vcol_rt, const float* tabg, int tab_id, int& cur_tab, const float* c2bh, const unsigned* nrm, const float* kmbh, float sink2,
                                          bf16* outp, int ldo, float* lse_out) {
    const int tid = threadIdx.x, lane = tid & 63, r32 = lane & 31, hi = lane >> 5; const int wid = __builtin_amdgcn_readfirstlane(tid >> 6);
    constexpr bool BAND = (TYPE == T_A);
    const int W = W_rt; const int DIL = BAND ? dil_rt : 1;
    const int qcol = BAND ? qcol_rt : (TYPE == T_B ? 768 : 2048) + 64 * h;
    const int kcol = BAND ? kcol_rt : (TYPE == T_B ? 1024 : 2304) + 64 * h;
    const int vcol = BAND ? vcol_rt : (TYPE == T_B ? 1280 : 2560) + 64 * h;
    const size_t rowbase = (size_t)b * S + res;
    const int qf0 = 256 * qb, qfw = qf0 + 32 * wid;
    const int kf0 = BAND ? qf0 - 128 : 0, NT = BAND ? 6 : 4 * (qb + 1);
    int tlo = (BAND && qb == 0) ? 2 : 0;
    if (TYPE == T_D) {
        const float qm = __uint_as_float(nrm[0]) + __uint_as_float(nrm[1]), kmx = __uint_as_float(nrm[2]) + __uint_as_float(nrm[3]);
        const float bound = 2.0f * sqrtf(qm * kmx) * 1.01f + 42.0f;
        const float c0 = c2bh[qf0];
        const bool skip = (lane < 4 * qb) && (c0 - c2bh[64 * (lane < 4 * qb ? lane : 0) + 63] < -bound);
        tlo = __builtin_popcountll(__ballot(skip));
    }
    ATT_LAS float* tab = (ATT_LAS float*)(lds + L_TAB);
    ATT_LAS float* km = (ATT_LAS float*)(lds + L_KM);
    ATT_LAS float* wsf = (ATT_LAS float*)(lds + L_WS) + wid * 64;
    const unsigned lds0 = (unsigned)(uintptr_t)lds;
#define ATT_ISSUE(t) do { const int k0_ = kf0 + 64 * (t); const int sl_ = ((t) - tlo) % NSLOT; int kk_ = k0_ + lane; kk_ = kk_ < 0 ? 0 : kk_; \
        glds16(qkv + (rowbase + (size_t)kk_ * DIL) * QP + kcol + wid * 8, (unsigned)__builtin_amdgcn_readfirstlane(lds0 + L_K + sl_ * SLOTB + wid * 1024)); \
        int kv_ = k0_ + 16 * (wid & 3) + (lane >> 2); kv_ = kv_ < 0 ? 0 : kv_; \
        glds16(qkv + (rowbase + (size_t)kv_ * DIL) * QP + vcol + (wid >> 2) * 32 + (lane & 3) * 8, (unsigned)__builtin_amdgcn_readfirstlane(lds0 + L_V + sl_ * SLOTB + wid * 1024)); \
        if (TYPE == T_D) glds4(c2bh + k0_ + lane, (unsigned)__builtin_amdgcn_readfirstlane(lds0 + L_KB + sl_ * 256)); } while (0)
    if (TYPE != T_D) { if (tab_id != cur_tab) { cur_tab = tab_id;
            for (int i = tid; i < TAB_N; i += 512) tab[i] = (i < 4096) ? tabg[4095 - i] : 0.f; } }
    if (TYPE == T_B) { for (int i = tid; i < 16 * 64; i += 512) km[i] = kmbh[i]; }
    bf16x8 qr[4];
    { const bf16* qrow = qkv + (rowbase + (size_t)(qfw + r32) * DIL) * QP + qcol;
#pragma unroll
      for (int d0 = 0; d0 < 4; ++d0) qr[d0] = *(const bf16x8*)(qrow + 16 * d0 + 8 * hi); }
    const float cq = (TYPE == T_D) ? c2bh[qfw + r32] : 0.f;
    ATT_ISSUE(tlo); if (tlo + 1 < NT) ATT_ISSUE(tlo + 1); if (tlo + 2 < NT) ATT_ISSUE(tlo + 2);
    asm volatile("s_waitcnt vmcnt(0)" ::: "memory");
    __syncthreads();
    unsigned sel = 0u;
    if (TYPE == T_B) {
        float g[16];
#pragma unroll
        for (int n = 0; n < 16; ++n) { g[n] = -INFINITY; if (n < qb) { float s = 0.f;
#pragma unroll
                for (int d0 = 0; d0 < 4; ++d0) { const f32x4 a = *(const ATT_LAS f32x4*)(km + n * 64 + 16 * d0 + 8 * hi), c = *(const ATT_LAS f32x4*)(km + n * 64 + 16 * d0 + 8 * hi + 4);
                    const bf16x8 qv = qr[d0];
                    s = fmaf(__builtin_bit_cast(float, (unsigned)(unsigned short)qv[0] << 16), a[0], s); s = fmaf(__builtin_bit_cast(float, (unsigned)(unsigned short)qv[1] << 16), a[1], s);
                    s = fmaf(__builtin_bit_cast(float, (unsigned)(unsigned short)qv[2] << 16), a[2], s); s = fmaf(__builtin_bit_cast(float, (unsigned)(unsigned short)qv[3] << 16), a[3], s);
                    s = fmaf(__builtin_bit_cast(float, (unsigned)(unsigned short)qv[4] << 16), c[0], s); s = fmaf(__builtin_bit_cast(float, (unsigned)(unsigned short)qv[5] << 16), c[1], s);
                    s = fmaf(__builtin_bit_cast(float, (unsigned)(unsigned short)qv[6] << 16), c[2], s); s = fmaf(__builtin_bit_cast(float, (unsigned)(unsigned short)qv[7] << 16), c[3], s); }
                g[n] = xhalf_sum(s); } }
#pragma unroll
        for (int r = 0; r < 3; ++r) { float best = -INFINITY; int bi = -1;
#pragma unroll
            for (int n = 0; n < 16; ++n) if (n < qb && !((sel >> n) & 1u) && g[n] > best) { best = g[n]; bi = n; }
            if (bi >= 0) sel |= 1u << bi; }
    }
    float m = 0.f, l = 0.f; f32x16 o[2]; o[0] = f32x16{}; o[1] = f32x16{};
    const int vpo = ((lane >> 4) & 1) * 32 + (lane & 3) * 8 + (4 * hi + ((lane & 15) >> 2)) * 64;
    f32x16 p0 = f32x16{}, p1 = f32x16{}; u32x4 pw[4] = {u32x4{}, u32x4{}, u32x4{}, u32x4{}};
    const int hb = wid >> 2;
#define ATT_BAR(N) asm volatile("s_waitcnt vmcnt(" #N ") lgkmcnt(0)\n\ts_barrier" ::: "memory")
#define ATT_ACTIVE(T, ACT, PICK) do { const int k0_ = kf0 + 64 * (T); PICK = true; \
        if (BAND) ACT = (k0_ <= qfw + 31) && (k0_ + 63 >= qfw - W); \
        else if (TYPE == T_B) { const bool past_ = k0_ < qf0; PICK = past_ ? ((sel >> (k0_ >> 8)) & 1u) : true; ACT = past_ ? (__ballot(PICK) != 0ull) : (k0_ <= qfw + 31); } \
        else ACT = (k0_ <= qfw + 31); } while (0)
#define ATT_LDK(T, KF) do { const int sl_ = ((T) - tlo) % NSLOT; const ATT_LAS char* kb_ = (const ATT_LAS char*)(lds + L_K + sl_ * SLOTB) + hi * 1024 + r32 * 16; \
        _Pragma("unroll") for (int d0 = 0; d0 < 4; ++d0) { KF[2 * d0] = *(const ATT_LAS bf16x8*)(kb_ + d0 * 2048); KF[2 * d0 + 1] = *(const ATT_LAS bf16x8*)(kb_ + d0 * 2048 + 512); } } while (0)
#define ATT_LDV(T, D0, VF) do { const int sl_ = ((T) - tlo) % NSLOT; const ATT_LAS char* vp = (const ATT_LAS char*)(lds + L_V + sl_ * SLOTB) + vpo; \
        _Pragma("unroll") for (int ks = 0; ks < 4; ++ks) { const s16x4 lo = vtr(vp + (D0) * 4096 + ks * 1024), hh = vtr(vp + (D0) * 4096 + ks * 1024 + 512); \
            VF[ks] = (bf16x8){lo[0], lo[1], lo[2], lo[3], hh[0], hh[1], hh[2], hh[3]}; } } while (0)
#define ATT_QK(KF, P0, P1, PICK) do { \
        f32x16 ci_; { const float c_ = (TYPE == T_B && !(PICK)) ? -INFINITY : cq - m; _Pragma("unroll") for (int r = 0; r < 16; ++r) ci_[r] = c_; } \
        _Pragma("unroll") for (int d0 = 0; d0 < 4; ++d0) { \
            if (d0 == 0) { P0 = __builtin_amdgcn_mfma_f32_32x32x16_bf16(KF[0], qr[0], ci_, 0, 0, 0); P1 = __builtin_amdgcn_mfma_f32_32x32x16_bf16(KF[1], qr[0], ci_, 0, 0, 0); } \
            else { P0 = __builtin_amdgcn_mfma_f32_32x32x16_bf16(KF[2 * d0], qr[d0], P0, 0, 0, 0); P1 = __builtin_amdgcn_mfma_f32_32x32x16_bf16(KF[2 * d0 + 1], qr[d0], P1, 0, 0, 0); } } } while (0)
#define ATT_MOD(T, P0, P1) do { const int sl_ = ((T) - tlo) % NSLOT; const int k0 = kf0 + 64 * (T); \
        const int d0l = qfw + r32 - k0 - 4 * hi; \
        if (TYPE != T_D) { \
            if (TYPE == T_B && qfw - k0 - 63 >= 1513) { const float bfar = tab[0]; \
                _Pragma("unroll") for (int r = 0; r < 16; ++r) { P0[r] += bfar; P1[r] += bfar; } \
            } else { const ATT_LAS float* tb = tab + (4095 - DIL * d0l); \
                _Pragma("unroll") for (int r = 0; r < 16; ++r) { P0[r] += tb[DIL * offr(r)]; P1[r] += tb[DIL * (offr(r) + 32)]; } } \
        } else { const ATT_LAS float* cb = (const ATT_LAS float*)(lds + L_KB + sl_ * 256) + 4 * hi; \
            _Pragma("unroll") for (int i = 0; i < 4; ++i) { const f32x4 c0 = *(const ATT_LAS f32x4*)(cb + 8 * i), c1 = *(const ATT_LAS f32x4*)(cb + 8 * i + 32); \
                _Pragma("unroll") for (int j = 0; j < 4; ++j) { P0[4 * i + j] -= c0[j]; P1[4 * i + j] -= c1[j]; } } } \
        if (k0 + 63 > qfw) { _Pragma("unroll") for (int r = 0; r < 16; ++r) { if (d0l - offr(r) < 0) P0[r] = -INFINITY; if (d0l - offr(r) - 32 < 0) P1[r] = -INFINITY; } } \
        if (BAND) { if (qfw + 31 - k0 > W) { _Pragma("unroll") for (int r = 0; r < 16; ++r) { if (d0l - offr(r) > W) P0[r] = -INFINITY; if (d0l - offr(r) - 32 > W) P1[r] = -INFINITY; } } } \
        float rm = fmaxf(P0[0], P1[0]), rm2 = fmaxf(P0[1], P1[1]); \
        _Pragma("unroll") for (int r = 2; r < 16; r += 2) { rm = fmaxf(fmaxf(rm, P0[r]), P1[r]); rm2 = fmaxf(fmaxf(rm2, P0[r + 1]), P1[r + 1]); } \
        rm = xhalf_max(fmaxf(rm, rm2)); \
        if (__ballot(rm > THR) != 0ull) { const float dl = fmaxf(rm, 0.f); m += dl; \
            _Pragma("unroll") for (int r = 0; r < 16; ++r) { P0[r] -= dl; P1[r] -= dl; } \
            const float f = EX2(-dl); l *= f; \
            if (hi == 0) wsf[r32] = f; \
            asm volatile("s_waitcnt lgkmcnt(0)" ::: "memory"); \
            _Pragma("unroll") for (int i = 0; i < 4; ++i) { const f32x4 fr = *(const ATT_LAS f32x4*)(wsf + 8 * i + 4 * hi); \
                _Pragma("unroll") for (int j = 0; j < 4; ++j) { o[0][4 * i + j] *= fr[j]; o[1][4 * i + j] *= fr[j]; } } } } while (0)
#define ATT_EXP(P0, P1, PW) do { float sacc = 0.f; \
        _Pragma("unroll") for (int r = 0; r < 16; ++r) { P0[r] = EX2(P0[r]); P1[r] = EX2(P1[r]); sacc += P0[r] + P1[r]; } \
        l += sacc; \
        _Pragma("unroll") for (int i = 0; i < 4; ++i) { PW[0][i] = cvtpk(P0[2 * i], P0[2 * i + 1]); PW[1][i] = cvtpk(P0[8 + 2 * i], P0[9 + 2 * i]); PW[2][i] = cvtpk(P1[2 * i], P1[2 * i + 1]); PW[3][i] = cvtpk(P1[8 + 2 * i], P1[9 + 2 * i]); } } while (0)
#define ATT_PV(D0, VF, PW) do { \
        _Pragma("unroll") for (int ks = 0; ks < 4; ++ks) o[D0] = __builtin_amdgcn_mfma_f32_32x32x16_bf16(__builtin_bit_cast(bf16x8, PW[ks]), VF[ks], o[D0], 0, 0, 0); } while (0)
    bool actC, pick0; ATT_ACTIVE(tlo, actC, pick0);
    if (actC) { bf16x8 kf0_[8]; ATT_LDK(tlo, kf0_); ATT_QK(kf0_, p0, p1, pick0); ATT_MOD(tlo, p0, p1); if (hb == 1) ATT_EXP(p0, p1, pw); }
    for (int t = tlo; t < NT; ++t) {
        const bool more1 = t + 1 < NT, more3 = t + 3 < NT;
        if (more3) ATT_ISSUE(t + 3);
        bool actN = false, pickN = true; if (more1) ATT_ACTIVE(t + 1, actN, pickN);
        bf16x8 kf[8], vf[4], vg[4];
        if (actC) ATT_LDV(t, 0, vf);
        __builtin_amdgcn_sched_barrier(0);
        if (hb == 0) { if (actC) ATT_EXP(p0, p1, pw); }
        if (actN) { ATT_LDK(t + 1, kf); ATT_QK(kf, p0, p1, pickN); }
        if (actC) { ATT_LDV(t, 1, vg); __builtin_amdgcn_sched_barrier(0); ATT_PV(0, vf, pw); ATT_PV(1, vg, pw); }
        if (actN) { ATT_MOD(t + 1, p0, p1); if (hb == 1) ATT_EXP(p0, p1, pw); }
        if (more3) { if (TYPE == T_D) ATT_BAR(3); else ATT_BAR(2); }
        else ATT_BAR(0);
        actC = actN;
    }
#undef ATT_BAR
#undef ATT_ACTIVE
#undef ATT_QK
#undef ATT_LDK
#undef ATT_LDV
#undef ATT_MOD
#undef ATT_EXP
#undef ATT_PV
    l = xhalf_sum(l);
    if (BAND) l += EX2(sink2 - m);
    if (hi == 0) wsf[32 + r32] = 1.0f / l;
    asm volatile("s_waitcnt lgkmcnt(0)" ::: "memory");
    {   ATT_LAS bf16* stg = (ATT_LAS bf16*)(lds + L_OST) + wid * 2048;
#pragma unroll
        for (int i = 0; i < 4; ++i) { const f32x4 rl = *(const ATT_LAS f32x4*)(wsf + 32 + 8 * i + 4 * hi);
#pragma unroll
            for (int j = 0; j < 4; ++j) { const int orow = 8 * i + 4 * hi + j;
#pragma unroll
                for (int d0 = 0; d0 < 2; ++d0) { const unsigned w = cvtpk(o[d0][4 * i + j] * rl[j], 0.f); stg[orow * 64 + d0 * 32 + r32] = (bf16)(w & 0xffffu); } } }
        asm volatile("s_waitcnt lgkmcnt(0)" ::: "memory");
#pragma unroll
        for (int i = 0; i < 4; ++i) { const int row = i * 8 + (lane >> 3), ch = lane & 7; const u32x4 v = *(const ATT_LAS u32x4*)(stg + row * 64 + ch * 8);
            *(u32x4*)(outp + (rowbase + (size_t)(qfw + row) * DIL) * ldo + ch * 8) = v; }
    }
    if (BAND) { if (lse_out != nullptr && hi == 0) lse_out[(rowbase + (size_t)(qfw + r32) * DIL) * 4] = m + __builtin_amdgcn_logf(l); }
    __syncthreads();
#undef ATT_ISSUE
}
}

namespace att2 {
#define A2_LAS __attribute__((address_space(3)))
typedef att::bf16x8 bf16x8; typedef att::s16x4 s16x4; typedef att::f32x16 f32x16; typedef att::f32x4 f32x4; typedef att::u32x4 u32x4; typedef unsigned short bf16;
enum { T_B = 1, T_D = 3 };
constexpr int S = 4096, QP = 2816, NW = 8, QBLK = 32, QB = 256, KVBLK = 64;
constexpr int NSLOT = 3, SLOTB = 8192;
constexpr int L_K = 0, L_V = NSLOT * SLOTB, L_WS = 2 * NSLOT * SLOTB, L_OST = L_WS + NW * 64 * 4, L_TAB = L_OST + NW * 4096, TAB_N = 5600, TAB_PADN = 96, L_KM = L_TAB + (TAB_N + TAB_PADN) * 4, L_END = L_KM + 4096;
static_assert(L_TAB % 16 == 0 && L_KM % 16 == 0 && L_END <= 131072, "attention engine 2 LDS map");
constexpr float THR = 8.0f;
typedef A2_LAS const char* lds_cptr;
#define A2_MX3(a, b, c) __builtin_fmaxf(__builtin_fmaxf((a), (b)), (c))
__device__ __forceinline__ void kload8(bf16x8* kf, lds_cptr kp) {
    kf[0] = *(const A2_LAS bf16x8*)(kp);        kf[1] = *(const A2_LAS bf16x8*)(kp + 512);  kf[2] = *(const A2_LAS bf16x8*)(kp + 2048); kf[3] = *(const A2_LAS bf16x8*)(kp + 2560);
    kf[4] = *(const A2_LAS bf16x8*)(kp + 4096); kf[5] = *(const A2_LAS bf16x8*)(kp + 4608); kf[6] = *(const A2_LAS bf16x8*)(kp + 6144); kf[7] = *(const A2_LAS bf16x8*)(kp + 6656);
}
__device__ __forceinline__ void kload2(bf16x8* kf, lds_cptr kp, int j) { kf[2 * j] = *(const A2_LAS bf16x8*)(kp + j * 2048); kf[2 * j + 1] = *(const A2_LAS bf16x8*)(kp + j * 2048 + 512); }
#define A2_SBAR() __builtin_amdgcn_sched_barrier(0)
#define A2_WAIT_BAR(N) asm volatile("s_waitcnt vmcnt(" #N ") lgkmcnt(0)\n\ts_barrier" ::: "memory")
#define A2_MFMA(a, b, c) __builtin_amdgcn_mfma_f32_32x32x16_bf16(a, b, c, 0, 0, 0)

template <int TYPE>
__device__ __forceinline__ void attn_unit2(A2_LAS unsigned char* lds, const bf16* qkv, int b, int h, int qb, const float* tabg, int tab_id, int& cur_tab, const float* c2bh, const unsigned* nrm, const float* kmbh,
                                           bf16* outp, int ldo) {
    int tid_ = threadIdx.x; asm volatile("" : "+v"(tid_));
    const int tid = tid_, lane = tid & 63, r32 = lane & 31, hi = lane >> 5; const int wid = __builtin_amdgcn_readfirstlane(tid >> 6);
    const int qcol = (TYPE == T_B ? 768 : 2048) + 64 * h, kcol = (TYPE == T_B ? 1024 : 2304) + 64 * h, vcol = (TYPE == T_B ? 1280 : 2560) + 64 * h;
    const size_t rowbase = (size_t)b * S; const int q0 = QB * qb, qrel = wid * QBLK + r32, qrow = q0 + qrel;
    int tlo = 0;
    if (TYPE == T_D) {
        const float qm = __uint_as_float(nrm[0]) + __uint_as_float(nrm[1]), kmx = __uint_as_float(nrm[2]) + __uint_as_float(nrm[3]);
        const float bound = 2.0f * sqrtf(qm * kmx) * 1.01f + 42.0f;
        const float c0 = c2bh[q0];
        const bool skip = (lane < 4 * qb) && (c0 - c2bh[64 * (lane < 4 * qb ? lane : 0) + 63] < -bound);
        tlo = __builtin_popcountll(__ballot(skip)) & ~1;
    }
    const int NT = 4 * (qb + 1) - tlo, key0 = 64 * tlo;
    A2_LAS float* tab = (A2_LAS float*)(lds + L_TAB);
    A2_LAS float* km = (A2_LAS float*)(lds + L_KM);
    A2_LAS float* wsf = (A2_LAS float*)(lds + L_WS) + wid * 64;
    const unsigned lds0 = (unsigned)(uintptr_t)lds;
    if (TYPE == T_B) { if (tab_id != cur_tab) { cur_tab = tab_id; for (int i = tid; i < TAB_N + TAB_PADN; i += 512) tab[i] = (i < 4096) ? tabg[4095 - i] : (i < TAB_N ? 0.f : -INFINITY); }
        for (int i = tid; i < 16 * 64; i += 512) km[i] = kmbh[i]; }
    else { cur_tab = -1; for (int i = tid; i < NT * 64; i += 512) tab[i] = c2bh[key0 + i]; }
    const bf16* ksrc = qkv + (rowbase + key0 + lane) * QP + kcol + wid * 8;
    const bf16* vsrc = qkv + (rowbase + key0 + 16 * (wid & 3) + (lane >> 2)) * QP + vcol + (wid >> 2) * 32 + (lane & 3) * 8;
    const unsigned kdst = lds0 + L_K + wid * 1024, vdst = lds0 + L_V + wid * 1024;
#define A2_DMA_K(t, slot) att::glds16(ksrc + (size_t)(t) * KVBLK * QP, (unsigned)__builtin_amdgcn_readfirstlane(kdst + (slot)))
#define A2_DMA_V(t, slot) att::glds16(vsrc + (size_t)(t) * KVBLK * QP, (unsigned)__builtin_amdgcn_readfirstlane(vdst + (slot)))
    const lds_cptr shm3 = (lds_cptr)lds; const lds_cptr kp0 = shm3 + L_K + hi * 1024 + r32 * 16; const lds_cptr vp0 = shm3 + L_V + ((lane >> 4) & 1) * 32 + (lane & 3) * 8 + (4 * hi + ((lane & 15) >> 2)) * 64;
    bf16x8 kf[8];
    A2_DMA_K(0, 0); A2_DMA_V(0, 0); A2_DMA_K(1, SLOTB);
    bf16x8 qr[4];
    { const bf16* qp = qkv + (rowbase + qrow) * QP + qcol;
#pragma unroll
      for (int d0 = 0; d0 < 4; ++d0) qr[d0] = *(const bf16x8*)(qp + d0 * 16 + hi * 8); }
    const float cq = (TYPE == T_D) ? c2bh[qrow] : 0.f;
    float mhat = 0.f, l_reg = 0.f; f32x16 o[2]; o[0] = f32x16{}; o[1] = f32x16{};
    bool resc = false;
    A2_DMA_K(2, 2 * SLOTB);
    A2_WAIT_BAR(3);
    unsigned sel = 0u;
    if (TYPE == T_B) {
        float g[16];
#pragma unroll
        for (int n = 0; n < 16; ++n) { g[n] = -INFINITY; if (n < qb) { float s = 0.f;
#pragma unroll
                for (int d0 = 0; d0 < 4; ++d0) { const f32x4 a = *(const A2_LAS f32x4*)(km + n * 64 + 16 * d0 + 8 * hi), c = *(const A2_LAS f32x4*)(km + n * 64 + 16 * d0 + 8 * hi + 4);
                    const bf16x8 qv = qr[d0];
                    s = fmaf(__builtin_bit_cast(float, (unsigned)(unsigned short)qv[0] << 16), a[0], s); s = fmaf(__builtin_bit_cast(float, (unsigned)(unsigned short)qv[1] << 16), a[1], s);
                    s = fmaf(__builtin_bit_cast(float, (unsigned)(unsigned short)qv[2] << 16), a[2], s); s = fmaf(__builtin_bit_cast(float, (unsigned)(unsigned short)qv[3] << 16), a[3], s);
                    s = fmaf(__builtin_bit_cast(float, (unsigned)(unsigned short)qv[4] << 16), c[0], s); s = fmaf(__builtin_bit_cast(float, (unsigned)(unsigned short)qv[5] << 16), c[1], s);
                    s = fmaf(__builtin_bit_cast(float, (unsigned)(unsigned short)qv[6] << 16), c[2], s); s = fmaf(__builtin_bit_cast(float, (unsigned)(unsigned short)qv[7] << 16), c[3], s); }
                g[n] = att::xhalf_sum(s); } }
#pragma unroll
        for (int r = 0; r < 3; ++r) { float best = -INFINITY; int bi = -1;
#pragma unroll
            for (int n = 0; n < 16; ++n) if (n < qb && !((sel >> n) & 1u) && g[n] > best) { best = g[n]; bi = n; }
            if (bi >= 0) sel |= 1u << bi; }
    }
#define A2_CB(tau, CB0, CB1) do { const float base_ = cq - mhat; \
        if (TYPE == T_D) { const A2_LAS float* cp_ = tab + 64 * (tau) + 4 * hi; \
            _Pragma("unroll") for (int r = 0; r < 16; ++r) { CB0[r] = base_ - cp_[att::offr(r)]; CB1[r] = base_ - cp_[att::offr(r) + 32]; } \
        } else { const int k0_ = key0 + 64 * (tau); const bool pick_ = (k0_ < q0) ? ((sel >> (k0_ >> 8)) & 1u) : true; \
            const A2_LAS float* tb_ = pick_ ? tab + (4095 - (qrow - k0_ - 4 * hi)) : tab + TAB_N; \
            _Pragma("unroll") for (int r = 0; r < 16; ++r) { CB0[r] = tb_[att::offr(r)] + base_; CB1[r] = tb_[att::offr(r) + 32] + base_; } } } while (0)
#define A2_CMASK(P0, P1, t) do { const int jb_ = (t) - (NT - 4); if (jb_ >= 0) { const int kb_ = 64 * jb_ + 4 * hi; \
        _Pragma("unroll") for (int r = 0; r < 16; ++r) { const int kv_ = kb_ + att::offr(r); if (kv_ > qrel) P0[r] = -INFINITY; if (kv_ + 32 > qrel) P1[r] = -INFINITY; } } } while (0)
#define A2_DECIDE(C0, C1) do { float a_ = A2_MX3(C0[0], C0[1], C1[0]), b_ = A2_MX3(C0[2], C0[3], C1[1]); a_ = A2_MX3(a_, C1[2], C1[3]); \
        _Pragma("unroll") for (int r = 4; r < 16; r += 4) { a_ = A2_MX3(a_, C0[r], C0[r + 1]); b_ = A2_MX3(b_, C0[r + 2], C0[r + 3]); a_ = A2_MX3(a_, C1[r], C1[r + 1]); b_ = A2_MX3(b_, C1[r + 2], C1[r + 3]); } \
        const float rm_ = att::xhalf_max(__builtin_fmaxf(a_, b_)); \
        resc = false; \
        if (__builtin_expect(__ballot(rm_ > THR) != 0ull, 0)) { const float dl_ = __builtin_fmaxf(rm_, 0.f); mhat += dl_; \
            _Pragma("unroll") for (int r = 0; r < 16; ++r) { C0[r] -= dl_; C1[r] -= dl_; } \
            const float f_ = EX2(-dl_); l_reg *= f_; if (hi == 0) wsf[r32] = f_; resc = true; } } while (0)
#define A2_RESC() do { if (resc) { asm volatile("s_waitcnt lgkmcnt(0)" ::: "memory"); \
        _Pragma("unroll") for (int i = 0; i < 4; ++i) { const f32x4 fr_ = *(const A2_LAS f32x4*)(wsf + 8 * i + 4 * hi); \
            _Pragma("unroll") for (int j = 0; j < 4; ++j) { o[0][4 * i + j] *= fr_[j]; o[1][4 * i + j] *= fr_[j]; } } } } while (0)
    f32x16 pA0, pA1, pB0, pB1;
    int sl_prev = 0, sl_cur = 0, sl_next = SLOTB;
#define A2_ROT() do { sl_prev = sl_cur; sl_cur = sl_next; sl_next = (sl_next == (NSLOT - 1) * SLOTB) ? 0 : sl_next + SLOTB; } while (0)
    { A2_CB(0, pA0, pA1); kload8(kf, kp0);
#pragma unroll
      for (int d0 = 0; d0 < 4; ++d0) { pA0 = A2_MFMA(kf[2 * d0], qr[d0], pA0); pA1 = A2_MFMA(kf[2 * d0 + 1], qr[d0], pA1); } }
    A2_CMASK(pA0, pA1, 0);
    A2_DECIDE(pA0, pA1);
#pragma unroll
    for (int r = 0; r < 16; ++r) { pA0[r] = EX2(pA0[r]); pA1[r] = EX2(pA1[r]); }
    A2_WAIT_BAR(0);
    A2_RESC();
    A2_DMA_K(3, 0); A2_DMA_V(1, SLOTB);
    A2_ROT();
    kload8(kf, kp0 + sl_cur);
    A2_WAIT_BAR(2);
    s16x4 vlo[8], vhi[8]; u32x4 pw0, pw1, pw2, pw3;
#define A2_PKW(P, B) att::cvtpk(P[B], P[B + 1])
#define A2_PAF(k) __builtin_bit_cast(bf16x8, pw##k)
#define A2_VFR(i) (bf16x8){vlo[i][0], vlo[i][1], vlo[i][2], vlo[i][3], vhi[i][0], vhi[i][1], vhi[i][2], vhi[i][3]}
#define A2_PIN(x) asm volatile("" : "+v"(x))
#define A2_GAPA(MF, A0, A1, A2, A3, W0, W1, PW) do { MF; sacc += A0; sacc += A1; sacc += A2; sacc += A3; A2_PIN(sacc); W0; W1; A2_PIN(PW); A2_SBAR(); } while (0)
#define A2_GAPB(MF, X, B) do { MF; X[B] = EX2(X[B]); X[B + 1] = EX2(X[B + 1]); X[B + 2] = EX2(X[B + 2]); X[B + 3] = EX2(X[B + 3]); A2_PIN(X); A2_SBAR(); } while (0)
#define A2_VRD(i) do { vlo[i] = att::vtr(vp_ + (((i) >> 2) * 4096 + ((i) & 3) * 1024)); vhi[i] = att::vtr(vp_ + (((i) >> 2) * 4096 + ((i) & 3) * 1024 + 512)); } while (0)
#define A2_KRD(G, j) do { if (G) { kload2(kf, kp0 + sl_next, j); A2_SBAR(); } } while (0)
#define A2_STEP(C0, C1, P0, P1, t, GK, GV, GL, MASKED) do { A2_SBAR(); \
        A2_CB(t, C0, C1); A2_SBAR();     \
        const lds_cptr vp_ = vp0 + sl_prev; \
        A2_VRD(0); A2_SBAR(); float sacc = (P0[0] + P0[1]); \
        A2_GAPA(C0 = A2_MFMA(kf[0], qr[0], C0), P0[2], P0[3], P0[4], P0[5],     pw0[0] = A2_PKW(P0, 0),  pw0[1] = A2_PKW(P0, 2),  pw0); \
        A2_VRD(4); A2_SBAR(); A2_GAPA(C1 = A2_MFMA(kf[1], qr[0], C1), P0[6], P0[7], P0[8], P0[9],     pw0[2] = A2_PKW(P0, 4),  pw0[3] = A2_PKW(P0, 6),  pw0); \
        A2_VRD(1); A2_SBAR(); A2_GAPA(C0 = A2_MFMA(kf[2], qr[1], C0),   P0[10], P0[11], P0[12], P0[13], pw1[0] = A2_PKW(P0, 8),  pw1[1] = A2_PKW(P0, 10), pw1); \
        A2_VRD(5); A2_SBAR(); A2_GAPA(C1 = A2_MFMA(kf[3], qr[1], C1),   P0[14], P0[15], P1[0], P1[1],   pw1[2] = A2_PKW(P0, 12), pw1[3] = A2_PKW(P0, 14), pw1); \
        A2_VRD(2); A2_SBAR(); A2_GAPA(C0 = A2_MFMA(kf[4], qr[2], C0),   P1[2], P1[3], P1[4], P1[5],     pw2[0] = A2_PKW(P1, 0),  pw2[1] = A2_PKW(P1, 2),  pw2); \
        A2_VRD(6); A2_SBAR(); A2_GAPA(C1 = A2_MFMA(kf[5], qr[2], C1),   P1[6], P1[7], P1[8], P1[9],     pw2[2] = A2_PKW(P1, 4),  pw2[3] = A2_PKW(P1, 6),  pw2); \
        A2_VRD(3); A2_SBAR(); A2_GAPA(C0 = A2_MFMA(kf[6], qr[3], C0),   P1[10], P1[11], P1[12], P1[13], pw3[0] = A2_PKW(P1, 8),  pw3[1] = A2_PKW(P1, 10), pw3); \
        A2_VRD(7); A2_SBAR(); A2_GAPA(C1 = A2_MFMA(kf[7], qr[3], C1),   P1[14], P1[15], 0.f, 0.f,       pw3[2] = A2_PKW(P1, 12), pw3[3] = A2_PKW(P1, 14), pw3); \
        l_reg += sacc; \
        if (GK) { A2_DMA_K((t) + 3, sl_cur); } if (GV) { A2_DMA_V((t) + 1, sl_next); } \
        if (MASKED) A2_CMASK(C0, C1, t); \
        A2_DECIDE(C0, C1); \
        A2_SBAR(); \
        A2_GAPB(o[0] = A2_MFMA(A2_PAF(0), A2_VFR(0), o[0]), C0, 0); \
        A2_GAPB(o[1] = A2_MFMA(A2_PAF(0), A2_VFR(4), o[1]), C0, 4); \
        A2_KRD(GL, 0); A2_GAPB(o[0] = A2_MFMA(A2_PAF(1), A2_VFR(1), o[0]), C0, 8); \
        A2_KRD(GL, 1); A2_GAPB(o[1] = A2_MFMA(A2_PAF(1), A2_VFR(5), o[1]), C0, 12); \
        A2_KRD(GL, 2); A2_GAPB(o[0] = A2_MFMA(A2_PAF(2), A2_VFR(2), o[0]), C1, 0); \
        A2_KRD(GL, 3); A2_GAPB(o[1] = A2_MFMA(A2_PAF(2), A2_VFR(6), o[1]), C1, 4); \
        A2_GAPB(o[0] = A2_MFMA(A2_PAF(3), A2_VFR(3), o[0]), C1, 8); \
        A2_GAPB(o[1] = A2_MFMA(A2_PAF(3), A2_VFR(7), o[1]), C1, 12); \
    } while (0)
    int t = 1;
    for (; t + 5 < NT; t += 2) {
        A2_STEP(pB0, pB1, pA0, pA1, t, true, true, true, false);     A2_WAIT_BAR(2); A2_RESC(); A2_ROT();
        A2_STEP(pA0, pA1, pB0, pB1, t + 1, true, true, true, false); A2_WAIT_BAR(2); A2_RESC(); A2_ROT();
    }
#define A2_ENDW(tt) do { if ((tt) + 3 < NT) { A2_WAIT_BAR(2); } else if ((tt) + 2 < NT) { A2_WAIT_BAR(1); } else { A2_WAIT_BAR(0); } } while (0)
    for (; t + 1 < NT; t += 2) {
        A2_STEP(pB0, pB1, pA0, pA1, t, (t + 3 < NT), (t + 1 < NT), (t + 1 < NT), true);         A2_ENDW(t);     A2_RESC(); A2_ROT();
        A2_STEP(pA0, pA1, pB0, pB1, t + 1, (t + 4 < NT), (t + 2 < NT), (t + 2 < NT), true);     A2_ENDW(t + 1); A2_RESC(); A2_ROT();
    }
    A2_STEP(pB0, pB1, pA0, pA1, NT - 1, false, false, false, true); A2_RESC();
    { float sacc = pB0[0] + pB0[1];
#pragma unroll
      for (int r = 2; r < 16; ++r) sacc += pB0[r];
#pragma unroll
      for (int r = 0; r < 16; ++r) sacc += pB1[r];
      l_reg += sacc;
      pw0 = (u32x4){A2_PKW(pB0, 0), A2_PKW(pB0, 2), A2_PKW(pB0, 4), A2_PKW(pB0, 6)}; pw1 = (u32x4){A2_PKW(pB0, 8), A2_PKW(pB0, 10), A2_PKW(pB0, 12), A2_PKW(pB0, 14)};
      pw2 = (u32x4){A2_PKW(pB1, 0), A2_PKW(pB1, 2), A2_PKW(pB1, 4), A2_PKW(pB1, 6)}; pw3 = (u32x4){A2_PKW(pB1, 8), A2_PKW(pB1, 10), A2_PKW(pB1, 12), A2_PKW(pB1, 14)};
      A2_SBAR();
      const lds_cptr vp_ = vp0 + sl_cur;
#pragma unroll
      for (int i = 0; i < 8; ++i) A2_VRD(i);
      o[0] = A2_MFMA(A2_PAF(0), A2_VFR(0), o[0]); o[0] = A2_MFMA(A2_PAF(1), A2_VFR(1), o[0]); o[0] = A2_MFMA(A2_PAF(2), A2_VFR(2), o[0]); o[0] = A2_MFMA(A2_PAF(3), A2_VFR(3), o[0]);
      o[1] = A2_MFMA(A2_PAF(0), A2_VFR(4), o[1]); o[1] = A2_MFMA(A2_PAF(1), A2_VFR(5), o[1]); o[1] = A2_MFMA(A2_PAF(2), A2_VFR(6), o[1]); o[1] = A2_MFMA(A2_PAF(3), A2_VFR(7), o[1]); }
    l_reg = att::xhalf_sum(l_reg);
    if (hi == 0) wsf[32 + r32] = 1.0f / l_reg;
    asm volatile("s_waitcnt lgkmcnt(0)" ::: "memory");
    {   A2_LAS bf16* stg = (A2_LAS bf16*)(lds + L_OST) + wid * 2048;
#pragma unroll
        for (int i = 0; i < 4; ++i) { const f32x4 rl = *(const A2_LAS f32x4*)(wsf + 32 + 8 * i + 4 * hi);
#pragma unroll
            for (int j = 0; j < 4; ++j) { const int orow = 8 * i + 4 * hi + j;
#pragma unroll
                for (int d0 = 0; d0 < 2; ++d0) { const unsigned w = att::cvtpk(o[d0][4 * i + j] * rl[j], 0.f); stg[orow * 64 + d0 * 32 + r32] = (bf16)(w & 0xffffu); } } }
        asm volatile("s_waitcnt lgkmcnt(0)" ::: "memory");
#pragma unroll
        for (int i = 0; i < 4; ++i) { const int row = i * 8 + (lane >> 3), ch = lane & 7; const u32x4 v = *(const A2_LAS u32x4*)(stg + row * 64 + ch * 8);
            *(u32x4*)(outp + (rowbase + q0 + wid * QBLK + row) * ldo + ch * 8) = v; }
    }
    asm volatile("s_waitcnt lgkmcnt(0)\n\ts_barrier" ::: "memory");
#undef A2_DMA_K
#undef A2_DMA_V
#undef A2_CB
#undef A2_CMASK
#undef A2_DECIDE
#undef A2_RESC
#undef A2_ROT
#undef A2_PKW
#undef A2_PAF
#undef A2_VFR
#undef A2_PIN
#undef A2_GAPA
#undef A2_GAPB
#undef A2_VRD
#undef A2_KRD
#undef A2_STEP
#undef A2_ENDW
}
}

namespace att3 {
#define A3_LAS __attribute__((address_space(3)))
typedef att::bf16x8 bf16x8; typedef att::s16x4 s16x4; typedef att::f32x16 f32x16; typedef att::f32x4 f32x4; typedef att::u32x4 u32x4; typedef unsigned short bf16;
constexpr int S = 4096, QP = 2816, SLOTB = 8192;
constexpr int L_K = 0, L_V = 6 * SLOTB, L_WS = 12 * SLOTB, L_TAB = L_WS + 2048, TAB_N = 5600, L_END = L_TAB + TAB_N * 4;
static_assert(L_TAB % 16 == 0 && L_END <= 131072, "attention engine 3 LDS map");
#define A3_MFMA(a, b, c) __builtin_amdgcn_mfma_f32_32x32x16_bf16(a, b, c, 0, 0, 0)

struct BandSrc { const bf16* k; const bf16* v; int rs, kw, tmin; };
__device__ __forceinline__ void band_dma(unsigned lds_region, const bf16* src, int rs, int kw, int tmin, bool isV, int wid, int lane) {
    for (int t = tmin; t < 6; ++t) { const int k0 = kw + 64 * t;
        if (!isV) att::glds16(src + (size_t)(k0 + lane) * rs + wid * 8, (unsigned)__builtin_amdgcn_readfirstlane(lds_region + t * SLOTB + wid * 1024));
        else att::glds16(src + (size_t)(k0 + 16 * (wid & 3) + (lane >> 2)) * rs + (wid >> 2) * 32 + (lane & 3) * 8, (unsigned)__builtin_amdgcn_readfirstlane(lds_region + t * SLOTB + wid * 1024)); }
}
#define A3_WAITV(n4, n6) do { if (n4) asm volatile("s_waitcnt vmcnt(4)" ::: "memory"); else if (n6) asm volatile("s_waitcnt vmcnt(6)" ::: "memory"); else asm volatile("s_waitcnt vmcnt(0)" ::: "memory"); } while (0)
template <int DIL>
__device__ __forceinline__ void attn_band(A3_LAS unsigned char* lds, const bf16* qkv, int b, int h, int qb, int res, int W, int qcol, int kcol, int vcol,
                                          const float* tabg, int tab_id, int& cur_tab, float sink2, bf16* outp, int ldo, float* lse_out, const BandSrc nx, const bool nxt) {
    int tid_ = threadIdx.x; asm volatile("" : "+v"(tid_));
    const int tid = tid_, lane = tid & 63, r32 = lane & 31, hi = lane >> 5; const int wid = __builtin_amdgcn_readfirstlane(tid >> 6);
    const size_t rowbase = (size_t)b * S + res;
    const int q0 = 256 * qb, kw = q0 - 128, tmin = (qb == 0) ? 2 : 0, ta = wid >> 1;
    A3_LAS float* tab = (A3_LAS float*)(lds + L_TAB);
    A3_LAS float* wsf = (A3_LAS float*)(lds + L_WS) + wid * 64;
    const unsigned lds0 = (unsigned)(uintptr_t)lds;
    if (tab_id != cur_tab) { cur_tab = tab_id; for (int i = tid; i < TAB_N; i += 512) tab[i] = (i < 4096 && 4095 - i <= W * DIL) ? tabg[4095 - i] : -INFINITY; }
    const int qfw = q0 + 32 * wid;
    bf16x8 qr[4];
    { const bf16* qrow = qkv + (rowbase + (size_t)(qfw + r32) * DIL) * QP + qcol;
#pragma unroll
      for (int d0 = 0; d0 < 4; ++d0) qr[d0] = *(const bf16x8*)(qrow + 16 * d0 + 8 * hi); }
    A3_WAITV(tmin == 2, tmin == 0);
    __syncthreads();
    f32x16 p[3][2];
#pragma unroll
    for (int i = 0; i < 3; ++i) {
        const int t = ta + i;
        if (t >= tmin) {
            const A3_LAS char* kb = (const A3_LAS char*)(lds + L_K + t * SLOTB) + hi * 1024 + r32 * 16;
            f32x16& a0 = p[i][0]; f32x16& a1 = p[i][1];
#pragma unroll
            for (int d0 = 0; d0 < 4; ++d0) { const bf16x8 b0 = *(const A3_LAS bf16x8*)(kb + d0 * 2048), b1 = *(const A3_LAS bf16x8*)(kb + d0 * 2048 + 512);
                if (d0 == 0) { a0 = A3_MFMA(b0, qr[0], f32x16{}); a1 = A3_MFMA(b1, qr[0], f32x16{}); } else { a0 = A3_MFMA(b0, qr[d0], a0); a1 = A3_MFMA(b1, qr[d0], a1); } }
            const int d0l = qfw + r32 - (kw + 64 * t) - 4 * hi;
            const A3_LAS float* tb = tab + (4095 - DIL * d0l);
#pragma unroll
            for (int r = 0; r < 16; ++r) { a0[r] += tb[DIL * att::offr(r)]; a1[r] += tb[DIL * (att::offr(r) + 32)]; }
        }
    }
    __syncthreads();
    if (nxt) band_dma(lds0 + L_K, nx.k, nx.rs, nx.kw, nx.tmin, false, wid, lane);
    float m = -INFINITY, m2 = -INFINITY;
#pragma unroll
    for (int i = 0; i < 3; ++i) { if (ta + i >= tmin) {
#pragma unroll
        for (int r = 0; r < 16; r += 2) { m = __builtin_fmaxf(__builtin_fmaxf(m, p[i][0][r]), p[i][0][r + 1]); m2 = __builtin_fmaxf(__builtin_fmaxf(m2, p[i][1][r]), p[i][1][r + 1]); } } }
    m = __builtin_fmaxf(m, m2);
    m = att::xhalf_max(m);
    const float negm = -m;
    if (nxt) A3_WAITV(nx.tmin == 2, nx.tmin == 0); else A3_WAITV(false, false);
    __syncthreads();
    float l = 0.f; f32x16 o[2]; o[0] = f32x16{}; o[1] = f32x16{};
    const int vpo = ((lane >> 4) & 1) * 32 + (lane & 3) * 8 + (4 * hi + ((lane & 15) >> 2)) * 64;
#pragma unroll
    for (int i = 0; i < 3; ++i) {
        const int t = ta + i;
        if (t >= tmin) {
            float sacc = 0.f;
#pragma unroll
            for (int r = 0; r < 16; ++r) { p[i][0][r] = EX2(p[i][0][r] + negm); p[i][1][r] = EX2(p[i][1][r] + negm); sacc += p[i][0][r] + p[i][1][r]; }
            l += sacc;
            u32x4 pw[4];
#pragma unroll
            for (int j = 0; j < 4; ++j) { pw[0][j] = att::cvtpk(p[i][0][2 * j], p[i][0][2 * j + 1]); pw[1][j] = att::cvtpk(p[i][0][8 + 2 * j], p[i][0][9 + 2 * j]); pw[2][j] = att::cvtpk(p[i][1][2 * j], p[i][1][2 * j + 1]); pw[3][j] = att::cvtpk(p[i][1][8 + 2 * j], p[i][1][9 + 2 * j]); }
            const A3_LAS char* vp = (const A3_LAS char*)(lds + L_V + t * SLOTB) + vpo;
#pragma unroll
            for (int d0 = 0; d0 < 2; ++d0)
#pragma unroll
                for (int ks = 0; ks < 4; ++ks) { const s16x4 lo = att::vtr(vp + d0 * 4096 + ks * 1024), hh = att::vtr(vp + d0 * 4096 + ks * 1024 + 512);
                    const bf16x8 vf = (bf16x8){lo[0], lo[1], lo[2], lo[3], hh[0], hh[1], hh[2], hh[3]};
                    o[d0] = A3_MFMA(__builtin_bit_cast(bf16x8, pw[ks]), vf, o[d0]); }
        }
    }
    l = att::xhalf_sum(l);
    l += EX2(sink2 - m);
    if (hi == 0) wsf[32 + r32] = 1.0f / l;
    __syncthreads();
    {   A3_LAS bf16* stg = (A3_LAS bf16*)(lds + L_V) + wid * 2048;
#pragma unroll
        for (int i = 0; i < 4; ++i) { const f32x4 rl = *(const A3_LAS f32x4*)(wsf + 32 + 8 * i + 4 * hi);
#pragma unroll
            for (int j = 0; j < 4; ++j) { const int orow = 8 * i + 4 * hi + j;
#pragma unroll
                for (int d0 = 0; d0 < 2; ++d0) { const unsigned w = att::cvtpk(o[d0][4 * i + j] * rl[j], 0.f); stg[orow * 64 + d0 * 32 + r32] = (bf16)(w & 0xffffu); } } }
        asm volatile("s_waitcnt lgkmcnt(0)" ::: "memory");
#pragma unroll
        for (int i = 0; i < 4; ++i) { const int row = i * 8 + (lane >> 3), ch = lane & 7; const u32x4 v = *(const A3_LAS u32x4*)(stg + row * 64 + ch * 8);
            *(u32x4*)(outp + (rowbase + (size_t)(qfw + row) * DIL) * ldo + ch * 8) = v; }
    }
    if (lse_out != nullptr && hi == 0) lse_out[(rowbase + (size_t)(qfw + r32) * DIL) * 4] = m + __builtin_amdgcn_logf(l);
    asm volatile("s_waitcnt lgkmcnt(0)" ::: "memory"); __syncthreads();
    if (nxt) band_dma(lds0 + L_V, nx.v, nx.rs, nx.kw, nx.tmin, true, wid, lane);
}
}

#ifndef PG8_SP2
#define PG8_SP2 true
#endif
#ifndef PG8_ALIGN
#define PG8_ALIGN true
#endif

constexpr int NWAVES = 8;
constexpr int NB = 8, S = 4096, DM = 1024, M = NB * S, HD = 64, QP = 2816, NIN = 2820, DFF = 2816, NGU = 5632, DEPTH = 2;
constexpr float LOG2E = 1.4426950408889634f, C2 = 0.125f * LOG2E, EPS = 1e-6f;
constexpr int C_QA = 0, C_KA = 256, C_VA = 512, C_QB = 768, C_KB = 1024, C_VB = 1280, C_QC = 1536, C_KC = 1792, C_VC = 1920, C_QD = 2048, C_KD = 2304, C_VD = 2560;
constexpr int NPHASE = 14, PH_PER_LAYER = 6;
constexpr int N_LAUNCHES = MK_N_LAUNCHES;

constexpr size_t MiB = 1u << 20;
constexpr size_t WS_CTL = 0, CTL_ZERO_BYTES = 1 * MiB;
constexpr size_t WS_WIN = 1 * MiB;
constexpr size_t WS_WOUT = 12 * MiB;
constexpr size_t WS_WGU = 16 * MiB;
constexpr size_t WS_WDN = 38 * MiB;
constexpr size_t WS_SMALL = 49 * MiB;
constexpr size_t WS_WFD = WS_SMALL;
constexpr size_t WS_BIAST = WS_SMALL + 64 * 1024;
constexpr size_t WS_RSTD = WS_SMALL + 256 * 1024;
constexpr size_t WS_LF = WS_SMALL + 512 * 1024;
constexpr size_t WS_C2 = WS_SMALL + 1024 * 1024;
constexpr size_t WS_KMEAN = WS_SMALL + 1536 * 1024;
constexpr size_t WS_XB = 52 * MiB;
constexpr size_t WS_MIX = 116 * MiB;
constexpr size_t WS_QKV = 180 * MiB;
constexpr size_t WS_PA = 356 * MiB;
constexpr size_t WS_LSE = 404 * MiB;
constexpr size_t WS_SS = 406 * MiB;
constexpr size_t WS_FD = 408 * MiB;
constexpr size_t WS_X8 = 416 * MiB;
constexpr size_t WS_MIX8 = 448 * MiB;
constexpr size_t WS_END = 480 * MiB;
constexpr float WSCALE = 64.0f, ASCALE = 8.0f;
constexpr int CW_BAR = 4096, CW_NORM = 16384, CW_KMEAN = 65536;
constexpr int CW_UNUSED_ = 0;

constexpr int RING_OFF = 0, RING_BYTES = 131072;
constexpr int LDSCTL_OFF = RING_BYTES, MISC_OFF = LDSCTL_OFF + 320;
constexpr int LDS_BYTES = 147456;

#define GAS __attribute__((address_space(1)))
#define LAS __attribute__((address_space(3)))
typedef unsigned short bf16;
typedef unsigned v4u __attribute__((ext_vector_type(4)));
typedef float f32x4 __attribute__((ext_vector_type(4)));
typedef GAS unsigned gu32;
#define RLX_AGENT __ATOMIC_RELAXED, __HIP_MEMORY_SCOPE_AGENT
#define LDS_WAIT() asm volatile("s_waitcnt lgkmcnt(0)" ::: "memory")
__device__ __forceinline__ unsigned f2bf(float f) { unsigned u = __builtin_bit_cast(unsigned, f); return (u + 0x7fffu + ((u >> 16) & 1u)) >> 16; }
__device__ __forceinline__ unsigned pk2(float lo, float hi) { return f2bf(lo) | (f2bf(hi) << 16); }
__device__ __forceinline__ float bflo(unsigned w) { return __builtin_bit_cast(float, w << 16); }
__device__ __forceinline__ float bfhi(unsigned w) { return __builtin_bit_cast(float, w & 0xffff0000u); }

#define XB_TMO      128
#define XB_XCNT(j)  (256  + 64 * (j))
#define XB_XSUB(j)  (1280 + 64 * (j))
#define XB_XGEN(j)  (2304 + 64 * (j))
#define XB_TOP      3328
#define XB_TOPGEN   3392
#define XCD_BAR_WORDS 3456
#define XB_SPIN_CAP (1u << 18)

__device__ __forceinline__ unsigned xb_ld(unsigned* p)              { return __hip_atomic_load(p, __ATOMIC_RELAXED, __HIP_MEMORY_SCOPE_AGENT); }
__device__ __forceinline__ unsigned xb_add(unsigned* p, unsigned v) { return __hip_atomic_fetch_add(p, v, __ATOMIC_RELAXED, __HIP_MEMORY_SCOPE_AGENT); }
__device__ __forceinline__ unsigned xb_xcc_id() { return (unsigned)__builtin_amdgcn_s_getreg((3 << 11) | 20) & 0xFu; }
#define XB_SPIN(cond, bar) do { unsigned _sp = 0; while (cond) { __builtin_amdgcn_s_sleep(1); \
    if ((++_sp & 255u) == 0u) { if (xb_ld(&(bar)[XB_TMO])) break; if (_sp > XB_SPIN_CAP) { atomicAdd(&(bar)[XB_TMO], 1u); break; } } } } while (0)

struct XcdBarrier {
    unsigned* bar; unsigned x;
    volatile LAS unsigned* st;
};

__device__ __forceinline__ XcdBarrier xcd_barrier_post(unsigned* bar, volatile LAS unsigned* st) {
    XcdBarrier b; b.bar = bar; b.x = xb_xcc_id(); b.st = st;
    if (threadIdx.x == 0) (void)xb_add(&bar[XB_XCNT(b.x)], 1u);
    return b;
}
__device__ __forceinline__ void xcd_barrier_complete(unsigned* bar, unsigned x, unsigned& nloc, unsigned& nx) {
    const unsigned G = gridDim.x * gridDim.y * gridDim.z;
    unsigned sum, cnt, mine, sp = 0u;
    for (;;) {
        sum = 0u; cnt = 0u; mine = 0u;
#pragma unroll
        for (unsigned j = 0; j < 16; ++j) { const unsigned c = xb_ld(&bar[XB_XCNT(j)]); sum += c; cnt += (c > 0u) ? 1u : 0u; mine = (j == x) ? c : mine; }
        if (sum == G) break;
        __builtin_amdgcn_s_sleep(1);
        if ((++sp & 255u) == 0u) { if (xb_ld(&bar[XB_TMO])) break; if (sp > XB_SPIN_CAP) { atomicAdd(&bar[XB_TMO], 1u); break; } }
    }
    nloc = mine > 0u ? mine : 1u; nx = cnt > 0u ? cnt : 1u;
}

__device__ __forceinline__ void xcd_barrier(const XcdBarrier& b) {
    asm volatile("s_waitcnt vmcnt(0)" ::: "memory");
    __syncthreads();
    if (threadIdx.x == 0) {
        unsigned* bar = b.bar;
        __builtin_amdgcn_s_waitcnt(0);
        unsigned nloc = b.st[0], nx = b.st[1];
        if (nloc == 0u) { xcd_barrier_complete(bar, b.x, nloc, nx); b.st[0] = nloc; b.st[1] = nx; }
        const unsigned old = xb_add(&bar[XB_XSUB(b.x)], 1u);
        const unsigned gen = old / nloc;
        if (old + 1u == (gen + 1u) * nloc) {
            __builtin_amdgcn_fence(__ATOMIC_RELEASE, "agent");
            asm volatile("s_waitcnt vmcnt(0)" ::: "memory");
            const unsigned og = xb_add(&bar[XB_TOP], 1u);
            const unsigned tg = og / nx;
            if (og + 1u == (tg + 1u) * nx) xb_add(&bar[XB_TOPGEN], 1u);
            else XB_SPIN(xb_ld(&bar[XB_TOPGEN]) == tg, bar);
            __builtin_amdgcn_fence(__ATOMIC_ACQUIRE, "agent");
            xb_add(&bar[XB_XGEN(b.x)], 1u);
            asm volatile("s_waitcnt vmcnt(0)" ::: "memory");
        } else {
            XB_SPIN(xb_ld(&bar[XB_XGEN(b.x)]) == gen, bar);
            __builtin_amdgcn_fence(__ATOMIC_ACQUIRE, "agent");
            asm volatile("s_waitcnt vmcnt(0)" ::: "memory");
        }
    }
    __syncthreads();
}


__device__ __forceinline__ float wave_sum(float v) {
#pragma unroll
    for (int o = 1; o < 64; o <<= 1) v += __shfl_xor(v, o);
    return v;
}

__device__ __forceinline__ void tr_item(const float* W, int ldw, int K, const float* g, bf16* WT, int k0, int n0, int drow0, LAS float* scr, int lane) {
    float v[32];
#pragma unroll
    for (int i = 0; i < 32; ++i) { const int kk = 2 * i + (lane >> 5); v[i] = W[(size_t)(k0 + kk) * ldw + n0 + (lane & 31)]; }
    if (g) {
#pragma unroll
        for (int i = 0; i < 32; ++i) v[i] *= g[k0 + 2 * i + (lane >> 5)];
    }
#pragma unroll
    for (int i = 0; i < 32; ++i) scr[(2 * i + (lane >> 5)) * 33 + (lane & 31)] = v[i];
    LDS_WAIT(); asm volatile("" ::: "memory");
    const int c = lane & 7;
#pragma unroll
    for (int j = 0; j < 4; ++j) { const int n = (lane >> 3) + 8 * j; const LAS float* s = scr + (8 * c) * 33 + n;
        v4u o; o.x = pk2(s[0 * 33], s[1 * 33]); o.y = pk2(s[2 * 33], s[3 * 33]); o.z = pk2(s[4 * 33], s[5 * 33]); o.w = pk2(s[6 * 33], s[7 * 33]);
        *(GAS v4u*)(WT + (size_t)(drow0 + n) * K + k0 + 8 * c) = o; }
    LDS_WAIT(); asm volatile("" ::: "memory");
}
__device__ __forceinline__ void tr_item8(const float* W, int ldw, int K, const float* g, float sc, unsigned char* WT8, int k0, int n0, int drow0, LAS float* scr, int lane) {
    float v[32];
#pragma unroll
    for (int i = 0; i < 32; ++i) { const int kk = 2 * i + (lane >> 5); v[i] = W[(size_t)(k0 + kk) * ldw + n0 + (lane & 31)]; }
#pragma unroll
    for (int i = 0; i < 32; ++i) v[i] *= g ? g[k0 + 2 * i + (lane >> 5)] * sc : sc;
#pragma unroll
    for (int i = 0; i < 32; ++i) scr[(2 * i + (lane >> 5)) * 33 + (lane & 31)] = v[i];
    LDS_WAIT(); asm volatile("" ::: "memory");
    const int c = lane & 3;
#pragma unroll
    for (int j = 0; j < 2; ++j) { const int n = (lane >> 2) + 16 * j; const LAS float* s = scr + (16 * c) * 33 + n;
        v4u o; o.x = pg8::pk4_fp8(s[0 * 33], s[1 * 33], s[2 * 33], s[3 * 33]); o.y = pg8::pk4_fp8(s[4 * 33], s[5 * 33], s[6 * 33], s[7 * 33]);
        o.z = pg8::pk4_fp8(s[8 * 33], s[9 * 33], s[10 * 33], s[11 * 33]); o.w = pg8::pk4_fp8(s[12 * 33], s[13 * 33], s[14 * 33], s[15 * 33]);
        *(GAS v4u*)(WT8 + (size_t)(drow0 + n) * K + k0 + 16 * c) = o; }
    LDS_WAIT(); asm volatile("" ::: "memory");
}
__device__ __forceinline__ int t5_bucket(int n) {
    if (n < 16) return n;
    int b = 16;
    b += (n >= 22); b += (n >= 30); b += (n >= 40); b += (n >= 54); b += (n >= 73); b += (n >= 99); b += (n >= 134); b += (n >= 182);
    b += (n >= 246); b += (n >= 332); b += (n >= 450); b += (n >= 609); b += (n >= 825); b += (n >= 1117); b += (n >= 1513);
    return b;
}

struct Ptrs {
    const float *x, *norm1_g, *w_in, *f_bias, *sinks, *mix_g, *w_out, *norm2_g, *w_gate, *w_up, *w_down, *rel_bias, *final_g;
    float* out; unsigned char* ws;
};

__device__ __forceinline__ void phase_prep(const Ptrs& P, LAS unsigned char* lds, int it_lo, int it_hi, bool tables, int gw, int NGW, int wave, int lane) {
    LAS float* scr = (LAS float*)(lds + RING_OFF + wave * 16384);
    constexpr int I_IN = 16 * 88, I_OUT = 16 * 32, I_G = 16 * 88, I_DN = 44 * 32, I_LAYER = I_IN + I_OUT + 2 * I_G + I_DN;
    for (int it = it_lo * I_LAYER + gw; it < it_hi * I_LAYER; it += NGW) {
        const int l = it / I_LAYER; int r = it % I_LAYER;
        if (r < I_IN) { const int kb = r / 88, nb = r % 88; tr_item(P.w_in + (size_t)l * DM * NIN, NIN, DM, P.norm1_g + l * DM, (bf16*)(P.ws + WS_WIN) + (size_t)l * QP * DM, 64 * kb, 32 * nb, 32 * nb, scr, lane); continue; } r -= I_IN;
        if (r < I_OUT) { const int kb = r / 32, nb = r % 32;
            if (G2_FP8) tr_item8(P.w_out + (size_t)l * DM * DM, DM, DM, P.mix_g + l * DM, WSCALE, P.ws + WS_WOUT + (size_t)l * DM * DM, 64 * kb, 32 * nb, 32 * nb, scr, lane);
            else tr_item(P.w_out + (size_t)l * DM * DM, DM, DM, P.mix_g + l * DM, (bf16*)(P.ws + WS_WOUT) + (size_t)l * DM * DM, 64 * kb, 32 * nb, 32 * nb, scr, lane);
            continue; } r -= I_OUT;
        if (r < I_G) { const int kb = r / 88, nb = r % 88, n0 = 32 * nb; tr_item8(P.w_gate + (size_t)l * DM * DFF, DFF, DM, P.norm2_g + l * DM, WSCALE, P.ws + WS_WGU + (size_t)l * NGU * DM, 64 * kb, n0, 256 * (n0 / 128) + (n0 % 128), scr, lane); continue; } r -= I_G;
        if (r < I_G) { const int kb = r / 88, nb = r % 88, n0 = 32 * nb; tr_item8(P.w_up + (size_t)l * DM * DFF, DFF, DM, P.norm2_g + l * DM, WSCALE, P.ws + WS_WGU + (size_t)l * NGU * DM, 64 * kb, n0, 256 * (n0 / 128) + 128 + (n0 % 128), scr, lane); continue; } r -= I_G;
        { const int kb = r / 32, nb = r % 32; tr_item8(P.w_down + (size_t)l * DFF * DM, DM, DFF, nullptr, WSCALE, P.ws + WS_WDN + (size_t)l * DM * DFF, 64 * kb, 32 * nb, 32 * nb, scr, lane); }
    }
    if (!tables) return;
    const int gt = gw * 64 + lane, NGT = NGW * 64;
    float* biasT = (float*)(P.ws + WS_BIAST);
    for (int i = gt; i < 12 * 4096; i += NGT) { const int col = i >> 12, dist = i & 4095; biasT[i] = P.rel_bias[t5_bucket(dist) * 12 + col] * LOG2E; }
    unsigned* wfd = (unsigned*)(P.ws + WS_WFD);
    for (int i = gt; i < DEPTH * (DM / 2) * 4; i += NGT) { const int l = i / (DM * 2), k = 2 * ((i / 4) % (DM / 2)), h = i & 3;
        wfd[i] = pg8::cvt_pk_bf16(P.norm1_g[l * DM + k] * P.w_in[((size_t)l * DM + k) * NIN + 2816 + h], P.norm1_g[l * DM + k + 1] * P.w_in[((size_t)l * DM + k + 1) * NIN + 2816 + h]); }
}

template <bool WITH_FD>
__device__ __forceinline__ void row_pass(const float* xin, bf16* xb, float* rstd, const LAS float* wfd, const float* fbias, float* lf, int gw, int NGW, int lane) {
    f32x4 nx[4];
    if (gw < M) { const GAS f32x4* xr = (const GAS f32x4*)(xin + (size_t)gw * DM) + lane;
#pragma unroll
        for (int j = 0; j < 4; ++j) nx[j] = xr[64 * j]; }
    for (int m = gw; m < M; m += NGW) {
        f32x4 v[4]; float s = 0.f;
#pragma unroll
        for (int j = 0; j < 4; ++j) v[j] = nx[j];
        if (m + NGW < M) { const GAS f32x4* xr = (const GAS f32x4*)(xin + (size_t)(m + NGW) * DM) + lane;
#pragma unroll
            for (int j = 0; j < 4; ++j) nx[j] = xr[64 * j]; }
#pragma unroll
        for (int j = 0; j < 4; ++j) s += (v[j].x * v[j].x + v[j].y * v[j].y) + (v[j].z * v[j].z + v[j].w * v[j].w);
        const float wave_sum_keep = wave_sum(s);
        const float rs = 1.0f / sqrtf(wave_sum_keep * (1.0f / DM) + EPS);
        GAS unsigned long long* o8 = (GAS unsigned long long*)(xb + (size_t)m * DM) + lane;
#pragma unroll
        for (int j = 0; j < 4; ++j) o8[64 * j] = (unsigned long long)pk2(v[j].x, v[j].y) | ((unsigned long long)pk2(v[j].z, v[j].w) << 32);
        if (WITH_FD) {
            float f0 = 0.f, f1 = 0.f, f2 = 0.f, f3 = 0.f;
#pragma unroll
            for (int j = 0; j < 4; ++j)
#pragma unroll
                for (int i = 0; i < 4; ++i) { const f32x4 w = *(const LAS f32x4*)(wfd + (4 * lane + 256 * j + i) * 4); const float xv = v[j][i]; f0 += xv * w.x; f1 += xv * w.y; f2 += xv * w.z; f3 += xv * w.w; }
            f0 = wave_sum(f0); f1 = wave_sum(f1); f2 = wave_sum(f2); f3 = wave_sum(f3);
            if (lane < 4) { const float f = lane == 0 ? f0 : lane == 1 ? f1 : lane == 2 ? f2 : f3; const float z = f * rs + fbias[lane];
                lf[(size_t)lane * M + m] = fminf(z, 0.f) - log1pf(expf(-fabsf(z))); }
        }
        if (lane < 16) rstd[(size_t)m * 16 + lane] = (lane == 0) ? wave_sum_keep : 0.f;
    }
}
__device__ __forceinline__ void final_pass(const bf16* xb, float* out, const float* g, const float* ss, int gw, int NGW, int lane) {
    v4u na = {0u, 0u, 0u, 0u}, nb = {0u, 0u, 0u, 0u}; float ns = 0.f;
    if (gw < M) { const GAS v4u* p = (const GAS v4u*)(xb + (size_t)gw * DM) + 2 * lane; na = p[0]; nb = p[1]; ns = lane < 16 ? ss[(size_t)gw * 16 + lane] : 0.f; }
    for (int m = gw; m < M; m += NGW) {
        const v4u a = na, b = nb; const float sv = ns; float f[16];
        if (m + NGW < M) { const GAS v4u* p = (const GAS v4u*)(xb + (size_t)(m + NGW) * DM) + 2 * lane; na = p[0]; nb = p[1]; ns = lane < 16 ? ss[(size_t)(m + NGW) * 16 + lane] : 0.f; }
        f[0] = bflo(a.x); f[1] = bfhi(a.x); f[2] = bflo(a.y); f[3] = bfhi(a.y); f[4] = bflo(a.z); f[5] = bfhi(a.z); f[6] = bflo(a.w); f[7] = bfhi(a.w);
        f[8] = bflo(b.x); f[9] = bfhi(b.x); f[10] = bflo(b.y); f[11] = bfhi(b.y); f[12] = bflo(b.z); f[13] = bfhi(b.z); f[14] = bflo(b.w); f[15] = bfhi(b.w);
        const float s = wave_sum(sv);
        const float rs = 1.0f / sqrtf(s * (1.0f / DM) + EPS);
        GAS f32x4* o = (GAS f32x4*)(out + (size_t)m * DM) + 4 * lane; const f32x4* gv = (const f32x4*)g + 4 * lane;
#pragma unroll
        for (int j = 0; j < 4; ++j) { const f32x4 gg = gv[j]; o[j] = (f32x4){f[4 * j] * rs * gg[0], f[4 * j + 1] * rs * gg[1], f[4 * j + 2] * rs * gg[2], f[4 * j + 3] * rs * gg[3]}; }
    }
}
__device__ __forceinline__ void unpack16(const v4u a, const v4u b, float (&f)[16]) {
    f[0] = bflo(a.x); f[1] = bfhi(a.x); f[2] = bflo(a.y); f[3] = bfhi(a.y); f[4] = bflo(a.z); f[5] = bfhi(a.z); f[6] = bflo(a.w); f[7] = bfhi(a.w);
    f[8] = bflo(b.x); f[9] = bfhi(b.x); f[10] = bflo(b.y); f[11] = bfhi(b.y); f[12] = bflo(b.z); f[13] = bfhi(b.z); f[14] = bflo(b.w); f[15] = bfhi(b.w);
}
__device__ __forceinline__ void mixnorm_pass(bf16* mix, unsigned char* mix8, const bf16* pa, const float* lse, int gw, int NGW, int lane) {
    for (int m = gw; m < M; m += NGW) {
        GAS v4u* p = (GAS v4u*)(mix + (size_t)m * DM) + 2 * lane;
        float f[16];
        if ((ATT_MFMA_MASK & 1) && lane < 16) {
            const int hd = lane >> 2;
            const float l0 = lse[(size_t)m * 4 + hd], l1 = lse[((size_t)M + m) * 4 + hd], l2 = lse[((size_t)2 * M + m) * 4 + hd];
            const float mx = fmaxf(l0, fmaxf(l1, l2)); float w0 = EX2(l0 - mx), w1 = EX2(l1 - mx), w2 = EX2(l2 - mx); const float inv = 1.0f / (w0 + w1 + w2); w0 *= inv; w1 *= inv; w2 *= inv;
            float t[16];
            { const GAS v4u* q = (const GAS v4u*)(pa + (size_t)m * 256) + 2 * lane; unpack16(q[0], q[1], t);
#pragma unroll
              for (int i = 0; i < 16; ++i) f[i] = w0 * t[i]; }
            { const GAS v4u* q = (const GAS v4u*)(pa + ((size_t)M + m) * 256) + 2 * lane; unpack16(q[0], q[1], t);
#pragma unroll
              for (int i = 0; i < 16; ++i) f[i] += w1 * t[i]; }
            { const GAS v4u* q = (const GAS v4u*)(pa + ((size_t)2 * M + m) * 256) + 2 * lane; unpack16(q[0], q[1], t);
#pragma unroll
              for (int i = 0; i < 16; ++i) f[i] += w2 * t[i]; }
        } else { const v4u a = p[0], b = p[1]; unpack16(a, b, f); }
        {
        }
        float s = 0.f;
#pragma unroll
        for (int i = 0; i < 16; ++i) s += f[i] * f[i];
        s += __shfl_xor(s, 1); s += __shfl_xor(s, 2); s += __shfl_xor(s, 4); s += __shfl_xor(s, 8);
        const float rs = 1.0f / sqrtf(s * (1.0f / 256.0f) + EPS);
        v4u oa, ob;
        oa.x = pk2(f[0] * rs, f[1] * rs); oa.y = pk2(f[2] * rs, f[3] * rs); oa.z = pk2(f[4] * rs, f[5] * rs); oa.w = pk2(f[6] * rs, f[7] * rs);
        ob.x = pk2(f[8] * rs, f[9] * rs); ob.y = pk2(f[10] * rs, f[11] * rs); ob.z = pk2(f[12] * rs, f[13] * rs); ob.w = pk2(f[14] * rs, f[15] * rs);
        if (G2_FP8) { v4u q; q.x = pg8::pk4_fp8(f[0] * rs, f[1] * rs, f[2] * rs, f[3] * rs); q.y = pg8::pk4_fp8(f[4] * rs, f[5] * rs, f[6] * rs, f[7] * rs); q.z = pg8::pk4_fp8(f[8] * rs, f[9] * rs, f[10] * rs, f[11] * rs); q.w = pg8::pk4_fp8(f[12] * rs, f[13] * rs, f[14] * rs, f[15] * rs);
            *((GAS v4u*)(mix8 + (size_t)m * DM) + lane) = q; }
        else { p[0] = oa; p[1] = ob; }
    }
}
__device__ __forceinline__ void scan_job(int b, int h, const float* lf_in, const float* ss, const float* fdp, float fbias_h, float* c2, LAS float* scr, int tid, int lane, int wave) {
    const size_t row0 = (size_t)b * S + 8 * tid;
    float v[8];
    if (lf_in) { const f32x4 a = *(const f32x4*)(lf_in + (size_t)h * M + row0), c = *(const f32x4*)(lf_in + (size_t)h * M + row0 + 4); v[0] = a[0]; v[1] = a[1]; v[2] = a[2]; v[3] = a[3]; v[4] = c[0]; v[5] = c[1]; v[6] = c[2]; v[7] = c[3]; }
    else {
#pragma unroll
        for (int i = 0; i < 8; ++i) { const f32x4* sp = (const f32x4*)(ss + (row0 + i) * 16); const f32x4* fp = (const f32x4*)(fdp + (row0 + i) * 64 + h * 16);
            const f32x4 s0 = sp[0], s1 = sp[1], s2 = sp[2], s3 = sp[3], f0 = fp[0], f1 = fp[1], f2 = fp[2], f3 = fp[3];
            const float s = ((s0[0] + s0[1]) + (s0[2] + s0[3])) + ((s1[0] + s1[1]) + (s1[2] + s1[3])) + ((s2[0] + s2[1]) + (s2[2] + s2[3])) + ((s3[0] + s3[1]) + (s3[2] + s3[3]));
            const float fd = ((f0[0] + f0[1]) + (f0[2] + f0[3])) + ((f1[0] + f1[1]) + (f1[2] + f1[3])) + ((f2[0] + f2[1]) + (f2[2] + f2[3])) + ((f3[0] + f3[1]) + (f3[2] + f3[3]));
            const float z = fd * (1.0f / sqrtf(s * (1.0f / DM) + EPS)) + fbias_h;
            v[i] = fminf(z, 0.f) - log1pf(expf(-fabsf(z))); }
    }
#pragma unroll
    for (int i = 1; i < 8; ++i) v[i] += v[i - 1];
    const float tot = v[7]; float inc = tot;
#pragma unroll
    for (int o = 1; o < 64; o <<= 1) { const float y = __shfl_up(inc, o); if (lane >= o) inc += y; }
    if (lane == 63) scr[wave] = inc;
    __syncthreads();
    float pre = inc - tot;
#pragma unroll
    for (int w = 0; w < NWAVES; ++w) pre += (w < wave) ? scr[w] : 0.f;
    f32x4* dst = (f32x4*)(c2 + (size_t)(b * 4 + h) * S + 8 * tid);
    dst[0] = (f32x4){v[0] + pre, v[1] + pre, v[2] + pre, v[3] + pre} * LOG2E; dst[1] = (f32x4){v[4] + pre, v[5] + pre, v[6] + pre, v[7] + pre} * LOG2E;
    __syncthreads();
}

__device__ __forceinline__ float dot_row(const bf16* krow, const float (&q)[64]) {
    const GAS v4u* p = (const GAS v4u*)krow; float s = 0.f;
#pragma unroll
    for (int i = 0; i < 8; ++i) { const v4u w = p[i];
        s = fmaf(q[8 * i + 0], bflo(w.x), s); s = fmaf(q[8 * i + 1], bfhi(w.x), s); s = fmaf(q[8 * i + 2], bflo(w.y), s); s = fmaf(q[8 * i + 3], bfhi(w.y), s);
        s = fmaf(q[8 * i + 4], bflo(w.z), s); s = fmaf(q[8 * i + 5], bfhi(w.z), s); s = fmaf(q[8 * i + 6], bflo(w.w), s); s = fmaf(q[8 * i + 7], bfhi(w.w), s); }
    return s;
}
__device__ __forceinline__ void axpy_row(const bf16* vrow, float a, float p, float (&o)[64]) {
    const GAS v4u* q = (const GAS v4u*)vrow;
#pragma unroll
    for (int i = 0; i < 8; ++i) { const v4u w = q[i];
        o[8 * i + 0] = fmaf(p, bflo(w.x), o[8 * i + 0] * a); o[8 * i + 1] = fmaf(p, bfhi(w.x), o[8 * i + 1] * a); o[8 * i + 2] = fmaf(p, bflo(w.y), o[8 * i + 2] * a); o[8 * i + 3] = fmaf(p, bfhi(w.y), o[8 * i + 3] * a);
        o[8 * i + 4] = fmaf(p, bflo(w.z), o[8 * i + 4] * a); o[8 * i + 5] = fmaf(p, bfhi(w.z), o[8 * i + 5] * a); o[8 * i + 6] = fmaf(p, bflo(w.w), o[8 * i + 6] * a); o[8 * i + 7] = fmaf(p, bfhi(w.w), o[8 * i + 7] * a); }
}
#define NV_STEP(KEY, BIAS2, VALID) do { if (VALID) { \
        const bf16* kr_ = qkv + (rowb + (size_t)(KEY)) * QP; \
        const float s_ = dot_row(kr_ + kcol, q) + (BIAS2); \
        const float mn_ = fmaxf(m, s_), a_ = EX2(m - mn_), p_ = EX2(s_ - mn_); l = l * a_ + p_; m = mn_; \
        axpy_row(kr_ + vcol, a_, p_, o); } } while (0)
__device__ __forceinline__ void attn_naive_item(int type, int b, int h, int chunk, const bf16* qkv, bf16* mix, const float* biasT, const float* c2, const float* kmean, const float* sinks_l, int lane) {
    const int t0 = chunk * 64, t = t0 + lane; const size_t rowb = (size_t)b * S;
    int qcol, kcol, vcol;
    if (type == 0) { qcol = C_QA + 64 * h; kcol = C_KA + 64 * h; vcol = C_VA + 64 * h; }
    else if (type == 1) { qcol = C_QB + 64 * h; kcol = C_KB + 64 * h; vcol = C_VB + 64 * h; }
    else if (type == 2) { qcol = C_QC + 64 * h; kcol = C_KC + 64 * (h >> 1); vcol = C_VC + 64 * (h >> 1); }
    else { qcol = C_QD + 64 * h; kcol = C_KD + 64 * h; vcol = C_VD + 64 * h; }
    float q[64], o[64];
    { const GAS v4u* p = (const GAS v4u*)(qkv + (rowb + t) * QP + qcol);
#pragma unroll
      for (int i = 0; i < 8; ++i) { const v4u w = p[i]; q[8 * i] = bflo(w.x); q[8 * i + 1] = bfhi(w.x); q[8 * i + 2] = bflo(w.y); q[8 * i + 3] = bfhi(w.y); q[8 * i + 4] = bflo(w.z); q[8 * i + 5] = bfhi(w.z); q[8 * i + 6] = bflo(w.w); q[8 * i + 7] = bfhi(w.w); } }
#pragma unroll
    for (int d = 0; d < 64; ++d) o[d] = 0.f;
    float m = -1e30f, l = 0.f;
    if (type == 0) {
        const float* bt = biasT + h * 4096;
        for (int g = 0; g < 3; ++g) { const int dil = g == 0 ? 1 : g == 1 ? 4 : 16;
            for (int jj = 0; jj <= 128; ++jj) { const int key = t - dil * jj; const bool valid = key >= 0; const float b2 = bt[jj * dil]; NV_STEP(valid ? key : 0, b2, valid); } }
    } else if (type == 1) {
        const float* bt = biasT + (4 + h) * 4096; const int own = t0 >> 8;
        float g[16];
#pragma unroll
        for (int n = 0; n < 16; ++n) { g[n] = -INFINITY; if (n < own) { const float* km = kmean + ((size_t)(b * 4 + h) * 16 + n) * 64; float s = 0.f;
#pragma unroll
                for (int d = 0; d < 64; ++d) s = fmaf(q[d], km[d], s);
                g[n] = s; } }
        unsigned sel = 0u;
#pragma unroll
        for (int r = 0; r < 3; ++r) { float best = -INFINITY; int bi = -1;
#pragma unroll
            for (int n = 0; n < 16; ++n) if (n < own && !((sel >> n) & 1u) && g[n] > best) { best = g[n]; bi = n; }
            if (bi >= 0) sel |= 1u << bi; }
        for (int n = 0; n < own; ++n) { const bool pick = (sel >> n) & 1u;
            if (__ballot(pick) != 0ull) for (int i = 0; i < 256; ++i) { const int key = n * 256 + i; NV_STEP(key, bt[t - key], pick); } }
        for (int key = own * 256; key <= t0 + 63; ++key) { const bool valid = key <= t; NV_STEP(key, bt[valid ? t - key : 0], valid); }
    } else if (type == 2) {
        const float* bt = biasT + (8 + h) * 4096; const int jlo = t0 - 127 > 0 ? t0 - 127 : 0;
        for (int key = jlo; key <= t0 + 63; ++key) { const int dist = t - key; const bool valid = dist >= 0 && dist <= 127; NV_STEP(key, bt[valid ? dist : 0], valid); }
        l += EX2(sinks_l[h] * LOG2E - m);
    } else {
        const float* cc = c2 + (size_t)(b * 4 + h) * S; const float ct = cc[t];
        for (int key = 0; key <= t0 + 63; ++key) { const bool valid = key <= t; NV_STEP(key, ct - cc[key], valid); }
    }
    const float inv = 1.0f / l;
    GAS v4u* op = (GAS v4u*)(mix + (rowb + t) * DM + type * 256 + h * 64);
#pragma unroll
    for (int i = 0; i < 8; ++i) { v4u w; w.x = pk2(o[8 * i] * inv, o[8 * i + 1] * inv); w.y = pk2(o[8 * i + 2] * inv, o[8 * i + 3] * inv); w.z = pk2(o[8 * i + 4] * inv, o[8 * i + 5] * inv); w.w = pk2(o[8 * i + 6] * inv, o[8 * i + 7] * inv); op[i] = w; }
}
__device__ __forceinline__ void attn_naive_phase(const bf16* qkv, bf16* mix, const float* biasT, const float* c2, const float* kmean, const float* sinks_l, int gw, int NGW, int lane) {
    for (int idx = gw; idx < 4 * NB * 4 * 64; idx += NGW) {
        const int chunk = 63 - (idx >> 7), rem = idx & 127, type = rem >> 5, bh = rem & 31;
        if ((ATT_MFMA_MASK >> type) & 1) continue;
        attn_naive_item(type, bh >> 2, bh & 3, chunk, qkv, mix, biasT, c2, kmean, sinks_l, lane);
    }
}

__device__ __forceinline__ void attn_mfma_phase(LAS unsigned char* lds, unsigned char* ws, const float* sinks_l, int l, int c, int G) {
    int cur_tab = -1, cur_tab2 = -1, cur_tab3 = -1;
#define ATT_OPAQUE() int b = b0_, h = h0_, hs = hs0_; asm volatile("" : "+s"(b), "+s"(h), "+s"(hs)); \
        const bf16* qkv = (const bf16*)(ws + WS_QKV); bf16* mix = (bf16*)(ws + WS_MIX); const float* biasT = (const float*)(ws + WS_BIAST)
    for (int v = c; v < 256; v += G) {
        const int b0_ = (v & 31) >> 2, h0_ = v & 3, hs0_ = v >> 5;
        for (int j = 0; j < 2; ++j) {
            if ((ATT_MFMA_MASK >> 1) & 1) for (int d_ = 0; d_ < ADUP(1); ++d_) { ATT_OPAQUE(); const int qb = j ? hs : 15 - hs;
                if ((ATT2_MASK >> 1) & 1) att2::attn_unit2<att2::T_B>(lds, qkv, b, h, qb, biasT + (4 + h) * 4096, 4 + h, cur_tab2, nullptr, nullptr, (const float*)(ws + WS_CTL) + CW_KMEAN + (size_t)l * 32768 + (size_t)(b * 4 + h) * 16 * 64, mix + 256 + 64 * h, DM);
                else att::attn_item<att::T_B>(lds, qkv, b, h, qb, 0, 1, 0, 0, 0, 0, biasT + (4 + h) * 4096, 4 + h, cur_tab, nullptr, nullptr, (const float*)(ws + WS_CTL) + CW_KMEAN + (size_t)l * 32768 + (size_t)(b * 4 + h) * 16 * 64, 0.f, mix + 256 + 64 * h, DM, nullptr); }
            if ((ATT_MFMA_MASK >> 3) & 1) for (int d_ = 0; d_ < ADUP(3); ++d_) { ATT_OPAQUE(); const int qb = j ? hs : 15 - hs; if (j) h = (h + 2) & 3;
                if ((ATT2_MASK >> 3) & 1) att2::attn_unit2<att2::T_D>(lds, qkv, b, h, qb, nullptr, -1, cur_tab2, (const float*)(ws + WS_C2) + (size_t)(b * 4 + h) * S, (const unsigned*)(ws + WS_CTL) + CW_NORM + 128 * l + (b * 4 + h) * 4, nullptr, mix + 768 + 64 * h, DM);
                else att::attn_item<att::T_D>(lds, qkv, b, h, qb, 0, 1, 0, 0, 0, 0, nullptr, -1, cur_tab, (const float*)(ws + WS_C2) + (size_t)(b * 4 + h) * S, (const unsigned*)(ws + WS_CTL) + CW_NORM + 128 * l + (b * 4 + h) * 4, nullptr, 0.f, mix + 768 + 64 * h, DM, nullptr); }
        }
        if ((ATT_MFMA_MASK & 5) == 5) for (int d_ = 0; d_ < ADUP(0); ++d_) {
#define A3_GEOM(J) const int cls_ = (J) >> 1, rest_ = 2 * hs + ((J) & 1); const int dil_ = cls_ <= 1 ? 1 : cls_ == 2 ? 4 : 16, qb_ = cls_ <= 1 ? rest_ : cls_ == 2 ? rest_ >> 2 : 0, res_ = cls_ <= 1 ? 0 : cls_ == 2 ? rest_ & 3 : rest_; const bool swa_ = cls_ == 0
#define A3_SRC(J, OUT) do { A3_GEOM(J); const bf16* rb_ = qkv + ((size_t)b * S + res_) * QP; OUT.k = rb_ + (swa_ ? C_KC + 64 * (h >> 1) : C_KA + 64 * h); OUT.v = rb_ + (swa_ ? C_VC + 64 * (h >> 1) : C_VA + 64 * h); OUT.rs = dil_ * QP; OUT.kw = 256 * qb_ - 128; OUT.tmin = qb_ == 0 ? 2 : 0; } while (0)
            att3::BandSrc cur_, nx_; nx_.k = nullptr; nx_.v = nullptr; nx_.rs = 0; nx_.kw = 0; nx_.tmin = 0;
            { ATT_OPAQUE(); A3_SRC(0, cur_); const int wid_ = __builtin_amdgcn_readfirstlane(threadIdx.x >> 6), lane_ = threadIdx.x & 63; const unsigned l0_ = (unsigned)(uintptr_t)lds;
              att3::band_dma(l0_ + att3::L_K, cur_.k, cur_.rs, cur_.kw, cur_.tmin, false, wid_, lane_); att3::band_dma(l0_ + att3::L_V, cur_.v, cur_.rs, cur_.kw, cur_.tmin, true, wid_, lane_); }
            for (int j8 = 0; j8 < 8; ++j8) { ATT_OPAQUE();
                A3_GEOM(j8); const size_t g = (size_t)(cls_ - 1);
                if (j8 < 7) A3_SRC(j8 + 1, nx_);
#define A3_CALL(D) att3::attn_band<D>(lds, qkv, b, h, qb_, res_, swa_ ? 127 : 128, (swa_ ? C_QC : C_QA) + 64 * h, swa_ ? C_KC + 64 * (h >> 1) : C_KA + 64 * h, swa_ ? C_VC + 64 * (h >> 1) : C_VA + 64 * h, \
                    biasT + ((swa_ ? 8 : 0) + h) * 4096, cls_ * 4 + h, cur_tab3, swa_ ? sinks_l[h] * LOG2E : -INFINITY, \
                    swa_ ? mix + 512 + 64 * h : (bf16*)(ws + WS_PA) + g * M * 256 + 64 * h, swa_ ? DM : 256, swa_ ? nullptr : (float*)(ws + WS_LSE) + g * M * 4 + h, nx_, j8 < 7)
                if (dil_ == 1) A3_CALL(1); else if (dil_ == 4) A3_CALL(4); else A3_CALL(16);
#undef A3_CALL
                cur_ = nx_;
            }
#undef A3_GEOM
#undef A3_SRC
        }
    }
#undef ATT_OPAQUE
}

struct Args { const float* in[13]; float* out; unsigned char* ws; int ph_lo, ph_hi, li, pad; };
__global__ void __launch_bounds__(NWAVES * 64, 2) hybrid_fwd(Args args) {
    extern __shared__ __attribute__((aligned(16))) unsigned char lds_raw[];
    LAS unsigned char* lds = (LAS unsigned char*)lds_raw;
    volatile LAS unsigned* MISC = (volatile LAS unsigned*)(lds + MISC_OFF);
    const int tid = threadIdx.x, lane = tid & 63, wave = __builtin_amdgcn_readfirstlane(tid >> 6);
    const int G = gridDim.x; const int bx = blockIdx.x; const int vcu = (G % 8 == 0) ? (bx % 8) * (G / 8) + bx / 8 : bx;
    const int gw = vcu * NWAVES + wave, NGW = G * NWAVES;
    Ptrs P;
    P.x = args.in[0]; P.norm1_g = args.in[1]; P.w_in = args.in[2]; P.f_bias = args.in[3]; P.sinks = args.in[4]; P.mix_g = args.in[5]; P.w_out = args.in[6];
    P.norm2_g = args.in[7]; P.w_gate = args.in[8]; P.w_up = args.in[9]; P.w_down = args.in[10]; P.rel_bias = args.in[11]; P.final_g = args.in[12];
    P.out = args.out; P.ws = args.ws;
    unsigned char* ws = args.ws;
    gu32* ctl = (gu32*)(ws + WS_CTL);
    bf16* XB = (bf16*)(ws + WS_XB); bf16* MIX = (bf16*)(ws + WS_MIX); bf16* QKV = (bf16*)(ws + WS_QKV); bf16* ACT = (bf16*)(ws + WS_QKV);
    float* SSB = (float*)(ws + WS_SS); float* FDB = (float*)(ws + WS_FD); float* LF = (float*)(ws + WS_LF); float* CC2 = (float*)(ws + WS_C2); float* KMEAN = (float*)(ws + WS_KMEAN);
    const float* BIAST = (const float*)(ws + WS_BIAST);
    for (int u = tid; u < (LDS_BYTES - LDSCTL_OFF) / 4; u += NWAVES * 64) ((LAS unsigned*)(lds + LDSCTL_OFF))[u] = 0u;
    __syncthreads();
    XcdBarrier bar; bar.bar = (unsigned*)(ctl + CW_BAR) + args.li * XCD_BAR_WORDS; bar.x = 0; bar.st = nullptr;
    if (N_LAUNCHES == 1) bar = xcd_barrier_post((unsigned*)(ctl + CW_BAR) + args.li * XCD_BAR_WORDS, MISC + 8);
    const int lo = args.ph_lo, hi = args.ph_hi;
#define IN(k) (lo <= (k) && (k) < hi)
#define SEAM(k) do { if (IN(k) && IN((k) + 1)) { if (N_LAUNCHES == 1) xcd_barrier(bar); } } while (0)

    if (IN(0)) {
        phase_prep(P, lds, 0, (G == 256) ? 1 : DEPTH, true, gw, NGW, wave, lane);
        __syncthreads();
        { LAS float* wl = (LAS float*)(lds + RING_OFF); for (int i = tid; i < DM * 4; i += NWAVES * 64) { const int k = i >> 2, h = i & 3; wl[i] = P.norm1_g[k] * P.w_in[(size_t)k * NIN + 2816 + h]; } }
        __syncthreads();
        row_pass<true>(P.x, XB, SSB, (const LAS float*)(lds + RING_OFF), P.f_bias, LF, gw, NGW, lane);
        SEAM(0);
    }

    { constexpr int l = 0;
    {
        const int pb = 1 + PH_PER_LAYER * l;
        if (IN(pb + 0)) {
            pg8::Gemm g{XB, (const bf16*)(ws + WS_WIN) + (size_t)l * QP * DM, M, QP, DM}; pg8::StaticOrder So; So.init(M, QP, G, bx);
            pg8::EpiQKV E{QKV, QP, SSB, C2, (LAS float*)(lds + LDSCTL_OFF + 1024), (float*)(ctl + CW_KMEAN) + (size_t)l * 32768, (unsigned*)(ctl + CW_NORM + 128 * l)};
            pg8::rstd_table((LAS float*)(lds + LDSCTL_OFF + 1024), SSB, So);
            pg8::gemm_phase<pg8::EpiQKV, pg8::StaticOrder, PG8_ALIGN, PG8_SP2>(lds + RING_OFF, g, So, E);
            for (int j = bx; j < 32 + 128; j += G) if (j >= 128) { const int bh = j - 128;
                scan_job(bh >> 2, bh & 3, l == 0 ? LF : nullptr, SSB, FDB, P.f_bias[l * 4 + (bh & 3)], CC2, (LAS float*)(lds + LDSCTL_OFF + 1024), tid, lane, wave); }
            if (l == 0 && G == 256 && bx >= 128) phase_prep(P, lds, 1, DEPTH, false, (bx - 128) * NWAVES + wave, 128 * NWAVES, wave, lane);
            SEAM(pb + 0);
        }
        if (IN(pb + 1)) {
            if (ATT_MFMA_MASK != 15) attn_naive_phase(QKV, MIX, BIAST, CC2, KMEAN, P.sinks + l * 4, gw, NGW, lane);
            if (ATT_MFMA_MASK != 0) { __syncthreads(); attn_mfma_phase(lds + RING_OFF, ws, P.sinks + l * 4, l, bx, G); }
            SEAM(pb + 1); }
        if (IN(pb + 2)) { mixnorm_pass(MIX, ws + WS_MIX8, (const bf16*)(ws + WS_PA), (const float*)(ws + WS_LSE), gw, NGW, lane); SEAM(pb + 2); }
        if (IN(pb + 3)) {
            pg8::Gemm g{G2_FP8 ? (const bf16*)(ws + WS_MIX8) : MIX, G2_FP8 ? (const bf16*)(ws + WS_WOUT + (size_t)l * DM * DM) : (const bf16*)(ws + WS_WOUT) + (size_t)l * DM * DM, M, DM, DM}; pg8::StaticOrder So; So.init(M, DM, G, bx);
            pg8::EpiResidX E{XB, SSB, nullptr, nullptr, DM, G2_FP8 ? 1.0f / WSCALE : 1.0f, ws + WS_X8};
            pg8::gemm_phase<pg8::EpiResidX, pg8::StaticOrder, PG8_ALIGN, PG8_SP2, (G2_FP8 != 0)>(lds + RING_OFF, g, So, E);
            SEAM(pb + 3);
        }
        if (IN(pb + 4)) {
            pg8::Gemm g{(const bf16*)(ws + WS_X8), (const bf16*)(ws + WS_WGU + (size_t)l * NGU * DM), M, NGU, DM}; pg8::StaticOrder So; So.init(M, NGU, G, bx);
            pg8::EpiSwiGLU E{(unsigned char*)ACT, DFF, SSB, (LAS float*)(lds + LDSCTL_OFF + 1024), 1.0f / WSCALE, ASCALE};
            pg8::rstd_table((LAS float*)(lds + LDSCTL_OFF + 1024), SSB, So);
            pg8::gemm_phase<pg8::EpiSwiGLU, pg8::StaticOrder, PG8_ALIGN, PG8_SP2, true>(lds + RING_OFF, g, So, E);
            SEAM(pb + 4);
        }
        if (IN(pb + 5)) {
            pg8::Gemm g{ACT, (const bf16*)(ws + WS_WDN + (size_t)l * DM * DFF), M, DM, DFF}; pg8::StaticOrder So; So.init(M, DM, G, bx);
            pg8::EpiResidX E{XB, SSB, (l + 1 < DEPTH) ? (const unsigned*)(ws + WS_WFD) + (size_t)(l + 1) * (DM / 2) * 4 : nullptr, FDB, DM, 1.0f / (WSCALE * ASCALE), nullptr};
            pg8::gemm_phase<pg8::EpiResidX, pg8::StaticOrder, PG8_ALIGN, PG8_SP2, true>(lds + RING_OFF, g, So, E);
            SEAM(pb + 5);
        }
    }
    }
    { constexpr int l = 1;
    {
        const int pb = 1 + PH_PER_LAYER * l;
        if (IN(pb + 0)) {
            pg8::Gemm g{XB, (const bf16*)(ws + WS_WIN) + (size_t)l * QP * DM, M, QP, DM}; pg8::StaticOrder So; So.init(M, QP, G, bx);
            pg8::EpiQKV E{QKV, QP, SSB, C2, (LAS float*)(lds + LDSCTL_OFF + 1024), (float*)(ctl + CW_KMEAN) + (size_t)l * 32768, (unsigned*)(ctl + CW_NORM + 128 * l)};
            pg8::rstd_table((LAS float*)(lds + LDSCTL_OFF + 1024), SSB, So);
            pg8::gemm_phase<pg8::EpiQKV, pg8::StaticOrder, PG8_ALIGN, PG8_SP2>(lds + RING_OFF, g, So, E);
            for (int j = bx; j < 32 + 128; j += G) if (j >= 128) { const int bh = j - 128;
                scan_job(bh >> 2, bh & 3, l == 0 ? LF : nullptr, SSB, FDB, P.f_bias[l * 4 + (bh & 3)], CC2, (LAS float*)(lds + LDSCTL_OFF + 1024), tid, lane, wave); }
            if (l == 0 && G == 256 && bx >= 128) phase_prep(P, lds, 1, DEPTH, false, (bx - 128) * NWAVES + wave, 128 * NWAVES, wave, lane);
            SEAM(pb + 0);
        }
        if (IN(pb + 1)) {
            if (ATT_MFMA_MASK != 15) attn_naive_phase(QKV, MIX, BIAST, CC2, KMEAN, P.sinks + l * 4, gw, NGW, lane);
            if (ATT_MFMA_MASK != 0) { __syncthreads(); attn_mfma_phase(lds + RING_OFF, ws, P.sinks + l * 4, l, bx, G); }
            SEAM(pb + 1); }
        if (IN(pb + 2)) { mixnorm_pass(MIX, ws + WS_MIX8, (const bf16*)(ws + WS_PA), (const float*)(ws + WS_LSE), gw, NGW, lane); SEAM(pb + 2); }
        if (IN(pb + 3)) {
            pg8::Gemm g{G2_FP8 ? (const bf16*)(ws + WS_MIX8) : MIX, G2_FP8 ? (const bf16*)(ws + WS_WOUT + (size_t)l * DM * DM) : (const bf16*)(ws + WS_WOUT) + (size_t)l * DM * DM, M, DM, DM}; pg8::StaticOrder So; So.init(M, DM, G, bx);
            pg8::EpiResidX E{XB, SSB, nullptr, nullptr, DM, G2_FP8 ? 1.0f / WSCALE : 1.0f, ws + WS_X8};
            pg8::gemm_phase<pg8::EpiResidX, pg8::StaticOrder, PG8_ALIGN, PG8_SP2, (G2_FP8 != 0)>(lds + RING_OFF, g, So, E);
            SEAM(pb + 3);
        }
        if (IN(pb + 4)) {
            pg8::Gemm g{(const bf16*)(ws + WS_X8), (const bf16*)(ws + WS_WGU + (size_t)l * NGU * DM), M, NGU, DM}; pg8::StaticOrder So; So.init(M, NGU, G, bx);
            pg8::EpiSwiGLU E{(unsigned char*)ACT, DFF, SSB, (LAS float*)(lds + LDSCTL_OFF + 1024), 1.0f / WSCALE, ASCALE};
            pg8::rstd_table((LAS float*)(lds + LDSCTL_OFF + 1024), SSB, So);
            pg8::gemm_phase<pg8::EpiSwiGLU, pg8::StaticOrder, PG8_ALIGN, PG8_SP2, true>(lds + RING_OFF, g, So, E);
            SEAM(pb + 4);
        }
        if (IN(pb + 5)) {
            pg8::Gemm g{ACT, (const bf16*)(ws + WS_WDN + (size_t)l * DM * DFF), M, DM, DFF}; pg8::StaticOrder So; So.init(M, DM, G, bx);
            pg8::EpiResidX E{XB, SSB, (l + 1 < DEPTH) ? (const unsigned*)(ws + WS_WFD) + (size_t)(l + 1) * (DM / 2) * 4 : nullptr, FDB, DM, 1.0f / (WSCALE * ASCALE), nullptr};
            pg8::gemm_phase<pg8::EpiResidX, pg8::StaticOrder, PG8_ALIGN, PG8_SP2, true>(lds + RING_OFF, g, So, E);
            SEAM(pb + 5);
        }
    }
    }
    if (IN(NPHASE - 1)) final_pass(XB, P.out, P.final_g, SSB, gw, NGW, lane);
#undef IN
#undef SEAM
}

extern "C" void kernel_launch(void* const* d_in, const int* in_sizes, int n_in, void* d_out, int out_size, void* d_ws, size_t ws_size, hipStream_t stream) {
    static int grid = 0;
    if (grid == 0) {
        if (n_in != 13 || in_sizes[0] != M * DM || out_size != M * DM || ws_size < WS_END) { fprintf(stderr, "kernel_launch: unexpected shapes (n_in %d, in0 %d, out %d, ws %zu); nothing launched\n", n_in, n_in > 0 ? in_sizes[0] : -1, out_size, ws_size); grid = -1; return; }
        int dev = 0, cus = 0, per_cu = 0;
        if (hipGetDevice(&dev) != hipSuccess || hipDeviceGetAttribute(&cus, hipDeviceAttributeMultiprocessorCount, dev) != hipSuccess) { fprintf(stderr, "kernel_launch: device query failed\n"); grid = -1; return; }
        if (hipFuncSetAttribute((const void*)hybrid_fwd, hipFuncAttributeMaxDynamicSharedMemorySize, LDS_BYTES) != hipSuccess) { fprintf(stderr, "kernel_launch: hipFuncSetAttribute failed\n"); grid = -1; return; }
        if (hipOccupancyMaxActiveBlocksPerMultiprocessor(&per_cu, (const void*)hybrid_fwd, NWAVES * 64, LDS_BYTES) != hipSuccess || per_cu < 1)
            fprintf(stderr, "kernel_launch: note: occupancy query reports %d workgroups per CU\n", per_cu);
        (void)hipGetLastError();
        grid = cus;
    }
    if (grid < 0) return;
    if (hipMemsetAsync((char*)d_ws + WS_CTL, 0, CTL_ZERO_BYTES, stream) != hipSuccess) { fprintf(stderr, "kernel_launch: hipMemsetAsync failed\n"); return; }
    Args a{};
    for (int i = 0; i < 13; ++i) a.in[i] = (const float*)d_in[i];
    a.out = (float*)d_out; a.ws = (unsigned char*)d_ws;
    const int n_l = (PROBE_PHASE >= 0) ? 3 : N_LAUNCHES;
    for (int li = 0; li < n_l; ++li) {
        if (PROBE_PHASE >= 0) { a.ph_lo = li == 0 ? 0 : li == 1 ? PROBE_PHASE : PROBE_PHASE + 1; a.ph_hi = li == 0 ? PROBE_PHASE + 1 : li == 1 ? PROBE_PHASE + 1 : NPHASE; a.li = li; if (a.ph_lo >= a.ph_hi) continue; }
        else { a.ph_lo = (N_LAUNCHES == 1) ? 0 : li; a.ph_hi = (N_LAUNCHES == 1) ? NPHASE : li + 1; a.li = (N_LAUNCHES == 1) ? 0 : li; }
        hipLaunchKernelGGL(hybrid_fwd, dim3(grid), dim3(NWAVES * 64), LDS_BYTES, stream, a);
        const hipError_t le = hipPeekAtLastError();
        if (le != hipSuccess) { fprintf(stderr, "kernel_launch: launch %d failed: %s\n", li, hipGetErrorName(le)); break; }
    }
}
```

```cpp
#include <hip/hip_runtime.h>
#include <cstdio>
#include <cstdint>
#ifndef MK_N_LAUNCHES
#define MK_N_LAUNCHES 1
#endif
#define EX2(x) __builtin_amdgcn_exp2f(x)
#ifndef ATT_MFMA_MASK
#define ATT_MFMA_MASK 15
#endif
#ifndef DUP_MASK
#define DUP_MASK 0
#endif
#define DUPN(k) ((((DUP_MASK) >> (k)) & 1) + 1)
#ifndef ATT_DUP_TYPES
#define ATT_DUP_TYPES 0
#endif
#define ADUP(t) ((((ATT_DUP_TYPES) >> (t)) & 1) + 1)
#ifndef PROBE_PHASE
#define PROBE_PHASE -1
#endif
#ifndef ATT2_MASK
#define ATT2_MASK 10
#endif
#ifndef ATT3_ON
#define ATT3_ON 1
#endif
#ifndef RESID_PF
#define RESID_PF 8
#endif
#ifndef RESID_PF_FD
#define RESID_PF_FD 8
#endif
#ifndef DRY_MASK
#define DRY_MASK 0
#endif
#ifndef G2_FP8
#define G2_FP8 0
#endif
namespace pg8 {
#define PG8_LAS __attribute__((address_space(3)))
typedef unsigned short bf16_t;
typedef short bf16x8 __attribute__((ext_vector_type(8)));
typedef float f32x4 __attribute__((ext_vector_type(4)));
typedef unsigned u32x4 __attribute__((ext_vector_type(4)));
typedef int i32x4_t __attribute__((ext_vector_type(4)));
typedef int i32x8_t __attribute__((ext_vector_type(8)));
constexpr int BM = 256, BK = 64, HALF = 128, HTB = HALF * BK * 2  , STAGE_BYTES = 8 * HTB, NXCD = 8, WGM = 8;

__host__ __device__ __forceinline__ int lds_byte(int r, int c) { const int st = (r >> 4) * 2 + (c >> 5), rr = r & 15, cc = c & 31, ob = rr * 64 + cc * 2; return st * 1024 + (ob ^ (((ob >> 9) & 1) << 5)); }
__host__ __device__ __forceinline__ void stage_rc(int b, int& R, int& C) { const int st = b / 1024, sb = b % 1024, swz = sb ^ (((sb >> 9) & 1) << 5); R = (st >> 1) * 16 + swz / 64; C = (st & 1) * 32 + (swz % 64) / 2; }
__host__ __device__ __forceinline__ int perm32(int rho) { const int n = rho >> 4, i = rho & 15; return 8 * (i >> 2) + 4 * n + (i & 3); }

struct Unit { int pm, pn, ui; };
struct Gemm { const bf16_t* A; const bf16_t* Bt; int M, N, K; };

struct StaticOrder {
    int nM, nN, nwg, G, c;
    __host__ __device__ void init(int M, int N, int G_, int c_) { nM = M / BM; nN = N / BM; nwg = nM * nN; G = G_; c = c_; }
    __host__ __device__ bool next(int i, Unit& u) const {
        const long L = (long)i * G + c; if (L >= nwg) return false;
        int wgid = (int)L; { const int q = nwg / NXCD, r = nwg % NXCD, xcd = wgid % NXCD, off = wgid / NXCD; wgid = (xcd < r ? xcd * (q + 1) : r * (q + 1) + (xcd - r) * q) + off; }
        const int nig = WGM * nN, gid = wgid / nig, fm = gid * WGM, gsz = (nM - fm) < WGM ? (nM - fm) : WGM;
        u.pm = fm + ((wgid % nig) % gsz); u.pn = (wgid % nig) / gsz; u.ui = i; return true;
    }
    __device__ __forceinline__ void a_ready(const Unit&) const {}
    __device__ __forceinline__ void done(const Unit&) const {}
};

__device__ __forceinline__ unsigned cvt_pk_bf16(float lo, float hi) { unsigned r; asm volatile("v_cvt_pk_bf16_f32 %0, %1, %2" : "=v"(r) : "v"(lo), "v"(hi)); return r; }

#ifndef WT_STORES
#define WT_STORES 0
#endif
__device__ __forceinline__ void st16_wt(void* p, u32x4 v) {
#if WT_STORES
    asm volatile("global_store_dwordx4 %0, %1, off sc1\n\ts_nop 1" :: "v"(p), "v"(v) : "memory");
#else
    *(u32x4*)p = v;
#endif
}
typedef unsigned u32x2_t __attribute__((ext_vector_type(2)));
__device__ __forceinline__ void st8_wt(void* p, u32x2_t v) {
#if WT_STORES
    asm volatile("global_store_dwordx2 %0, %1, off sc1\n\ts_nop 1" :: "v"(p), "v"(v) : "memory");
#else
    *(u32x2_t*)p = v;
#endif
}
__device__ __forceinline__ unsigned pk4_fp8(float a, float b, float c, float d) {
    a = __builtin_amdgcn_fmed3f(a, -448.f, 448.f); b = __builtin_amdgcn_fmed3f(b, -448.f, 448.f); c = __builtin_amdgcn_fmed3f(c, -448.f, 448.f); d = __builtin_amdgcn_fmed3f(d, -448.f, 448.f);
    unsigned w = __builtin_amdgcn_cvt_pk_fp8_f32(a, b, 0u, false); return __builtin_amdgcn_cvt_pk_fp8_f32(c, d, w, true);
}
__device__ __forceinline__ float rstd_from_slots(const float* ss, int r) {
    const f32x4* p = (const f32x4*)(ss + (size_t)r * 16); const f32x4 a = p[0], b = p[1], c = p[2], d = p[3];
    const float s = ((a[0] + a[1]) + (a[2] + a[3])) + ((b[0] + b[1]) + (b[2] + b[3])) + ((c[0] + c[1]) + (c[2] + c[3])) + ((d[0] + d[1]) + (d[2] + d[3]));
    return 1.0f / sqrtf(s * (1.0f / 1024.0f) + 1e-6f);
}

template <class Sched> __device__ __forceinline__ void rstd_table(PG8_LAS float* tbl, const float* ss, const Sched& S) {
    Unit u;
    for (int i = 0; S.next(i, u); ++i) { if (threadIdx.x < 256) tbl[i * 256 + threadIdx.x] = rstd_from_slots(ss, u.pm * BM + (int)threadIdx.x); }
    __syncthreads();
}
struct EpiQKV {
    static constexpr bool PERM = true, AFTER_DRAIN = false;
    bf16_t* O; int ldc; const float* rstd; float qscale; PG8_LAS float* rsl;
    float* kmean; unsigned* nrm;
    __device__ __forceinline__ void operator()(const f32x4 (&acc)[2][2][4][2], const Unit& u, int wr, int wc, int fr, int fq) const {
        const int row0 = u.pm * BM + wr * 64 + fr, col0 = u.pn * BM + wc * 32 + 8 * fq;
        const float ts = (u.pn == 0 || u.pn == 3 || u.pn == 6 || u.pn == 8) ? qscale : 1.0f;
        const PG8_LAS float* sc = rsl + u.ui * 256 + wr * 64;
        const bool do_km = (u.pn == 4);
        const bool do_nrm = (u.pn == 8 || u.pn == 9);
        float cs[2][8]; float nmx[2] = {0.f, 0.f};
#pragma unroll
        for (int bj = 0; bj < 2; ++bj)
#pragma unroll
            for (int j = 0; j < 8; ++j) cs[bj][j] = 0.f;
#pragma unroll
        for (int ai = 0; ai < 2; ++ai)
#pragma unroll
            for (int m = 0; m < 4; ++m) { const int r = row0 + ai * HALF + m * 16; const float s = sc[ai * HALF + m * 16 + fr] * ts; bf16_t* rowp = O + (size_t)r * ldc + col0;
#pragma unroll
                for (int bj = 0; bj < 2; ++bj) { const f32x4 v0 = acc[ai][bj][m][0] * s, v1 = acc[ai][bj][m][1] * s;
                    u32x4 w; w.x = cvt_pk_bf16(v0[0], v0[1]); w.y = cvt_pk_bf16(v0[2], v0[3]); w.z = cvt_pk_bf16(v1[0], v1[1]); w.w = cvt_pk_bf16(v1[2], v1[3]);
                    st16_wt(rowp + bj * HALF, w);
                    if (do_km) {
#pragma unroll
                        for (int i = 0; i < 4; ++i) { cs[bj][i] += v0[i]; cs[bj][4 + i] += v1[i]; } }
                    if (do_nrm) { float q = (v0[0] * v0[0] + v0[1] * v0[1]) + (v0[2] * v0[2] + v0[3] * v0[3]) + (v1[0] * v1[0] + v1[1] * v1[1]) + (v1[2] * v1[2] + v1[3] * v1[3]);
                        q += __shfl_xor(q, 16); q += __shfl_xor(q, 32); nmx[bj] = __builtin_fmaxf(nmx[bj], q); } } }
        if (do_km) {
#pragma unroll
            for (int bj = 0; bj < 2; ++bj)
#pragma unroll
                for (int j = 0; j < 8; ++j) { float v = cs[bj][j]; v += __shfl_xor(v, 1); v += __shfl_xor(v, 2); v += __shfl_xor(v, 4); v += __shfl_xor(v, 8);
                    if (fr == 0) { const int cg = bj * HALF + wc * 32 + 8 * fq + j; atomicAdd(kmean + ((size_t)((u.pm >> 4) * 4 + (cg >> 6)) * 16 + (u.pm & 15)) * 64 + (cg & 63), v * (1.0f / 256.0f)); } }
        }
        if (do_nrm) {
#pragma unroll
            for (int bj = 0; bj < 2; ++bj) { float v = nmx[bj]; v = __builtin_fmaxf(v, __shfl_xor(v, 1)); v = __builtin_fmaxf(v, __shfl_xor(v, 2)); v = __builtin_fmaxf(v, __shfl_xor(v, 4)); v = __builtin_fmaxf(v, __shfl_xor(v, 8));
                if (fr == 0 && fq == 0) atomicMax(nrm + ((u.pm >> 4) * 4 + 2 * bj + (wc >> 1)) * 4 + (u.pn == 9 ? 2 : 0) + (wc & 1), __float_as_uint(v)); }
        }
    }
};
struct EpiResid {
    static constexpr bool PERM = false, AFTER_DRAIN = false;
    const float* base; float* out; int ldc;
    __device__ __forceinline__ void operator()(const f32x4 (&acc)[2][2][4][2], const Unit& u, int wr, int wc, int fr, int fq) const {
        const int row0 = u.pm * BM + wr * 64 + fr, col0 = u.pn * BM + wc * 32 + 4 * fq;
#pragma unroll
        for (int ai = 0; ai < 2; ++ai)
#pragma unroll
            for (int m = 0; m < 4; ++m) { const size_t off = (size_t)(row0 + ai * HALF + m * 16) * ldc + col0;
#pragma unroll
                for (int bj = 0; bj < 2; ++bj)
#pragma unroll
                    for (int n = 0; n < 2; ++n) { const f32x4 b = *(const f32x4*)(base + off + bj * HALF + n * 16); *(f32x4*)(out + off + bj * HALF + n * 16) = b + acc[ai][bj][m][n]; } }
    }
};
typedef __bf16 bf16x2_t __attribute__((ext_vector_type(2)));
__device__ __forceinline__ float dot2_bf16(unsigned a, unsigned b, float acc) { return __builtin_amdgcn_fdot2_f32_bf16(__builtin_bit_cast(bf16x2_t, a), __builtin_bit_cast(bf16x2_t, b), acc, false); }
template <class Sched> __device__ __forceinline__ void wfd_table(PG8_LAS unsigned* tbl, const unsigned* wfd, const Sched& S) {
    Unit u;
    for (int i = 0; S.next(i, u); ++i) tbl[i * 512 + threadIdx.x] = wfd[u.pn * 512 + threadIdx.x];
    __syncthreads();
}
template <bool FD, int PF> struct EpiResidX {
    static constexpr bool PERM = true, AFTER_DRAIN = false;
    bf16_t* xb; float* ss; PG8_LAS const unsigned* wl; float* fdp; int ldc; float ascale; unsigned char* x8;
    __device__ __forceinline__ void operator()(const f32x4 (&acc)[2][2][4][2], const Unit& u, int wr, int wc, int fr, int fq) const {
        const int row0 = u.pm * BM + wr * 64 + fr, col0 = u.pn * BM + wc * 32 + 8 * fq; const int slot = u.pn * 4 + wc;
        bf16_t* const base = xb + (size_t)row0 * ldc + col0;
        PG8_LAS const unsigned* wq0 = wl + u.ui * 512 + (wc * 16 + 4 * fq) * 4;
        u32x4 xw[16];
#pragma unroll
        for (int k = 0; k < PF; ++k) xw[k] = *(const u32x4*)(base + (size_t)((k >> 3) * HALF + ((k >> 1) & 3) * 16) * ldc + (k & 1) * HALF);
#pragma unroll
        for (int ai = 0; ai < 2; ++ai)
#pragma unroll
            for (int m = 0; m < 4; ++m) { const int r = row0 + ai * HALF + m * 16; bf16_t* rowp = base + (size_t)(ai * HALF + m * 16) * ldc;
                float s2 = 0.f, f0 = 0.f, f1 = 0.f, f2 = 0.f, f3 = 0.f;
#pragma unroll
                for (int bj = 0; bj < 2; ++bj) { const int k = (ai * 4 + m) * 2 + bj; const u32x4 xv = xw[k];
                    float v[8];
                    v[0] = fmaf(acc[ai][bj][m][0][0], ascale, __builtin_bit_cast(float, xv.x << 16)); v[1] = fmaf(acc[ai][bj][m][0][1], ascale, __builtin_bit_cast(float, xv.x & 0xffff0000u));
                    v[2] = fmaf(acc[ai][bj][m][0][2], ascale, __builtin_bit_cast(float, xv.y << 16)); v[3] = fmaf(acc[ai][bj][m][0][3], ascale, __builtin_bit_cast(float, xv.y & 0xffff0000u));
                    v[4] = fmaf(acc[ai][bj][m][1][0], ascale, __builtin_bit_cast(float, xv.z << 16)); v[5] = fmaf(acc[ai][bj][m][1][1], ascale, __builtin_bit_cast(float, xv.z & 0xffff0000u));
                    v[6] = fmaf(acc[ai][bj][m][1][2], ascale, __builtin_bit_cast(float, xv.w << 16)); v[7] = fmaf(acc[ai][bj][m][1][3], ascale, __builtin_bit_cast(float, xv.w & 0xffff0000u));
                    u32x4 w; w.x = cvt_pk_bf16(v[0], v[1]); w.y = cvt_pk_bf16(v[2], v[3]); w.z = cvt_pk_bf16(v[4], v[5]); w.w = cvt_pk_bf16(v[6], v[7]);
                    st16_wt(rowp + bj * HALF, w);
                    if (x8) { u32x2_t q; q.x = pk4_fp8(v[0], v[1], v[2], v[3]); q.y = pk4_fp8(v[4], v[5], v[6], v[7]); st8_wt(x8 + (size_t)r * ldc + col0 + bj * HALF, q); }
                    if (k + PF < 16) { const int kn = k + PF; xw[kn] = *(const u32x4*)(base + (size_t)((kn >> 3) * HALF + ((kn >> 1) & 3) * 16) * ldc + (kn & 1) * HALF); }
#pragma unroll
                    for (int i = 0; i < 8; ++i) s2 = fmaf(v[i], v[i], s2);
                    if (FD) {
#pragma unroll
                        for (int p = 0; p < 4; ++p) { const unsigned vp = p == 0 ? w.x : p == 1 ? w.y : p == 2 ? w.z : w.w; const u32x4 wq = *(PG8_LAS const u32x4*)(wq0 + (64 * bj + p) * 4);
                            f0 = dot2_bf16(vp, wq.x, f0); f1 = dot2_bf16(vp, wq.y, f1); f2 = dot2_bf16(vp, wq.z, f2); f3 = dot2_bf16(vp, wq.w, f3); } } }
                s2 += __shfl_xor(s2, 16); s2 += __shfl_xor(s2, 32);
                if (FD) { f0 += __shfl_xor(f0, 16); f0 += __shfl_xor(f0, 32); f1 += __shfl_xor(f1, 16); f1 += __shfl_xor(f1, 32); f2 += __shfl_xor(f2, 16); f2 += __shfl_xor(f2, 32); f3 += __shfl_xor(f3, 16); f3 += __shfl_xor(f3, 32); }
                if (fq == 0) { ss[(size_t)r * 16 + slot] = s2; if (FD) { float* fp = fdp + (size_t)r * 64 + slot; fp[0] = f0; fp[16] = f1; fp[32] = f2; fp[48] = f3; } } }
    }
};
typedef float f32x2 __attribute__((ext_vector_type(2)));
struct EpiSwiGLU {
    static constexpr bool PERM = true, AFTER_DRAIN = false;
    unsigned char* O; int ldc; const float* rstd; PG8_LAS float* rsl; float ascale, oscale;
    __device__ __forceinline__ void operator()(const f32x4 (&acc)[2][2][4][2], const Unit& u, int wr, int wc, int fr, int fq) const {
        const int row0 = u.pm * BM + wr * 64 + fr, col0 = u.pn * HALF + wc * 32 + 8 * fq;
        const PG8_LAS float* sc = rsl + u.ui * 256 + wr * 64;
#pragma unroll
        for (int ai = 0; ai < 2; ++ai)
#pragma unroll
            for (int m = 0; m < 4; ++m) { const int r = row0 + ai * HALF + m * 16; const float s = sc[ai * HALF + m * 16 + fr] * ascale; unsigned char* rowp = O + (size_t)r * ldc + col0;
                const float sn = -1.4426950408889634f * s, ikk = __builtin_amdgcn_rcpf(s * s * oscale);
                const f32x2 sn2 = {sn, sn}, ik2 = {ikk, ikk};
                u32x2_t w;
#pragma unroll
                for (int n = 0; n < 2; ++n) { const f32x4 g4 = acc[ai][0][m][n], u4 = acc[ai][1][m][n];
                    const f32x2 g01 = {g4[0], g4[1]}, g23 = {g4[2], g4[3]}, u01 = {u4[0], u4[1]}, u23 = {u4[2], u4[3]};
                    const f32x2 t01 = g01 * sn2, t23 = g23 * sn2;
                    f32x2 e01, e23; e01.x = __builtin_amdgcn_exp2f(t01.x); e01.y = __builtin_amdgcn_exp2f(t01.y); e23.x = __builtin_amdgcn_exp2f(t23.x); e23.y = __builtin_amdgcn_exp2f(t23.y);
                    const f32x2 d01 = __builtin_elementwise_fma(e01, ik2, ik2), d23 = __builtin_elementwise_fma(e23, ik2, ik2);
                    f32x2 r01, r23; r01.x = __builtin_amdgcn_rcpf(d01.x); r01.y = __builtin_amdgcn_rcpf(d01.y); r23.x = __builtin_amdgcn_rcpf(d23.x); r23.y = __builtin_amdgcn_rcpf(d23.y);
                    const f32x2 a01 = (g01 * u01) * r01, a23 = (g23 * u23) * r23;
                    const unsigned q = pk4_fp8(a01.x, a01.y, a23.x, a23.y); if (n == 0) w.x = q; else w.y = q; }
                st8_wt(rowp, w); }
    }
};

template <class Epi, class Sched, bool ALIGN_EPI = false, bool SP2 = false, bool F8 = false>
__device__ __forceinline__ void gemm_phase(PG8_LAS unsigned char* lds, const Gemm g, const Sched& S, const Epi& E) {
    const int tid = threadIdx.x, wid = __builtin_amdgcn_readfirstlane(tid >> 6), lane = tid & 63, wr = wid >> 2, wc = wid & 3, fr = lane & 15, fq = lane >> 4;
    const int KB = F8 ? g.K : 2 * g.K, nt = KB / (BK * 2);
    unsigned voffA[2], voffB[2];
#pragma unroll
    for (int i = 0; i < 2; ++i) { int R, C; stage_rc(tid * 16 + i * 8192, R, C); const int Rb = Epi::PERM ? ((R & ~31) + perm32(R & 31)) : R;
        voffA[i] = (unsigned)(R * KB + C * 2); voffB[i] = (unsigned)(Rb * KB + C * 2); }
    const size_t kstep = (size_t)(BK * 2);
    const size_t hstep = (size_t)HALF * KB;
    const size_t tstep = 2 * hstep;
    const unsigned ldsw = (unsigned)wid * 1024u;
    int aoffk[2], boffk[2];
#pragma unroll
    for (int k = 0; k < 2; ++k) { const int c = F8 ? 16 * fq + 8 * k : fq * 8 + 32 * k; aoffk[k] = lds_byte(wr * 64 + fr, c); boffk[k] = lds_byte(wc * 32 + fr, c); }
#define PG8_SA(b, h) (((b) * 2 + (h)) * HTB)
#define PG8_SB(b, h) ((4 + (b) * 2 + (h)) * HTB)
#define PG8_STAGE(bufoff, gbase, voff) do { _Pragma("unroll") for (int _i = 0; _i < 2; ++_i) \
        __builtin_amdgcn_global_load_lds((const unsigned*)((const char*)(gbase) + (voff)[_i]), (PG8_LAS unsigned*)(lds + (bufoff) + ldsw + _i * 8192), 16, 0, 0); } while (0)
#define PG8_LDA(dst, b, h) do { _Pragma("unroll") for (int m = 0; m < 4; ++m) _Pragma("unroll") for (int k = 0; k < 2; ++k) dst[m][k] = *(const PG8_LAS bf16x8*)(lds + PG8_SA(b, h) + aoffk[k] + m * 2048); } while (0)
#define PG8_LDA8(dst, b, h) do { _Pragma("unroll") for (int m = 0; m < 4; ++m) { const i32x4_t lo_ = *(const PG8_LAS i32x4_t*)(lds + PG8_SA(b, h) + aoffk[0] + m * 2048), hi_ = *(const PG8_LAS i32x4_t*)(lds + PG8_SA(b, h) + aoffk[1] + m * 2048); dst[m] = __builtin_shufflevector(lo_, hi_, 0, 1, 2, 3, 4, 5, 6, 7); } } while (0)
#define PG8_LDB(dst, b, h) do { _Pragma("unroll") for (int n = 0; n < 2; ++n) _Pragma("unroll") for (int k = 0; k < 2; ++k) dst[n][k] = *(const PG8_LAS bf16x8*)(lds + PG8_SB(b, h) + boffk[k] + n * 2048); } while (0)
#define PG8_LDB8(dst, b, h) do { _Pragma("unroll") for (int n = 0; n < 2; ++n) { const i32x4_t lo_ = *(const PG8_LAS i32x4_t*)(lds + PG8_SB(b, h) + boffk[0] + n * 2048), hi_ = *(const PG8_LAS i32x4_t*)(lds + PG8_SB(b, h) + boffk[1] + n * 2048); dst[n] = __builtin_shufflevector(lo_, hi_, 0, 1, 2, 3, 4, 5, 6, 7); } } while (0)
#define PG8_MMA(ai, bj, At, Bt) do { __builtin_amdgcn_s_setprio(1); _Pragma("unroll") for (int m = 0; m < 4; ++m) _Pragma("unroll") for (int n = 0; n < 2; ++n) _Pragma("unroll") for (int k = 0; k < 2; ++k) \
        acc[ai][bj][m][n] = __builtin_amdgcn_mfma_f32_16x16x32_bf16(Bt[n][k], At[m][k], acc[ai][bj][m][n], 0, 0, 0); __builtin_amdgcn_s_setprio(0); } while (0)
#define PG8_MMA8(ai, bj, At, Bt) do { __builtin_amdgcn_sched_barrier(0); __builtin_amdgcn_s_setprio(1); _Pragma("unroll") for (int m = 0; m < 4; ++m) _Pragma("unroll") for (int n = 0; n < 2; ++n) \
        acc[ai][bj][m][n] = __builtin_amdgcn_mfma_scale_f32_16x16x128_f8f6f4(Bt[n], At[m], acc[ai][bj][m][n], 0, 0, 0, 0x7f7f7f7f, 0, 0x7f7f7f7f); __builtin_amdgcn_s_setprio(0); \
        asm volatile("" : "+v"(acc[ai][bj][0][0]), "+v"(acc[ai][bj][0][1]), "+v"(acc[ai][bj][1][0]), "+v"(acc[ai][bj][1][1]), "+v"(acc[ai][bj][2][0]), "+v"(acc[ai][bj][2][1]), "+v"(acc[ai][bj][3][0]), "+v"(acc[ai][bj][3][1])); \
        __builtin_amdgcn_sched_barrier(0); } while (0)
#define PG8_LDAx(b, h) do { if constexpr (F8) PG8_LDA8(At8, b, h); else PG8_LDA(At, b, h); } while (0)
#define PG8_LDBx(w, b, h) do { if constexpr (F8) { if ((w) == 0) PG8_LDB8(B08, b, h); else PG8_LDB8(B18, b, h); } else { if ((w) == 0) PG8_LDB(B0, b, h); else PG8_LDB(B1, b, h); } } while (0)
#define PG8_MMAx(ai, bj, w) do { if constexpr (F8) { if ((w) == 0) PG8_MMA8(ai, bj, At8, B08); else PG8_MMA8(ai, bj, At8, B18); } else { if ((w) == 0) PG8_MMA(ai, bj, At, B0); else PG8_MMA(ai, bj, At, B1); } } while (0)
#define PG8_WAIT_V(n) asm volatile("s_waitcnt vmcnt(" #n ")" ::: "memory")
#define PG8_WAIT_L(n) asm volatile("s_waitcnt lgkmcnt(" #n ")" ::: "memory")
#define PG8_BAR __builtin_amdgcn_s_barrier()
#define PG8_SCHED __builtin_amdgcn_sched_barrier(0)
    Unit cur, nxt; int ui = 0;
    if (!S.next(0, cur)) return;
    f32x4 acc[2][2][4][2];
#pragma unroll
    for (int a = 0; a < 2; ++a)
#pragma unroll
        for (int b = 0; b < 2; ++b)
#pragma unroll
            for (int m = 0; m < 4; ++m)
#pragma unroll
                for (int n = 0; n < 2; ++n) acc[a][b][m][n] = (f32x4){0.f, 0.f, 0.f, 0.f};
    bf16x8 At[4][2], B0[2][2], B1[2][2]; i32x8_t At8[4], B08[2], B18[2];
    const char* cA = (const char*)g.A + (size_t)cur.pm * tstep; const char* cB = (const char*)g.Bt + (size_t)cur.pn * tstep;
    S.a_ready(cur);
    if constexpr (SP2) {
        PG8_STAGE(PG8_SB(0, 0), cB, voffB); PG8_STAGE(PG8_SB(0, 1), cB + hstep, voffB); PG8_STAGE(PG8_SA(0, 0), cA, voffA); PG8_STAGE(PG8_SA(0, 1), cA + hstep, voffA);
        if (wr == 1) PG8_BAR;
        PG8_WAIT_V(2); PG8_BAR;
        PG8_STAGE(PG8_SB(1, 0), cB + kstep, voffB); PG8_STAGE(PG8_SA(1, 0), cA + kstep, voffA); PG8_STAGE(PG8_SB(1, 1), cB + hstep + kstep, voffB);
        PG8_WAIT_V(6); PG8_BAR;
    } else {
        PG8_STAGE(PG8_SB(0, 0), cB, voffB); PG8_STAGE(PG8_SA(0, 0), cA, voffA); PG8_STAGE(PG8_SB(0, 1), cB + hstep, voffB); PG8_STAGE(PG8_SA(0, 1), cA + hstep, voffA);
        if (wr == 1) PG8_BAR;
        PG8_WAIT_V(4); PG8_BAR;
        PG8_STAGE(PG8_SB(1, 0), cB + kstep, voffB); PG8_STAGE(PG8_SA(1, 0), cA + kstep, voffA); PG8_STAGE(PG8_SB(1, 1), cB + hstep + kstep, voffB);
        PG8_WAIT_V(6); PG8_BAR;
    }
    for (;;) {
        const bool has_next = S.next(ui + 1, nxt);
        const char* nA = has_next ? (const char*)g.A + (size_t)nxt.pm * tstep : cA; const char* nB = has_next ? (const char*)g.Bt + (size_t)nxt.pn * tstep : cB;
        for (int t = 0; t < nt; t += 2) {
            const bool last = (t == nt - 2);
            const char* a1 = cA + (size_t)(t + 1) * kstep;
            const char* a2 = last ? nA : cA + (size_t)(t + 2) * kstep; const char* b2 = last ? nB : cB + (size_t)(t + 2) * kstep;
            const char* a3 = a2 + kstep; const char* b3 = b2 + kstep;
            if (last && has_next) S.a_ready(nxt);
            if constexpr (SP2) {
            PG8_LDBx(0, 0, 0); PG8_LDBx(1, 0, 1); PG8_SCHED; PG8_LDAx(0, 0); PG8_STAGE(PG8_SA(1, 1), a1 + hstep, voffA);
            PG8_WAIT_V(8); PG8_WAIT_L(0); PG8_BAR; PG8_MMAx(0, 0, 0); PG8_MMAx(0, 1, 1); PG8_BAR; PG8_SCHED;
            PG8_LDAx(0, 1); PG8_STAGE(PG8_SB(0, 0), b2, voffB); PG8_STAGE(PG8_SB(0, 1), b2 + hstep, voffB); PG8_STAGE(PG8_SA(0, 0), a2, voffA);
            PG8_WAIT_V(8); PG8_WAIT_L(0); PG8_BAR; PG8_MMAx(1, 0, 0); PG8_MMAx(1, 1, 1); PG8_BAR; PG8_SCHED;
            PG8_LDBx(0, 1, 0); PG8_LDBx(1, 1, 1); PG8_SCHED; PG8_LDAx(1, 0); PG8_STAGE(PG8_SA(0, 1), a2 + hstep, voffA);
            PG8_WAIT_V(8); PG8_WAIT_L(0); PG8_BAR; PG8_MMAx(0, 0, 0); PG8_MMAx(0, 1, 1); PG8_BAR; PG8_SCHED;
            PG8_LDAx(1, 1); PG8_STAGE(PG8_SB(1, 0), b3, voffB); PG8_STAGE(PG8_SB(1, 1), b3 + hstep, voffB); PG8_STAGE(PG8_SA(1, 0), a3, voffA);
            PG8_WAIT_V(8); PG8_WAIT_L(0); PG8_BAR; PG8_MMAx(1, 0, 0); PG8_MMAx(1, 1, 1); PG8_BAR; PG8_SCHED;
            } else {
            PG8_LDBx(0, 0, 0); PG8_SCHED; PG8_LDAx(0, 0); PG8_STAGE(PG8_SA(1, 1), a1 + hstep, voffA);
            PG8_WAIT_L(8); PG8_BAR; PG8_WAIT_L(0); PG8_MMAx(0, 0, 0); PG8_BAR; PG8_SCHED;
            PG8_LDBx(1, 0, 1); PG8_STAGE(PG8_SB(0, 0), b2, voffB);
            PG8_BAR; PG8_WAIT_L(0); PG8_MMAx(0, 1, 1); PG8_BAR;
            PG8_LDAx(0, 1); PG8_STAGE(PG8_SA(0, 0), a2, voffA);
            PG8_BAR; PG8_WAIT_L(0); PG8_MMAx(1, 0, 0); PG8_BAR; PG8_SCHED;
            PG8_STAGE(PG8_SB(0, 1), b2 + hstep, voffB);
            PG8_WAIT_V(6); PG8_BAR; PG8_MMAx(1, 1, 1); PG8_BAR;
            PG8_LDBx(0, 1, 0); PG8_SCHED; PG8_LDAx(1, 0); PG8_STAGE(PG8_SA(0, 1), a2 + hstep, voffA);
            PG8_WAIT_L(8); PG8_BAR; PG8_WAIT_L(0); PG8_MMAx(0, 0, 0); PG8_BAR; PG8_SCHED;
            PG8_LDBx(1, 1, 1); PG8_STAGE(PG8_SB(1, 0), b3, voffB);
            PG8_BAR; PG8_WAIT_L(0); PG8_MMAx(0, 1, 1); PG8_BAR;
            PG8_LDAx(1, 1); PG8_STAGE(PG8_SA(1, 0), a3, voffA);
            PG8_BAR; PG8_WAIT_L(0); PG8_MMAx(1, 0, 0); PG8_BAR; PG8_SCHED;
            PG8_STAGE(PG8_SB(1, 1), b3 + hstep, voffB);
            PG8_WAIT_V(6); PG8_BAR; PG8_MMAx(1, 1, 1); PG8_BAR;
            }
        }
        if constexpr (ALIGN_EPI) { if (wr == 0) PG8_BAR; }
        if constexpr (!Epi::AFTER_DRAIN) { E(acc, cur, wr, wc, fr, fq); S.done(cur); }
        if (!has_next) break;
#pragma unroll
        for (int a = 0; a < 2; ++a)
#pragma unroll
            for (int b = 0; b < 2; ++b)
#pragma unroll
                for (int m = 0; m < 4; ++m)
#pragma unroll
                    for (int n = 0; n < 2; ++n) acc[a][b][m][n] = (f32x4){0.f, 0.f, 0.f, 0.f};
        cur = nxt; cA = nA; cB = nB; ++ui;
        if constexpr (ALIGN_EPI) { if (wr == 1) PG8_BAR; }
    }
    PG8_WAIT_V(0);
    if constexpr (!ALIGN_EPI) { if (wr == 0) PG8_BAR; }
    PG8_BAR;
    if constexpr (Epi::AFTER_DRAIN) { E.fused(acc, cur, wr, wc, fr, fq, lds, wid, lane); S.done(cur); }
#undef PG8_SA
#undef PG8_SB
#undef PG8_STAGE
#undef PG8_LDA
#undef PG8_LDB
#undef PG8_MMA
#undef PG8_MMA8
#undef PG8_LDAx
#undef PG8_LDBx
#undef PG8_MMAx
#undef PG8_LDA8
#undef PG8_LDB8
#undef PG8_WAIT_V
#undef PG8_WAIT_L
#undef PG8_BAR
#undef PG8_SCHED
}
}
namespace att {
#define ATT_LAS __attribute__((address_space(3)))
typedef short bf16x8 __attribute__((ext_vector_type(8)));
typedef short s16x4 __attribute__((ext_vector_type(4)));
typedef float f32x16 __attribute__((ext_vector_type(16)));
typedef float f32x4 __attribute__((ext_vector_type(4)));
typedef unsigned u32x4 __attribute__((ext_vector_type(4)));
typedef unsigned short bf16;
enum { T_A = 0, T_B = 1, T_C = 2, T_D = 3 };
constexpr int S = 4096, QP = 2816;
constexpr int SLOTB = 8192;
constexpr int NSLOT = 4;
constexpr int L_K = 0, L_V = NSLOT * SLOTB, L_KB = 2 * NSLOT * SLOTB, L_WS = L_KB + NSLOT * 256 + 256, L_TAB = L_WS + 2048, TAB_N = 5600, L_KM = L_TAB + TAB_N * 4, L_OST = L_KM + 4096, L_END = L_OST + 8 * 4096;
static_assert(L_TAB % 16 == 0 && L_KM % 16 == 0 && L_OST % 16 == 0 && L_END <= 131072, "attention LDS map");
constexpr float THR = 8.0f;
__device__ __forceinline__ constexpr int offr(int r) { return (r & 3) + 8 * (r >> 2); }
__device__ __forceinline__ unsigned cvtpk(float lo, float hi) { typedef float f2 __attribute__((ext_vector_type(2))); typedef __bf16 b2 __attribute__((ext_vector_type(2))); f2 v = {lo, hi}; b2 b = __builtin_convertvector(v, b2); return __builtin_bit_cast(unsigned, b); }
__device__ __forceinline__ s16x4 vtr(const ATT_LAS char* p) { typedef short v4i16_t __attribute__((ext_vector_type(4))); return __builtin_bit_cast(s16x4, __builtin_amdgcn_ds_read_tr16_b64_v4i16((ATT_LAS v4i16_t*)p)); }
__device__ __forceinline__ float xhalf_max(float v) { auto rr = __builtin_amdgcn_permlane32_swap(__float_as_uint(v), __float_as_uint(v), false, false); return fmaxf(__uint_as_float(rr[0]), __uint_as_float(rr[1])); }
__device__ __forceinline__ float xhalf_sum(float v) { auto rr = __builtin_amdgcn_permlane32_swap(__float_as_uint(v), __float_as_uint(v), false, false); return __uint_as_float(rr[0]) + __uint_as_float(rr[1]); }

__device__ __forceinline__ void glds16(const void* gsrc, unsigned lds_dst) { unsigned keep;
    asm volatile("s_mov_b32 %0, m0\n\ts_mov_b32 m0, %2\n\ts_nop 0\n\tglobal_load_lds_dwordx4 %1, off\n\ts_mov_b32 m0, %0" : "=&s"(keep) : "v"(gsrc), "s"(lds_dst) : "memory"); }
__device__ __forceinline__ void glds4(const void* gsrc, unsigned lds_dst) { unsigned keep;
    asm volatile("s_mov_b32 %0, m0\n\ts_mov_b32 m0, %2\n\ts_nop 0\n\tglobal_load_lds_dword %1, off\n\ts_mov_b32 m0, %0" : "=&s"(keep) : "v"(gsrc), "s"(lds_dst) : "memory"); }

template <int TYPE>
__device__ __forceinline__ void attn_item(ATT_LAS unsigned char* lds, const bf16* qkv, int b, int h, int qb, int res, int dil_rt, int W_rt, int qcol_rt, int kcol_rt, int vcol_rt, const float* tabg, int tab_id, int& cur_tab, const float* c2bh, const unsigned* nrm, const float* kmbh, float sink2,
                                          bf16* outp, int ldo, float* lse_out) {
    const int tid = threadIdx.x, lane = tid & 63, r32 = lane & 31, hi = lane >> 5; const int wid = __builtin_amdgcn_readfirstlane(tid >> 6);
    constexpr bool BAND = (TYPE == T_A);
    const int W = W_rt; const int DIL = BAND ? dil_rt : 1;
    const int qcol = BAND ? qcol_rt : (TYPE == T_B ? 768 : 2048) + 64 * h;
    const int kcol = BAND ? kcol_rt : (TYPE == T_B ? 1024 : 2304) + 64 * h;
    const int vcol = BAND ? vcol_rt : (TYPE == T_B ? 1280 : 2560) + 64 * h;
    const size_t rowbase = (size_t)b * S + res;
    const int qf0 = 256 * qb, qfw = qf0 + 32 * wid;
    const int kf0 = BAND ? qf0 - 128 : 0, NT = BAND ? 6 : 4 * (qb + 1);
    int tlo = (BAND && qb == 0) ? 2 : 0;
    if (TYPE == T_D) {
        const float qm = __uint_as_float(nrm[0]) + __uint_as_float(nrm[1]), kmx = __uint_as_float(nrm[2]) + __uint_as_float(nrm[3]);
        const float bound = 2.0f * sqrtf(qm * kmx) * 1.01f + 42.0f;
        const float c0 = c2bh[qf0];
        const bool skip = (lane < 4 * qb) && (c0 - c2bh[64 * (lane < 4 * qb ? lane : 0) + 63] < -bound);
        tlo = __builtin_popcountll(__ballot(skip));
    }
    ATT_LAS float* tab = (ATT_LAS float*)(lds + L_TAB);
    ATT_LAS float* km = (ATT_LAS float*)(lds + L_KM);
    ATT_LAS float* wsf = (ATT_LAS float*)(lds + L_WS) + wid * 64;
    const unsigned lds0 = (unsigned)(uintptr_t)lds;
#define ATT_ISSUE(t) do { const int k0_ = kf0 + 64 * (t); const int sl_ = ((t) - tlo) % NSLOT; int kk_ = k0_ + lane; kk_ = kk_ < 0 ? 0 : kk_; \
        glds16(qkv + (rowbase + (size_t)kk_ * DIL) * QP + kcol + wid * 8, (unsigned)__builtin_amdgcn_readfirstlane(lds0 + L_K + sl_ * SLOTB + wid * 1024)); \
        int kv_ = k0_ + 16 * (wid & 3) + (lane >> 2); kv_ = kv_ < 0 ? 0 : kv_; \
        glds16(qkv + (rowbase + (size_t)kv_ * DIL) * QP + vcol + (wid >> 2) * 32 + (lane & 3) * 8, (unsigned)__builtin_amdgcn_readfirstlane(lds0 + L_V + sl_ * SLOTB + wid * 1024)); \
        if (TYPE == T_D) glds4(c2bh + k0_ + lane, (unsigned)__builtin_amdgcn_readfirstlane(lds0 + L_KB + sl_ * 256)); } while (0)
    if (TYPE != T_D) { if (tab_id != cur_tab) { cur_tab = tab_id;
            for (int i = tid; i < TAB_N; i += 512) tab[i] = (i < 4096) ? tabg[4095 - i] : 0.f; } }
    if (TYPE == T_B) { for (int i = tid; i < 16 * 64; i += 512) km[i] = kmbh[i]; }
    bf16x8 qr[4];
    { const bf16* qrow = qkv + (rowbase + (size_t)(qfw + r32) * DIL) * QP + qcol;
#pragma unroll
      for (int d0 = 0; d0 < 4; ++d0) qr[d0] = *(const bf16x8*)(qrow + 16 * d0 + 8 * hi); }
    const float cq = (TYPE == T_D) ? c2bh[qfw + r32] : 0.f;
    ATT_ISSUE(tlo); if (tlo + 1 < NT) ATT_ISSUE(tlo + 1); if (tlo + 2 < NT) ATT_ISSUE(tlo + 2);
    asm volatile("s_waitcnt vmcnt(0)" ::: "memory");
    __syncthreads();
    unsigned sel = 0u;
    if (TYPE == T_B) {
        float g[16];
#pragma unroll
        for (int n = 0; n < 16; ++n) { g[n] = -INFINITY; if (n < qb) { float s = 0.f;
#pragma unroll
                for (int d0 = 0; d0 < 4; ++d0) { const f32x4 a = *(const ATT_LAS f32x4*)(km + n * 64 + 16 * d0 + 8 * hi), c = *(const ATT_LAS f32x4*)(km + n * 64 + 16 * d0 + 8 * hi + 4);
                    const bf16x8 qv = qr[d0];
                    s = fmaf(__builtin_bit_cast(float, (unsigned)(unsigned short)qv[0] << 16), a[0], s); s = fmaf(__builtin_bit_cast(float, (unsigned)(unsigned short)qv[1] << 16), a[1], s);
                    s = fmaf(__builtin_bit_cast(float, (unsigned)(unsigned short)qv[2] << 16), a[2], s); s = fmaf(__builtin_bit_cast(float, (unsigned)(unsigned short)qv[3] << 16), a[3], s);
                    s = fmaf(__builtin_bit_cast(float, (unsigned)(unsigned short)qv[4] << 16), c[0], s); s = fmaf(__builtin_bit_cast(float, (unsigned)(unsigned short)qv[5] << 16), c[1], s);
                    s = fmaf(__builtin_bit_cast(float, (unsigned)(unsigned short)qv[6] << 16), c[2], s); s = fmaf(__builtin_bit_cast(float, (unsigned)(unsigned short)qv[7] << 16), c[3], s); }
                g[n] = xhalf_sum(s); } }
#pragma unroll
        for (int r = 0; r < 3; ++r) { float best = -INFINITY; int bi = -1;
#pragma unroll
            for (int n = 0; n < 16; ++n) if (n < qb && !((sel >> n) & 1u) && g[n] > best) { best = g[n]; bi = n; }
            if (bi >= 0) sel |= 1u << bi; }
    }
    float m = 0.f, l = 0.f; f32x16 o[2]; o[0] = f32x16{}; o[1] = f32x16{};
    const int vpo = ((lane >> 4) & 1) * 32 + (lane & 3) * 8 + (4 * hi + ((lane & 15) >> 2)) * 64;
    f32x16 p0 = f32x16{}, p1 = f32x16{}; u32x4 pw[4] = {u32x4{}, u32x4{}, u32x4{}, u32x4{}};
    const int hb = wid >> 2;
#define ATT_BAR(N) asm volatile("s_waitcnt vmcnt(" #N ") lgkmcnt(0)\n\ts_barrier" ::: "memory")
#define ATT_ACTIVE(T, ACT, PICK) do { const int k0_ = kf0 + 64 * (T); PICK = true; \
        if (BAND) ACT = (k0_ <= qfw + 31) && (k0_ + 63 >= qfw - W); \
        else if (TYPE == T_B) { const bool past_ = k0_ < qf0; PICK = past_ ? ((sel >> (k0_ >> 8)) & 1u) : true; ACT = past_ ? (__ballot(PICK) != 0ull) : (k0_ <= qfw + 31); } \
        else ACT = (k0_ <= qfw + 31); } while (0)
#define ATT_LDK(T, KF) do { const int sl_ = ((T) - tlo) % NSLOT; const ATT_LAS char* kb_ = (const ATT_LAS char*)(lds + L_K + sl_ * SLOTB) + hi * 1024 + r32 * 16; \
        _Pragma("unroll") for (int d0 = 0; d0 < 4; ++d0) { KF[2 * d0] = *(const ATT_LAS bf16x8*)(kb_ + d0 * 2048); KF[2 * d0 + 1] = *(const ATT_LAS bf16x8*)(kb_ + d0 * 2048 + 512); } } while (0)
#define ATT_LDV(T, D0, VF) do { const int sl_ = ((T) - tlo) % NSLOT; const ATT_LAS char* vp = (const ATT_LAS char*)(lds + L_V + sl_ * SLOTB) + vpo; \
        _Pragma("unroll") for (int ks = 0; ks < 4; ++ks) { const s16x4 lo = vtr(vp + (D0) * 4096 + ks * 1024), hh = vtr(vp + (D0) * 4096 + ks * 1024 + 512); \
            VF[ks] = (bf16x8){lo[0], lo[1], lo[2], lo[3], hh[0], hh[1], hh[2], hh[3]}; } } while (0)
#define ATT_QK(KF, P0, P1, PICK) do { \
        f32x16 ci_; { const float c_ = (TYPE == T_B && !(PICK)) ? -INFINITY : cq - m; _Pragma("unroll") for (int r = 0; r < 16; ++r) ci_[r] = c_; } \
        _Pragma("unroll") for (int d0 = 0; d0 < 4; ++d0) { \
            if (d0 == 0) { P0 = __builtin_amdgcn_mfma_f32_32x32x16_bf16(KF[0], qr[0], ci_, 0, 0, 0); P1 = __builtin_amdgcn_mfma_f32_32x32x16_bf16(KF[1], qr[0], ci_, 0, 0, 0); } \
            else { P0 = __builtin_amdgcn_mfma_f32_32x32x16_bf16(KF[2 * d0], qr[d0], P0, 0, 0, 0); P1 = __builtin_amdgcn_mfma_f32_32x32x16_bf16(KF[2 * d0 + 1], qr[d0], P1, 0, 0, 0); } } } while (0)
#define ATT_MOD(T, P0, P1) do { const int sl_ = ((T) - tlo) % NSLOT; const int k0 = kf0 + 64 * (T); \
        const int d0l = qfw + r32 - k0 - 4 * hi; \
        if (TYPE != T_D) { \
            if (TYPE == T_B && qfw - k0 - 63 >= 1513) { const float bfar = tab[0]; \
                _Pragma("unroll") for (int r = 0; r < 16; ++r) { P0[r] += bfar; P1[r] += bfar; } \
            } else { const ATT_LAS float* tb = tab + (4095 - DIL * d0l); \
                _Pragma("unroll") for (int r = 0; r < 16; ++r) { P0[r] += tb[DIL * offr(r)]; P1[r] += tb[DIL * (offr(r) + 32)]; } } \
        } else { const ATT_LAS float* cb = (const ATT_LAS float*)(lds + L_KB + sl_ * 256) + 4 * hi; \
            _Pragma("unroll") for (int i = 0; i < 4; ++i) { const f32x4 c0 = *(const ATT_LAS f32x4*)(cb + 8 * i), c1 = *(const ATT_LAS f32x4*)(cb + 8 * i + 32); \
                _Pragma("unroll") for (int j = 0; j < 4; ++j) { P0[4 * i + j] -= c0[j]; P1[4 * i + j] -= c1[j]; } } } \
        if (k0 + 63 > qfw) { _Pragma("unroll") for (int r = 0; r < 16; ++r) { if (d0l - offr(r) < 0) P0[r] = -INFINITY; if (d0l - offr(r) - 32 < 0) P1[r] = -INFINITY; } } \
        if (BAND) { if (qfw + 31 - k0 > W) { _Pragma("unroll") for (int r = 0; r < 16; ++r) { if (d0l - offr(r) > W) P0[r] = -INFINITY; if (d0l - offr(r) - 32 > W) P1[r] = -INFINITY; } } } \
        float rm = fmaxf(P0[0], P1[0]), rm2 = fmaxf(P0[1], P1[1]); \
        _Pragma("unroll") for (int r = 2; r < 16; r += 2) { rm = fmaxf(fmaxf(rm, P0[r]), P1[r]); rm2 = fmaxf(fmaxf(rm2, P0[r + 1]), P1[r + 1]); } \
        rm = xhalf_max(fmaxf(rm, rm2)); \
        if (__ballot(rm > THR) != 0ull) { const float dl = fmaxf(rm, 0.f); m += dl; \
            _Pragma("unroll") for (int r = 0; r < 16; ++r) { P0[r] -= dl; P1[r] -= dl; } \
            const float f = EX2(-dl); l *= f; \
            if (hi == 0) wsf[r32] = f; \
            asm volatile("s_waitcnt lgkmcnt(0)" ::: "memory"); \
            _Pragma("unroll") for (int i = 0; i < 4; ++i) { const f32x4 fr = *(const ATT_LAS f32x4*)(wsf + 8 * i + 4 * hi); \
                _Pragma("unroll") for (int j = 0; j < 4; ++j) { o[0][4 * i + j] *= fr[j]; o[1][4 * i + j] *= fr[j]; } } } } while (0)
#define ATT_EXP(P0, P1, PW) do { float sacc = 0.f; \
        _Pragma("unroll") for (int r = 0; r < 16; ++r) { P0[r] = EX2(P0[r]); P1[r] = EX2(P1[r]); sacc += P0[r] + P1[r]; } \
        l += sacc; \
        _Pragma("unroll") for (int i = 0; i < 4; ++i) { PW[0][i] = cvtpk(P0[2 * i], P0[2 * i + 1]); PW[1][i] = cvtpk(P0[8 + 2 * i], P0[9 + 2 * i]); PW[2][i] = cvtpk(P1[2 * i], P1[2 * i + 1]); PW[3][i] = cvtpk(P1[8 + 2 * i], P1[9 + 2 * i]); } } while (0)
#define ATT_PV(D0, VF, PW) do { \
        _Pragma("unroll") for (int ks = 0; ks < 4; ++ks) o[D0] = __builtin_amdgcn_mfma_f32_32x32x16_bf16(__builtin_bit_cast(bf16x8, PW[ks]), VF[ks], o[D0], 0, 0, 0); } while (0)
    bool actC, pick0; ATT_ACTIVE(tlo, actC, pick0);
    if (actC) { bf16x8 kf0_[8]; ATT_LDK(tlo, kf0_); ATT_QK(kf0_, p0, p1, pick0); ATT_MOD(tlo, p0, p1); if (hb == 1) ATT_EXP(p0, p1, pw); }
    for (int t = tlo; t < NT; ++t) {
        const bool more1 = t + 1 < NT, more3 = t + 3 < NT;
        if (more3) ATT_ISSUE(t + 3);
        bool actN = false, pickN = true; if (more1) ATT_ACTIVE(t + 1, actN, pickN);
        bf16x8 kf[8], vf[4], vg[4];
        if (actC) ATT_LDV(t, 0, vf);
        __builtin_amdgcn_sched_barrier(0);
        if (hb == 0) { if (actC) ATT_EXP(p0, p1, pw); }
        if (actN) { ATT_LDK(t + 1, kf); ATT_QK(kf, p0, p1, pickN); }
        if (actC) { ATT_LDV(t, 1, vg); __builtin_amdgcn_sched_barrier(0); ATT_PV(0, vf, pw); ATT_PV(1, vg, pw); }
        if (actN) { ATT_MOD(t + 1, p0, p1); if (hb == 1) ATT_EXP(p0, p1, pw); }
        if (more3) { if (TYPE == T_D) ATT_BAR(3); else ATT_BAR(2); }
        else ATT_BAR(0);
        actC = actN;
    }
#undef ATT_BAR
#undef ATT_ACTIVE
#undef ATT_QK
#undef ATT_LDK
#undef ATT_LDV
#undef ATT_MOD
#undef ATT_EXP
#undef ATT_PV
    l = xhalf_sum(l);
    if (BAND) l += EX2(sink2 - m);
    if (hi == 0) wsf[32 + r32] = 1.0f / l;
    asm volatile("s_waitcnt lgkmcnt(0)" ::: "memory");
    {   ATT_LAS bf16* stg = (ATT_LAS bf16*)(lds + L_OST) + wid * 2048;
#pragma unroll
        for (int i = 0; i < 4; ++i) { const f32x4 rl = *(const ATT_LAS f32x4*)(wsf + 32 + 8 * i + 4 * hi);
#pragma unroll
            for (int j = 0; j < 4; ++j) { const int orow = 8 * i + 4 * hi + j;
#pragma unroll
                for (int d0 = 0; d0 < 2; ++d0) { const unsigned w = cvtpk(o[d0][4 * i + j] * rl[j], 0.f); stg[orow * 64 + d0 * 32 + r32] = (bf16)(w & 0xffffu); } } }
        asm volatile("s_waitcnt lgkmcnt(0)" ::: "memory");
#pragma unroll
        for (int i = 0; i < 4; ++i) { const int row = i * 8 + (lane >> 3), ch = lane & 7; const u32x4 v = *(const ATT_LAS u32x4*)(stg + row * 64 + ch * 8);
            *(u32x4*)(outp + (rowbase + (size_t)(qfw + row) * DIL) * ldo + ch * 8) = v; }
    }
    if (BAND) { if (lse_out != nullptr && hi == 0) lse_out[(rowbase + (size_t)(qfw + r32) * DIL) * 4] = m + __builtin_amdgcn_logf(l); }
    __syncthreads();
#undef ATT_ISSUE
}
}

namespace att2 {
#define A2_LAS __attribute__((address_space(3)))
typedef att::bf16x8 bf16x8; typedef att::s16x4 s16x4; typedef att::f32x16 f32x16; typedef att::f32x4 f32x4; typedef att::u32x4 u32x4; typedef unsigned short bf16;
enum { T_B = 1, T_D = 3 };
constexpr int S = 4096, QP = 2816, NW = 8, QBLK = 32, QB = 256, KVBLK = 64;
constexpr int NSLOT = 3, SLOTB = 8192;
constexpr int L_K = 0, L_V = NSLOT * SLOTB, L_WS = 2 * NSLOT * SLOTB, L_OST = L_WS + NW * 64 * 4, L_TAB = L_OST + NW * 4096, TAB_N = 5600, TAB_PADN = 96, L_KM = L_TAB + (TAB_N + TAB_PADN) * 4, L_END = L_KM + 4096;
static_assert(L_TAB % 16 == 0 && L_KM % 16 == 0 && L_END <= 131072, "attention engine 2 LDS map");
constexpr float THR = 8.0f;
typedef A2_LAS const char* lds_cptr;
#define A2_MX3(a, b, c) __builtin_fmaxf(__builtin_fmaxf((a), (b)), (c))
__device__ __forceinline__ void kload8(bf16x8* kf, lds_cptr kp) {
    kf[0] = *(const A2_LAS bf16x8*)(kp);        kf[1] = *(const A2_LAS bf16x8*)(kp + 512);  kf[2] = *(const A2_LAS bf16x8*)(kp + 2048); kf[3] = *(const A2_LAS bf16x8*)(kp + 2560);
    kf[4] = *(const A2_LAS bf16x8*)(kp + 4096); kf[5] = *(const A2_LAS bf16x8*)(kp + 4608); kf[6] = *(const A2_LAS bf16x8*)(kp + 6144); kf[7] = *(const A2_LAS bf16x8*)(kp + 6656);
}
__device__ __forceinline__ void kload2(bf16x8* kf, lds_cptr kp, int j) { kf[2 * j] = *(const A2_LAS bf16x8*)(kp + j * 2048); kf[2 * j + 1] = *(const A2_LAS bf16x8*)(kp + j * 2048 + 512); }
#define A2_SBAR() __builtin_amdgcn_sched_barrier(0)
#define A2_WAIT_BAR(N) asm volatile("s_waitcnt vmcnt(" #N ") lgkmcnt(0)\n\ts_barrier" ::: "memory")
#define A2_MFMA(a, b, c) __builtin_amdgcn_mfma_f32_32x32x16_bf16(a, b, c, 0, 0, 0)

template <int TYPE>
__device__ __forceinline__ void attn_unit2(A2_LAS unsigned char* lds, const bf16* qkv, int b, int h, int qb, const float* tabg, int tab_id, int& cur_tab, const float* c2bh, const unsigned* nrm, const float* kmbh,
                                           bf16* outp, int ldo) {
    int tid_ = threadIdx.x; asm volatile("" : "+v"(tid_));
    const int tid = tid_, lane = tid & 63, r32 = lane & 31, hi = lane >> 5; const int wid = __builtin_amdgcn_readfirstlane(tid >> 6);
    const int qcol = (TYPE == T_B ? 768 : 2048) + 64 * h, kcol = (TYPE == T_B ? 1024 : 2304) + 64 * h, vcol = (TYPE == T_B ? 1280 : 2560) + 64 * h;
    const size_t rowbase = (size_t)b * S; const int q0 = QB * qb, qrel = wid * QBLK + r32, qrow = q0 + qrel;
    int tlo = 0;
    if (TYPE == T_D) {
        const float qm = __uint_as_float(nrm[0]) + __uint_as_float(nrm[1]), kmx = __uint_as_float(nrm[2]) + __uint_as_float(nrm[3]);
        const float bound = 2.0f * sqrtf(qm * kmx) * 1.01f + 42.0f;
        const float c0 = c2bh[q0];
        const bool skip = (lane < 4 * qb) && (c0 - c2bh[64 * (lane < 4 * qb ? lane : 0) + 63] < -bound);
        tlo = __builtin_popcountll(__ballot(skip)) & ~1;
    }
    const int NT = 4 * (qb + 1) - tlo, key0 = 64 * tlo;
    A2_LAS float* tab = (A2_LAS float*)(lds + L_TAB);
    A2_LAS float* km = (A2_LAS float*)(lds + L_KM);
    A2_LAS float* wsf = (A2_LAS float*)(lds + L_WS) + wid * 64;
    const unsigned lds0 = (unsigned)(uintptr_t)lds;
    if (TYPE == T_B) { if (tab_id != cur_tab) { cur_tab = tab_id; for (int i = tid; i < TAB_N + TAB_PADN; i += 512) tab[i] = (i < 4096) ? tabg[4095 - i] : (i < TAB_N ? 0.f : -INFINITY); }
        for (int i = tid; i < 16 * 64; i += 512) km[i] = kmbh[i]; }
    else { cur_tab = -1; for (int i = tid; i < NT * 64; i += 512) tab[i] = c2bh[key0 + i]; }
    const bf16* ksrc = qkv + (rowbase + key0 + lane) * QP + kcol + wid * 8;
    const bf16* vsrc = qkv + (rowbase + key0 + 16 * (wid & 3) + (lane >> 2)) * QP + vcol + (wid >> 2) * 32 + (lane & 3) * 8;
    const unsigned kdst = lds0 + L_K + wid * 1024, vdst = lds0 + L_V + wid * 1024;
#define A2_DMA_K(t, slot) att::glds16(ksrc + (size_t)(t) * KVBLK * QP, (unsigned)__builtin_amdgcn_readfirstlane(kdst + (slot)))
#define A2_DMA_V(t, slot) att::glds16(vsrc + (size_t)(t) * KVBLK * QP, (unsigned)__builtin_amdgcn_readfirstlane(vdst + (slot)))
    const lds_cptr shm3 = (lds_cptr)lds; const lds_cptr kp0 = shm3 + L_K + hi * 1024 + r32 * 16; const lds_cptr vp0 = shm3 + L_V + ((lane >> 4) & 1) * 32 + (lane & 3) * 8 + (4 * hi + ((lane & 15) >> 2)) * 64;
    bf16x8 kf[8];
    A2_DMA_K(0, 0); A2_DMA_V(0, 0); A2_DMA_K(1, SLOTB);
    bf16x8 qr[4];
    { const bf16* qp = qkv + (rowbase + qrow) * QP + qcol;
#pragma unroll
      for (int d0 = 0; d0 < 4; ++d0) qr[d0] = *(const bf16x8*)(qp + d0 * 16 + hi * 8); }
    const float cq = (TYPE == T_D) ? c2bh[qrow] : 0.f;
    float mhat = 0.f, l_reg = 0.f; f32x16 o[2]; o[0] = f32x16{}; o[1] = f32x16{};
    bool resc = false;
    A2_DMA_K(2, 2 * SLOTB);
    A2_WAIT_BAR(3);
    unsigned sel = 0u;
    if (TYPE == T_B) {
        float g[16];
#pragma unroll
        for (int n = 0; n < 16; ++n) { g[n] = -INFINITY; if (n < qb) { float s = 0.f;
#pragma unroll
                for (int d0 = 0; d0 < 4; ++d0) { const f32x4 a = *(const A2_LAS f32x4*)(km + n * 64 + 16 * d0 + 8 * hi), c = *(const A2_LAS f32x4*)(km + n * 64 + 16 * d0 + 8 * hi + 4);
                    const bf16x8 qv = qr[d0];
                    s = fmaf(__builtin_bit_cast(float, (unsigned)(unsigned short)qv[0] << 16), a[0], s); s = fmaf(__builtin_bit_cast(float, (unsigned)(unsigned short)qv[1] << 16), a[1], s);
                    s = fmaf(__builtin_bit_cast(float, (unsigned)(unsigned short)qv[2] << 16), a[2], s); s = fmaf(__builtin_bit_cast(float, (unsigned)(unsigned short)qv[3] << 16), a[3], s);
                    s = fmaf(__builtin_bit_cast(float, (unsigned)(unsigned short)qv[4] << 16), c[0], s); s = fmaf(__builtin_bit_cast(float, (unsigned)(unsigned short)qv[5] << 16), c[1], s);
                    s = fmaf(__builtin_bit_cast(float, (unsigned)(unsigned short)qv[6] << 16), c[2], s); s = fmaf(__builtin_bit_cast(float, (unsigned)(unsigned short)qv[7] << 16), c[3], s); }
                g[n] = att::xhalf_sum(s); } }
#pragma unroll
        for (int r = 0; r < 3; ++r) { float best = -INFINITY; int bi = -1;
#pragma unroll
            for (int n = 0; n < 16; ++n) if (n < qb && !((sel >> n) & 1u) && g[n] > best) { best = g[n]; bi = n; }
            if (bi >= 0) sel |= 1u << bi; }
    }
#define A2_CB(tau, CB0, CB1) do { const float base_ = cq - mhat; \
        if (TYPE == T_D) { const A2_LAS float* cp_ = tab + 64 * (tau) + 4 * hi; \
            _Pragma("unroll") for (int r = 0; r < 16; ++r) { CB0[r] = base_ - cp_[att::offr(r)]; CB1[r] = base_ - cp_[att::offr(r) + 32]; } \
        } else { const int k0_ = key0 + 64 * (tau); const bool pick_ = (k0_ < q0) ? ((sel >> (k0_ >> 8)) & 1u) : true; \
            const A2_LAS float* tb_ = pick_ ? tab + (4095 - (qrow - k0_ - 4 * hi)) : tab + TAB_N; \
            _Pragma("unroll") for (int r = 0; r < 16; ++r) { CB0[r] = tb_[att::offr(r)] + base_; CB1[r] = tb_[att::offr(r) + 32] + base_; } } } while (0)
#define A2_CMASK(P0, P1, t) do { const int jb_ = (t) - (NT - 4); if (jb_ >= 0) { const int kb_ = 64 * jb_ + 4 * hi; \
        _Pragma("unroll") for (int r = 0; r < 16; ++r) { const int kv_ = kb_ + att::offr(r); if (kv_ > qrel) P0[r] = -INFINITY; if (kv_ + 32 > qrel) P1[r] = -INFINITY; } } } while (0)
#define A2_DECIDE(C0, C1) do { float a_ = A2_MX3(C0[0], C0[1], C1[0]), b_ = A2_MX3(C0[2], C0[3], C1[1]); a_ = A2_MX3(a_, C1[2], C1[3]); \
        _Pragma("unroll") for (int r = 4; r < 16; r += 4) { a_ = A2_MX3(a_, C0[r], C0[r + 1]); b_ = A2_MX3(b_, C0[r + 2], C0[r + 3]); a_ = A2_MX3(a_, C1[r], C1[r + 1]); b_ = A2_MX3(b_, C1[r + 2], C1[r + 3]); } \
        const float rm_ = att::xhalf_max(__builtin_fmaxf(a_, b_)); \
        resc = false; \
        if (__builtin_expect(__ballot(rm_ > THR) != 0ull, 0)) { const float dl_ = __builtin_fmaxf(rm_, 0.f); mhat += dl_; \
            _Pragma("unroll") for (int r = 0; r < 16; ++r) { C0[r] -= dl_; C1[r] -= dl_; } \
            const float f_ = EX2(-dl_); l_reg *= f_; if (hi == 0) wsf[r32] = f_; resc = true; } } while (0)
#define A2_RESC() do { if (resc) { asm volatile("s_waitcnt lgkmcnt(0)" ::: "memory"); \
        _Pragma("unroll") for (int i = 0; i < 4; ++i) { const f32x4 fr_ = *(const A2_LAS f32x4*)(wsf + 8 * i + 4 * hi); \
            _Pragma("unroll") for (int j = 0; j < 4; ++j) { o[0][4 * i + j] *= fr_[j]; o[1][4 * i + j] *= fr_[j]; } } } } while (0)
    f32x16 pA0, pA1, pB0, pB1;
    int sl_prev = 0, sl_cur = 0, sl_next = SLOTB;
#define A2_ROT() do { sl_prev = sl_cur; sl_cur = sl_next; sl_next = (sl_next == (NSLOT - 1) * SLOTB) ? 0 : sl_next + SLOTB; } while (0)
    { A2_CB(0, pA0, pA1); kload8(kf, kp0);
#pragma unroll
      for (int d0 = 0; d0 < 4; ++d0) { pA0 = A2_MFMA(kf[2 * d0], qr[d0], pA0); pA1 = A2_MFMA(kf[2 * d0 + 1], qr[d0], pA1); } }
    A2_CMASK(pA0, pA1, 0);
    A2_DECIDE(pA0, pA1);
#pragma unroll
    for (int r = 0; r < 16; ++r) { pA0[r] = EX2(pA0[r]); pA1[r] = EX2(pA1[r]); }
    A2_WAIT_BAR(0);
    A2_RESC();
    A2_DMA_K(3, 0); A2_DMA_V(1, SLOTB);
    A2_ROT();
    kload8(kf, kp0 + sl_cur);
    A2_WAIT_BAR(2);
    s16x4 vlo[8], vhi[8]; u32x4 pw0, pw1, pw2, pw3;
#define A2_PKW(P, B) att::cvtpk(P[B], P[B + 1])
#define A2_PAF(k) __builtin_bit_cast(bf16x8, pw##k)
#define A2_VFR(i) (bf16x8){vlo[i][0], vlo[i][1], vlo[i][2], vlo[i][3], vhi[i][0], vhi[i][1], vhi[i][2], vhi[i][3]}
#define A2_PIN(x) asm volatile("" : "+v"(x))
#define A2_GAPA(MF, A0, A1, A2, A3, W0, W1, PW) do { MF; sacc += A0; sacc += A1; sacc += A2; sacc += A3; A2_PIN(sacc); W0; W1; A2_PIN(PW); A2_SBAR(); } while (0)
#define A2_GAPB(MF, X, B) do { MF; X[B] = EX2(X[B]); X[B + 1] = EX2(X[B + 1]); X[B + 2] = EX2(X[B + 2]); X[B + 3] = EX2(X[B + 3]); A2_PIN(X); A2_SBAR(); } while (0)
#define A2_VRD(i) do { vlo[i] = att::vtr(vp_ + (((i) >> 2) * 4096 + ((i) & 3) * 1024)); vhi[i] = att::vtr(vp_ + (((i) >> 2) * 4096 + ((i) & 3) * 1024 + 512)); } while (0)
#define A2_KRD(G, j) do { if (G) { kload2(kf, kp0 + sl_next, j); A2_SBAR(); } } while (0)
#define A2_STEP(C0, C1, P0, P1, t, GK, GV, GL, MASKED) do { A2_SBAR(); \
        A2_CB(t, C0, C1); A2_SBAR();     \
        const lds_cptr vp_ = vp0 + sl_prev; \
        A2_VRD(0); A2_SBAR(); float sacc = (P0[0] + P0[1]); \
        A2_GAPA(C0 = A2_MFMA(kf[0], qr[0], C0), P0[2], P0[3], P0[4], P0[5],     pw0[0] = A2_PKW(P0, 0),  pw0[1] = A2_PKW(P0, 2),  pw0); \
        A2_VRD(4); A2_SBAR(); A2_GAPA(C1 = A2_MFMA(kf[1], qr[0], C1), P0[6], P0[7], P0[8], P0[9],     pw0[2] = A2_PKW(P0, 4),  pw0[3] = A2_PKW(P0, 6),  pw0); \
        A2_VRD(1); A2_SBAR(); A2_GAPA(C0 = A2_MFMA(kf[2], qr[1], C0),   P0[10], P0[11], P0[12], P0[13], pw1[0] = A2_PKW(P0, 8),  pw1[1] = A2_PKW(P0, 10), pw1); \
        A2_VRD(5); A2_SBAR(); A2_GAPA(C1 = A2_MFMA(kf[3], qr[1], C1),   P0[14], P0[15], P1[0], P1[1],   pw1[2] = A2_PKW(P0, 12), pw1[3] = A2_PKW(P0, 14), pw1); \
        A2_VRD(2); A2_SBAR(); A2_GAPA(C0 = A2_MFMA(kf[4], qr[2], C0),   P1[2], P1[3], P1[4], P1[5],     pw2[0] = A2_PKW(P1, 0),  pw2[1] = A2_PKW(P1, 2),  pw2); \
        A2_VRD(6); A2_SBAR(); A2_GAPA(C1 = A2_MFMA(kf[5], qr[2], C1),   P1[6], P1[7], P1[8], P1[9],     pw2[2] = A2_PKW(P1, 4),  pw2[3] = A2_PKW(P1, 6),  pw2); \
        A2_VRD(3); A2_SBAR(); A2_GAPA(C0 = A2_MFMA(kf[6], qr[3], C0),   P1[10], P1[11], P1[12], P1[13], pw3[0] = A2_PKW(P1, 8),  pw3[1] = A2_PKW(P1, 10), pw3); \
        A2_VRD(7); A2_SBAR(); A2_GAPA(C1 = A2_MFMA(kf[7], qr[3], C1),   P1[14], P1[15], 0.f, 0.f,       pw3[2] = A2_PKW(P1, 12), pw3[3] = A2_PKW(P1, 14), pw3); \
        l_reg += sacc; \
        if (GK) { A2_DMA_K((t) + 3, sl_cur); } if (GV) { A2_DMA_V((t) + 1, sl_next); } \
        if (MASKED) A2_CMASK(C0, C1, t); \
        A2_DECIDE(C0, C1); \
        A2_SBAR(); \
        A2_GAPB(o[0] = A2_MFMA(A2_PAF(0), A2_VFR(0), o[0]), C0, 0); \
        A2_GAPB(o[1] = A2_MFMA(A2_PAF(0), A2_VFR(4), o[1]), C0, 4); \
        A2_KRD(GL, 0); A2_GAPB(o[0] = A2_MFMA(A2_PAF(1), A2_VFR(1), o[0]), C0, 8); \
        A2_KRD(GL, 1); A2_GAPB(o[1] = A2_MFMA(A2_PAF(1), A2_VFR(5), o[1]), C0, 12); \
        A2_KRD(GL, 2); A2_GAPB(o[0] = A2_MFMA(A2_PAF(2), A2_VFR(2), o[0]), C1, 0); \
        A2_KRD(GL, 3); A2_GAPB(o[1] = A2_MFMA(A2_PAF(2), A2_VFR(6), o[1]), C1, 4); \
        A2_GAPB(o[0] = A2_MFMA(A2_PAF(3), A2_VFR(3), o[0]), C1, 8); \
        A2_GAPB(o[1] = A2_MFMA(A2_PAF(3), A2_VFR(7), o[1]), C1, 12); \
    } while (0)
    int t = 1;
    for (; t + 5 < NT; t += 2) {
        A2_STEP(pB0, pB1, pA0, pA1, t, true, true, true, false);     A2_WAIT_BAR(2); A2_RESC(); A2_ROT();
        A2_STEP(pA0, pA1, pB0, pB1, t + 1, true, true, true, false); A2_WAIT_BAR(2); A2_RESC(); A2_ROT();
    }
#define A2_ENDW(tt) do { if ((tt) + 3 < NT) { A2_WAIT_BAR(2); } else if ((tt) + 2 < NT) { A2_WAIT_BAR(1); } else { A2_WAIT_BAR(0); } } while (0)
    for (; t + 1 < NT; t += 2) {
        A2_STEP(pB0, pB1, pA0, pA1, t, (t + 3 < NT), (t + 1 < NT), (t + 1 < NT), true);         A2_ENDW(t);     A2_RESC(); A2_ROT();
        A2_STEP(pA0, pA1, pB0, pB1, t + 1, (t + 4 < NT), (t + 2 < NT), (t + 2 < NT), true);     A2_ENDW(t + 1); A2_RESC(); A2_ROT();
    }
    A2_STEP(pB0, pB1, pA0, pA1, NT - 1, false, false, false, true); A2_RESC();
    { float sacc = pB0[0] + pB0[1];
#pragma unroll
      for (int r = 2; r < 16; ++r) sacc += pB0[r];
#pragma unroll
      for (int r = 0; r < 16; ++r) sacc += pB1[r];
      l_reg += sacc;
      pw0 = (u32x4){A2_PKW(pB0, 0), A2_PKW(pB0, 2), A2_PKW(pB0, 4), A2_PKW(pB0, 6)}; pw1 = (u32x4){A2_PKW(pB0, 8), A2_PKW(pB0, 10), A2_PKW(pB0, 12), A2_PKW(pB0, 14)};
      pw2 = (u32x4){A2_PKW(pB1, 0), A2_PKW(pB1, 2), A2_PKW(pB1, 4), A2_PKW(pB1, 6)}; pw3 = (u32x4){A2_PKW(pB1, 8), A2_PKW(pB1, 10), A2_PKW(pB1, 12), A2_PKW(pB1, 14)};
      A2_SBAR();
      const lds_cptr vp_ = vp0 + sl_cur;
#pragma unroll
      for (int i = 0; i < 8; ++i) A2_VRD(i);
      o[0] = A2_MFMA(A2_PAF(0), A2_VFR(0), o[0]); o[0] = A2_MFMA(A2_PAF(1), A2_VFR(1), o[0]); o[0] = A2_MFMA(A2_PAF(2), A2_VFR(2), o[0]); o[0] = A2_MFMA(A2_PAF(3), A2_VFR(3), o[0]);
      o[1] = A2_MFMA(A2_PAF(0), A2_VFR(4), o[1]); o[1] = A2_MFMA(A2_PAF(1), A2_VFR(5), o[1]); o[1] = A2_MFMA(A2_PAF(2), A2_VFR(6), o[1]); o[1] = A2_MFMA(A2_PAF(3), A2_VFR(7), o[1]); }
    l_reg = att::xhalf_sum(l_reg);
    if (hi == 0) wsf[32 + r32] = 1.0f / l_reg;
    asm volatile("s_waitcnt lgkmcnt(0)" ::: "memory");
    {   A2_LAS bf16* stg = (A2_LAS bf16*)(lds + L_OST) + wid * 2048;
#pragma unroll
        for (int i = 0; i < 4; ++i) { const f32x4 rl = *(const A2_LAS f32x4*)(wsf + 32 + 8 * i + 4 * hi);
#pragma unroll
            for (int j = 0; j < 4; ++j) { const int orow = 8 * i + 4 * hi + j;
#pragma unroll
                for (int d0 = 0; d0 < 2; ++d0) { const unsigned w = att::cvtpk(o[d0][4 * i + j] * rl[j], 0.f); stg[orow * 64 + d0 * 32 + r32] = (bf16)(w & 0xffffu); } } }
        asm volatile("s_waitcnt lgkmcnt(0)" ::: "memory");
#pragma unroll
        for (int i = 0; i < 4; ++i) { const int row = i * 8 + (lane >> 3), ch = lane & 7; const u32x4 v = *(const A2_LAS u32x4*)(stg + row * 64 + ch * 8);
            *(u32x4*)(outp + (rowbase + q0 + wid * QBLK + row) * ldo + ch * 8) = v; }
    }
    asm volatile("s_waitcnt lgkmcnt(0)\n\ts_barrier" ::: "memory");
#undef A2_DMA_K
#undef A2_DMA_V
#undef A2_CB
#undef A2_CMASK
#undef A2_DECIDE
#undef A2_RESC
#undef A2_ROT
#undef A2_PKW
#undef A2_PAF
#undef A2_VFR
#undef A2_PIN
#undef A2_GAPA
#undef A2_GAPB
#undef A2_VRD
#undef A2_KRD
#undef A2_STEP
#undef A2_ENDW
}
}

namespace att3 {
#define A3_LAS __attribute__((address_space(3)))
typedef att::bf16x8 bf16x8; typedef att::s16x4 s16x4; typedef att::f32x16 f32x16; typedef att::f32x4 f32x4; typedef att::u32x4 u32x4; typedef unsigned short bf16;
constexpr int S = 4096, QP = 2816, SLOTB = 8192;
constexpr int L_K = 0, L_V = 6 * SLOTB, L_WS = 12 * SLOTB, L_TAB = L_WS + 2048, TAB_N = 5600, L_END = L_TAB + TAB_N * 4;
static_assert(L_TAB % 16 == 0 && L_END <= 131072, "attention engine 3 LDS map");
#define A3_MFMA(a, b, c) __builtin_amdgcn_mfma_f32_32x32x16_bf16(a, b, c, 0, 0, 0)

struct BandSrc { const bf16* k; const bf16* v; int rs, kw, tmin; };
__device__ __forceinline__ void band_dma(unsigned lds_region, const bf16* src, int rs, int kw, int tmin, bool isV, int wid, int lane) {
    for (int t = tmin; t < 6; ++t) { const int k0 = kw + 64 * t;
        if (!isV) att::glds16(src + (size_t)(k0 + lane) * rs + wid * 8, (unsigned)__builtin_amdgcn_readfirstlane(lds_region + t * SLOTB + wid * 1024));
        else att::glds16(src + (size_t)(k0 + 16 * (wid & 3) + (lane >> 2)) * rs + (wid >> 2) * 32 + (lane & 3) * 8, (unsigned)__builtin_amdgcn_readfirstlane(lds_region + t * SLOTB + wid * 1024)); }
}
#define A3_WAITV(n4, n6) do { if (n4) asm volatile("s_waitcnt vmcnt(4)" ::: "memory"); else if (n6) asm volatile("s_waitcnt vmcnt(6)" ::: "memory"); else asm volatile("s_waitcnt vmcnt(0)" ::: "memory"); } while (0)
template <int DIL>
__device__ __forceinline__ void attn_band(A3_LAS unsigned char* lds, const bf16* qkv, int b, int h, int qb, int res, int W, int qcol, int kcol, int vcol,
                                          const float* tabg, int tab_id, int& cur_tab, float sink2, bf16* outp, int ldo, float* lse_out, const BandSrc nx, const bool nxt) {
    int tid_ = threadIdx.x; asm volatile("" : "+v"(tid_));
    const int tid = tid_, lane = tid & 63, r32 = lane & 31, hi = lane >> 5; const int wid = __builtin_amdgcn_readfirstlane(tid >> 6);
    const size_t rowbase = (size_t)b * S + res;
    const int q0 = 256 * qb, kw = q0 - 128, tmin = (qb == 0) ? 2 : 0, ta = wid >> 1;
    A3_LAS float* tab = (A3_LAS float*)(lds + L_TAB);
    A3_LAS float* wsf = (A3_LAS float*)(lds + L_WS) + wid * 64;
    const unsigned lds0 = (unsigned)(uintptr_t)lds;
    if (tab_id != cur_tab) { cur_tab = tab_id; for (int i = tid; i < TAB_N; i += 512) tab[i] = (i < 4096 && 4095 - i <= W * DIL) ? tabg[4095 - i] : -INFINITY; }
    const int qfw = q0 + 32 * wid;
    bf16x8 qr[4];
    { const bf16* qrow = qkv + (rowbase + (size_t)(qfw + r32) * DIL) * QP + qcol;
#pragma unroll
      for (int d0 = 0; d0 < 4; ++d0) qr[d0] = *(const bf16x8*)(qrow + 16 * d0 + 8 * hi); }
    A3_WAITV(tmin == 2, tmin == 0);
    __syncthreads();
    f32x16 p[3][2];
#pragma unroll
    for (int i = 0; i < 3; ++i) {
        const int t = ta + i;
        if (t >= tmin) {
            const A3_LAS char* kb = (const A3_LAS char*)(lds + L_K + t * SLOTB) + hi * 1024 + r32 * 16;
            f32x16& a0 = p[i][0]; f32x16& a1 = p[i][1];
#pragma unroll
            for (int d0 = 0; d0 < 4; ++d0) { const bf16x8 b0 = *(const A3_LAS bf16x8*)(kb + d0 * 2048), b1 = *(const A3_LAS bf16x8*)(kb + d0 * 2048 + 512);
                if (d0 == 0) { a0 = A3_MFMA(b0, qr[0], f32x16{}); a1 = A3_MFMA(b1, qr[0], f32x16{}); } else { a0 = A3_MFMA(b0, qr[d0], a0); a1 = A3_MFMA(b1, qr[d0], a1); } }
            const int d0l = qfw + r32 - (kw + 64 * t) - 4 * hi;
            const A3_LAS float* tb = tab + (4095 - DIL * d0l);
#pragma unroll
            for (int r = 0; r < 16; ++r) { a0[r] += tb[DIL * att::offr(r)]; a1[r] += tb[DIL * (att::offr(r) + 32)]; }
        }
    }
    __syncthreads();
    if (nxt) band_dma(lds0 + L_K, nx.k, nx.rs, nx.kw, nx.tmin, false, wid, lane);
    float m = -INFINITY, m2 = -INFINITY;
#pragma unroll
    for (int i = 0; i < 3; ++i) { if (ta + i >= tmin) {
#pragma unroll
        for (int r = 0; r < 16; r += 2) { m = __builtin_fmaxf(__builtin_fmaxf(m, p[i][0][r]), p[i][0][r + 1]); m2 = __builtin_fmaxf(__builtin_fmaxf(m2, p[i][1][r]), p[i][1][r + 1]); } } }
    m = __builtin_fmaxf(m, m2);
    m = att::xhalf_max(m);
    const float negm = -m;
    if (nxt) A3_WAITV(nx.tmin == 2, nx.tmin == 0); else A3_WAITV(false, false);
    __syncthreads();
    float l = 0.f; f32x16 o[2]; o[0] = f32x16{}; o[1] = f32x16{};
    const int vpo = ((lane >> 4) & 1) * 32 + (lane & 3) * 8 + (4 * hi + ((lane & 15) >> 2)) * 64;
#pragma unroll
    for (int i = 0; i < 3; ++i) {
        const int t = ta + i;
        if (t >= tmin) {
            float sacc = 0.f;
#pragma unroll
            for (int r = 0; r < 16; ++r) { p[i][0][r] = EX2(p[i][0][r] + negm); p[i][1][r] = EX2(p[i][1][r] + negm); sacc += p[i][0][r] + p[i][1][r]; }
            l += sacc;
            u32x4 pw[4];
#pragma unroll
            for (int j = 0; j < 4; ++j) { pw[0][j] = att::cvtpk(p[i][0][2 * j], p[i][0][2 * j + 1]); pw[1][j] = att::cvtpk(p[i][0][8 + 2 * j], p[i][0][9 + 2 * j]); pw[2][j] = att::cvtpk(p[i][1][2 * j], p[i][1][2 * j + 1]); pw[3][j] = att::cvtpk(p[i][1][8 + 2 * j], p[i][1][9 + 2 * j]); }
            const A3_LAS char* vp = (const A3_LAS char*)(lds + L_V + t * SLOTB) + vpo;
#pragma unroll
            for (int d0 = 0; d0 < 2; ++d0)
#pragma unroll
                for (int ks = 0; ks < 4; ++ks) { const s16x4 lo = att::vtr(vp + d0 * 4096 + ks * 1024), hh = att::vtr(vp + d0 * 4096 + ks * 1024 + 512);
                    const bf16x8 vf = (bf16x8){lo[0], lo[1], lo[2], lo[3], hh[0], hh[1], hh[2], hh[3]};
                    o[d0] = A3_MFMA(__builtin_bit_cast(bf16x8, pw[ks]), vf, o[d0]); }
        }
    }
    l = att::xhalf_sum(l);
    l += EX2(sink2 - m);
    if (hi == 0) wsf[32 + r32] = 1.0f / l;
    __syncthreads();
    {   A3_LAS bf16* stg = (A3_LAS bf16*)(lds + L_V) + wid * 2048;
#pragma unroll
        for (int i = 0; i < 4; ++i) { const f32x4 rl = *(const A3_LAS f32x4*)(wsf + 32 + 8 * i + 4 * hi);
#pragma unroll
            for (int j = 0; j < 4; ++j) { const int orow = 8 * i + 4 * hi + j;
#pragma unroll
                for (int d0 = 0; d0 < 2; ++d0) { const unsigned w = att::cvtpk(o[d0][4 * i + j] * rl[j], 0.f); stg[orow * 64 + d0 * 32 + r32] = (bf16)(w & 0xffffu); } } }
        asm volatile("s_waitcnt lgkmcnt(0)" ::: "memory");
#pragma unroll
        for (int i = 0; i < 4; ++i) { const int row = i * 8 + (lane >> 3), ch = lane & 7; const u32x4 v = *(const A3_LAS u32x4*)(stg + row * 64 + ch * 8);
            *(u32x4*)(outp + (rowbase + (size_t)(qfw + row) * DIL) * ldo + ch * 8) = v; }
    }
    if (lse_out != nullptr && hi == 0) lse_out[(rowbase + (size_t)(qfw + r32) * DIL) * 4] = m + __builtin_amdgcn_logf(l);
    asm volatile("s_waitcnt lgkmcnt(0)" ::: "memory"); __syncthreads();
    if (nxt) band_dma(lds0 + L_V, nx.v, nx.rs, nx.kw, nx.tmin, true, wid, lane);
}
}

#ifndef PG8_SP2
#define PG8_SP2 true
#endif
#ifndef PG8_ALIGN
#define PG8_ALIGN true
#endif

constexpr int NWAVES = 8;
constexpr int NB = 8, S = 4096, DM = 1024, M = NB * S, HD = 64, QP = 2816, NIN = 2820, DFF = 2816, NGU = 5632, DEPTH = 2;
constexpr float LOG2E = 1.4426950408889634f, C2 = 0.125f * LOG2E, EPS = 1e-6f;
constexpr int C_QA = 0, C_KA = 256, C_VA = 512, C_QB = 768, C_KB = 1024, C_VB = 1280, C_QC = 1536, C_KC = 1792, C_VC = 1920, C_QD = 2048, C_KD = 2304, C_VD = 2560;
constexpr int NPHASE = 14, PH_PER_LAYER = 6;
constexpr int N_LAUNCHES = MK_N_LAUNCHES;

constexpr size_t MiB = 1u << 20;
constexpr size_t WS_CTL = 0, CTL_ZERO_BYTES = 1 * MiB;
constexpr size_t WS_WIN = 1 * MiB;
constexpr size_t WS_WOUT = 12 * MiB;
constexpr size_t WS_WGU = 16 * MiB;
constexpr size_t WS_WDN = 38 * MiB;
constexpr size_t WS_SMALL = 49 * MiB;
constexpr size_t WS_WFD = WS_SMALL;
constexpr size_t WS_BIAST = WS_SMALL + 64 * 1024;
constexpr size_t WS_RSTD = WS_SMALL + 256 * 1024;
constexpr size_t WS_LF = WS_SMALL + 512 * 1024;
constexpr size_t WS_C2 = WS_SMALL + 1024 * 1024;
constexpr size_t WS_KMEAN = WS_SMALL + 1536 * 1024;
constexpr size_t WS_XB = 52 * MiB;
constexpr size_t WS_MIX = 116 * MiB;
constexpr size_t WS_QKV = 180 * MiB;
constexpr size_t WS_PA = 356 * MiB;
constexpr size_t WS_LSE = 404 * MiB;
constexpr size_t WS_SS = 406 * MiB;
constexpr size_t WS_FD = 408 * MiB;
constexpr size_t WS_X8 = 416 * MiB;
constexpr size_t WS_MIX8 = 448 * MiB;
constexpr size_t WS_END = 480 * MiB;
constexpr float WSCALE = 64.0f, ASCALE = 8.0f;
constexpr int CW_BAR = 4096, CW_NORM = 16384, CW_KMEAN = 65536;
constexpr int CW_UNUSED_ = 0;

constexpr int RING_OFF = 0, RING_BYTES = 131072;
constexpr int LDSCTL_OFF = RING_BYTES, MISC_OFF = LDSCTL_OFF + 320;
constexpr int LDS_BYTES = 147456;

#define GAS __attribute__((address_space(1)))
#define LAS __attribute__((address_space(3)))
typedef unsigned short bf16;
typedef unsigned v4u __attribute__((ext_vector_type(4)));
typedef float f32x4 __attribute__((ext_vector_type(4)));
typedef GAS unsigned gu32;
#define RLX_AGENT __ATOMIC_RELAXED, __HIP_MEMORY_SCOPE_AGENT
#define LDS_WAIT() asm volatile("s_waitcnt lgkmcnt(0)" ::: "memory")
__device__ __forceinline__ unsigned f2bf(float f) { unsigned u = __builtin_bit_cast(unsigned, f); return (u + 0x7fffu + ((u >> 16) & 1u)) >> 16; }
__device__ __forceinline__ unsigned pk2(float lo, float hi) { return f2bf(lo) | (f2bf(hi) << 16); }
__device__ __forceinline__ float bflo(unsigned w) { return __builtin_bit_cast(float, w << 16); }
__device__ __forceinline__ float bfhi(unsigned w) { return __builtin_bit_cast(float, w & 0xffff0000u); }

#define XB_TMO      128
#define XB_XCNT(j)  (256  + 64 * (j))
#define XB_XSUB(j)  (1280 + 64 * (j))
#define XB_XGEN(j)  (2304 + 64 * (j))
#define XB_TOP      3328
#define XB_TOPGEN   3392
#define XCD_BAR_WORDS 3456
#define XB_SPIN_CAP (1u << 18)

__device__ __forceinline__ unsigned xb_ld(unsigned* p)              { return __hip_atomic_load(p, __ATOMIC_RELAXED, __HIP_MEMORY_SCOPE_AGENT); }
__device__ __forceinline__ unsigned xb_add(unsigned* p, unsigned v) { return __hip_atomic_fetch_add(p, v, __ATOMIC_RELAXED, __HIP_MEMORY_SCOPE_AGENT); }
__device__ __forceinline__ unsigned xb_xcc_id() { return (unsigned)__builtin_amdgcn_s_getreg((3 << 11) | 20) & 0xFu; }
#define XB_SPIN(cond, bar) do { unsigned _sp = 0; while (cond) { __builtin_amdgcn_s_sleep(1); \
    if ((++_sp & 255u) == 0u) { if (xb_ld(&(bar)[XB_TMO])) break; if (_sp > XB_SPIN_CAP) { atomicAdd(&(bar)[XB_TMO], 1u); break; } } } } while (0)

struct XcdBarrier {
    unsigned* bar; unsigned x;
    volatile LAS unsigned* st;
};

__device__ __forceinline__ XcdBarrier xcd_barrier_post(unsigned* bar, volatile LAS unsigned* st) {
    XcdBarrier b; b.bar = bar; b.x = xb_xcc_id(); b.st = st;
    if (threadIdx.x == 0) (void)xb_add(&bar[XB_XCNT(b.x)], 1u);
    return b;
}
__device__ __forceinline__ void xcd_barrier_complete(unsigned* bar, unsigned x, unsigned& nloc, unsigned& nx) {
    const unsigned G = gridDim.x * gridDim.y * gridDim.z;
    unsigned sum, cnt, mine, sp = 0u;
    for (;;) {
        sum = 0u; cnt = 0u; mine = 0u;
#pragma unroll
        for (unsigned j = 0; j < 16; ++j) { const unsigned c = xb_ld(&bar[XB_XCNT(j)]); sum += c; cnt += (c > 0u) ? 1u : 0u; mine = (j == x) ? c : mine; }
        if (sum == G) break;
        __builtin_amdgcn_s_sleep(1);
        if ((++sp & 255u) == 0u) { if (xb_ld(&bar[XB_TMO])) break; if (sp > XB_SPIN_CAP) { atomicAdd(&bar[XB_TMO], 1u); break; } }
    }
    nloc = mine > 0u ? mine : 1u; nx = cnt > 0u ? cnt : 1u;
}

__device__ __forceinline__ void xcd_barrier(const XcdBarrier& b) {
    asm volatile("s_waitcnt vmcnt(0)" ::: "memory");
    __syncthreads();
    if (threadIdx.x == 0) {
        unsigned* bar = b.bar;
        __builtin_amdgcn_s_waitcnt(0);
        unsigned nloc = b.st[0], nx = b.st[1];
        if (nloc == 0u) { xcd_barrier_complete(bar, b.x, nloc, nx); b.st[0] = nloc; b.st[1] = nx; }
        const unsigned old = xb_add(&bar[XB_XSUB(b.x)], 1u);
        const unsigned gen = old / nloc;
        if (old + 1u == (gen + 1u) * nloc) {
            __builtin_amdgcn_fence(__ATOMIC_RELEASE, "agent");
            asm volatile("s_waitcnt vmcnt(0)" ::: "memory");
            const unsigned og = xb_add(&bar[XB_TOP], 1u);
            const unsigned tg = og / nx;
            if (og + 1u == (tg + 1u) * nx) xb_add(&bar[XB_TOPGEN], 1u);
            else XB_SPIN(xb_ld(&bar[XB_TOPGEN]) == tg, bar);
            __builtin_amdgcn_fence(__ATOMIC_ACQUIRE, "agent");
            xb_add(&bar[XB_XGEN(b.x)], 1u);
            asm volatile("s_waitcnt vmcnt(0)" ::: "memory");
        } else {
            XB_SPIN(xb_ld(&bar[XB_XGEN(b.x)]) == gen, bar);
            __builtin_amdgcn_fence(__ATOMIC_ACQUIRE, "agent");
            asm volatile("s_waitcnt vmcnt(0)" ::: "memory");
        }
    }
    __syncthreads();
}


__device__ __forceinline__ float wave_sum(float v) {
#pragma unroll
    for (int o = 1; o < 64; o <<= 1) v += __shfl_xor(v, o);
    return v;
}

__device__ __forceinline__ void tr_item(const float* W, int ldw, int K, const float* g, bf16* WT, int k0, int n0, int drow0, LAS float* scr, int lane) {
    float v[32];
#pragma unroll
    for (int i = 0; i < 32; ++i) { const int kk = 2 * i + (lane >> 5); v[i] = W[(size_t)(k0 + kk) * ldw + n0 + (lane & 31)]; }
    if (g) {
#pragma unroll
        for (int i = 0; i < 32; ++i) v[i] *= g[k0 + 2 * i + (lane >> 5)];
    }
#pragma unroll
    for (int i = 0; i < 32; ++i) scr[(2 * i + (lane >> 5)) * 33 + (lane & 31)] = v[i];
    LDS_WAIT(); asm volatile("" ::: "memory");
    const int c = lane & 7;
#pragma unroll
    for (int j = 0; j < 4; ++j) { const int n = (lane >> 3) + 8 * j; const LAS float* s = scr + (8 * c) * 33 + n;
        v4u o; o.x = pk2(s[0 * 33], s[1 * 33]); o.y = pk2(s[2 * 33], s[3 * 33]); o.z = pk2(s[4 * 33], s[5 * 33]); o.w = pk2(s[6 * 33], s[7 * 33]);
        *(GAS v4u*)(WT + (size_t)(drow0 + n) * K + k0 + 8 * c) = o; }
    LDS_WAIT(); asm volatile("" ::: "memory");
}
__device__ __forceinline__ void tr_item8(const float* W, int ldw, int K, const float* g, float sc, unsigned char* WT8, int k0, int n0, int drow0, LAS float* scr, int lane) {
    float v[32];
#pragma unroll
    for (int i = 0; i < 32; ++i) { const int kk = 2 * i + (lane >> 5); v[i] = W[(size_t)(k0 + kk) * ldw + n0 + (lane & 31)]; }
#pragma unroll
    for (int i = 0; i < 32; ++i) v[i] *= g ? g[k0 + 2 * i + (lane >> 5)] * sc : sc;
#pragma unroll
    for (int i = 0; i < 32; ++i) scr[(2 * i + (lane >> 5)) * 33 + (lane & 31)] = v[i];
    LDS_WAIT(); asm volatile("" ::: "memory");
    const int c = lane & 3;
#pragma unroll
    for (int j = 0; j < 2; ++j) { const int n = (lane >> 2) + 16 * j; const LAS float* s = scr + (16 * c) * 33 + n;
        v4u o; o.x = pg8::pk4_fp8(s[0 * 33], s[1 * 33], s[2 * 33], s[3 * 33]); o.y = pg8::pk4_fp8(s[4 * 33], s[5 * 33], s[6 * 33], s[7 * 33]);
        o.z = pg8::pk4_fp8(s[8 * 33], s[9 * 33], s[10 * 33], s[11 * 33]); o.w = pg8::pk4_fp8(s[12 * 33], s[13 * 33], s[14 * 33], s[15 * 33]);
        *(GAS v4u*)(WT8 + (size_t)(drow0 + n) * K + k0 + 16 * c) = o; }
    LDS_WAIT(); asm volatile("" ::: "memory");
}
__device__ __forceinline__ int t5_bucket(int n) {
    if (n < 16) return n;
    int b = 16;
    b += (n >= 22); b += (n >= 30); b += (n >= 40); b += (n >= 54); b += (n >= 73); b += (n >= 99); b += (n >= 134); b += (n >= 182);
    b += (n >= 246); b += (n >= 332); b += (n >= 450); b += (n >= 609); b += (n >= 825); b += (n >= 1117); b += (n >= 1513);
    return b;
}

struct Ptrs {
    const float *x, *norm1_g, *w_in, *f_bias, *sinks, *mix_g, *w_out, *norm2_g, *w_gate, *w_up, *w_down, *rel_bias, *final_g;
    float* out; unsigned char* ws;
};

__device__ __forceinline__ void phase_prep(const Ptrs& P, LAS unsigned char* lds, int it_lo, int it_hi, bool tables, int gw, int NGW, int wave, int lane) {
    LAS float* scr = (LAS float*)(lds + RING_OFF + wave * 16384);
    constexpr int I_IN = 16 * 88, I_OUT = 16 * 32, I_G = 16 * 88, I_DN = 44 * 32, I_LAYER = I_IN + I_OUT + 2 * I_G + I_DN;
    for (int it = it_lo * I_LAYER + gw; it < it_hi * I_LAYER; it += NGW) {
        const int l = it / I_LAYER; int r = it % I_LAYER;
        if (r < I_IN) { const int kb = r / 88, nb = r % 88; tr_item(P.w_in + (size_t)l * DM * NIN, NIN, DM, P.norm1_g + l * DM, (bf16*)(P.ws + WS_WIN) + (size_t)l * QP * DM, 64 * kb, 32 * nb, 32 * nb, scr, lane); continue; } r -= I_IN;
        if (r < I_OUT) { const int kb = r / 32, nb = r % 32;
            if (G2_FP8) tr_item8(P.w_out + (size_t)l * DM * DM, DM, DM, P.mix_g + l * DM, WSCALE, P.ws + WS_WOUT + (size_t)l * DM * DM, 64 * kb, 32 * nb, 32 * nb, scr, lane);
            else tr_item(P.w_out + (size_t)l * DM * DM, DM, DM, P.mix_g + l * DM, (bf16*)(P.ws + WS_WOUT) + (size_t)l * DM * DM, 64 * kb, 32 * nb, 32 * nb, scr, lane);
            continue; } r -= I_OUT;
        if (r < I_G) { const int kb = r / 88, nb = r % 88, n0 = 32 * nb; tr_item8(P.w_gate + (size_t)l * DM * DFF, DFF, DM, P.norm2_g + l * DM, WSCALE, P.ws + WS_WGU + (size_t)l * NGU * DM, 64 * kb, n0, 256 * (n0 / 128) + (n0 % 128), scr, lane); continue; } r -= I_G;
        if (r < I_G) { const int kb = r / 88, nb = r % 88, n0 = 32 * nb; tr_item8(P.w_up + (size_t)l * DM * DFF, DFF, DM, P.norm2_g + l * DM, WSCALE, P.ws + WS_WGU + (size_t)l * NGU * DM, 64 * kb, n0, 256 * (n0 / 128) + 128 + (n0 % 128), scr, lane); continue; } r -= I_G;
        { const int kb = r / 32, nb = r % 32; tr_item8(P.w_down + (size_t)l * DFF * DM, DM, DFF, nullptr, WSCALE, P.ws + WS_WDN + (size_t)l * DM * DFF, 64 * kb, 32 * nb, 32 * nb, scr, lane); }
    }
    if (!tables) return;
    const int gt = gw * 64 + lane, NGT = NGW * 64;
    float* biasT = (float*)(P.ws + WS_BIAST);
    for (int i = gt; i < 12 * 4096; i += NGT) { const int col = i >> 12, dist = i & 4095; biasT[i] = P.rel_bias[t5_bucket(dist) * 12 + col] * LOG2E; }
    unsigned* wfd = (unsigned*)(P.ws + WS_WFD);
    for (int i = gt; i < DEPTH * (DM / 2) * 4; i += NGT) { const int l = i / (DM * 2), k = 2 * ((i / 4) % (DM / 2)), h = i & 3;
        wfd[i] = pg8::cvt_pk_bf16(P.norm1_g[l * DM + k] * P.w_in[((size_t)l * DM + k) * NIN + 2816 + h], P.norm1_g[l * DM + k + 1] * P.w_in[((size_t)l * DM + k + 1) * NIN + 2816 + h]); }
}

template <bool WITH_FD>
__device__ __forceinline__ void row_pass(const float* xin, bf16* xb, float* rstd, const LAS float* wfd, const float* fbias, float* lf, int gw, int NGW, int lane) {
    f32x4 nx[4];
    if (gw < M) { const GAS f32x4* xr = (const GAS f32x4*)(xin + (size_t)gw * DM) + lane;
#pragma unroll
        for (int j = 0; j < 4; ++j) nx[j] = xr[64 * j]; }
    for (int m = gw; m < M; m += NGW) {
        f32x4 v[4]; float s = 0.f;
#pragma unroll
        for (int j = 0; j < 4; ++j) v[j] = nx[j];
        if (m + NGW < M) { const GAS f32x4* xr = (const GAS f32x4*)(xin + (size_t)(m + NGW) * DM) + lane;
#pragma unroll
            for (int j = 0; j < 4; ++j) nx[j] = xr[64 * j]; }
#pragma unroll
        for (int j = 0; j < 4; ++j) s += (v[j].x * v[j].x + v[j].y * v[j].y) + (v[j].z * v[j].z + v[j].w * v[j].w);
        const float wave_sum_keep = wave_sum(s);
        const float rs = 1.0f / sqrtf(wave_sum_keep * (1.0f / DM) + EPS);
        GAS unsigned long long* o8 = (GAS unsigned long long*)(xb + (size_t)m * DM) + lane;
#pragma unroll
        for (int j = 0; j < 4; ++j) o8[64 * j] = (unsigned long long)pk2(v[j].x, v[j].y) | ((unsigned long long)pk2(v[j].z, v[j].w) << 32);
        if (WITH_FD) {
            float f0 = 0.f, f1 = 0.f, f2 = 0.f, f3 = 0.f;
#pragma unroll
            for (int j = 0; j < 4; ++j)
#pragma unroll
                for (int i = 0; i < 4; ++i) { const f32x4 w = *(const LAS f32x4*)(wfd + (4 * lane + 256 * j + i) * 4); const float xv = v[j][i]; f0 += xv * w.x; f1 += xv * w.y; f2 += xv * w.z; f3 += xv * w.w; }
            f0 = wave_sum(f0); f1 = wave_sum(f1); f2 = wave_sum(f2); f3 = wave_sum(f3);
            if (lane < 4) { const float f = lane == 0 ? f0 : lane == 1 ? f1 : lane == 2 ? f2 : f3; const float z = f * rs + fbias[lane];
                lf[(size_t)lane * M + m] = fminf(z, 0.f) - log1pf(expf(-fabsf(z))); }
        }
        if (lane < 16) rstd[(size_t)m * 16 + lane] = (lane == 0) ? wave_sum_keep : 0.f;
    }
}
__device__ __forceinline__ void final_pass(const bf16* xb, float* out, const float* g, const float* ss, int gw, int NGW, int lane) {
    v4u na = {0u, 0u, 0u, 0u}, nb = {0u, 0u, 0u, 0u}; float ns = 0.f;
    if (gw < M) { const GAS v4u* p = (const GAS v4u*)(xb + (size_t)gw * DM) + 2 * lane; na = p[0]; nb = p[1]; ns = lane < 16 ? ss[(size_t)gw * 16 + lane] : 0.f; }
    for (int m = gw; m < M; m += NGW) {
        const v4u a = na, b = nb; const float sv = ns; float f[16];
        if (m + NGW < M) { const GAS v4u* p = (const GAS v4u*)(xb + (size_t)(m + NGW) * DM) + 2 * lane; na = p[0]; nb = p[1]; ns = lane < 16 ? ss[(size_t)(m + NGW) * 16 + lane] : 0.f; }
        f[0] = bflo(a.x); f[1] = bfhi(a.x); f[2] = bflo(a.y); f[3] = bfhi(a.y); f[4] = bflo(a.z); f[5] = bfhi(a.z); f[6] = bflo(a.w); f[7] = bfhi(a.w);
        f[8] = bflo(b.x); f[9] = bfhi(b.x); f[10] = bflo(b.y); f[11] = bfhi(b.y); f[12] = bflo(b.z); f[13] = bfhi(b.z); f[14] = bflo(b.w); f[15] = bfhi(b.w);
        const float s = wave_sum(sv);
        const float rs = 1.0f / sqrtf(s * (1.0f / DM) + EPS);
        GAS f32x4* o = (GAS f32x4*)(out + (size_t)m * DM) + 4 * lane; const f32x4* gv = (const f32x4*)g + 4 * lane;
#pragma unroll
        for (int j = 0; j < 4; ++j) { const f32x4 gg = gv[j]; o[j] = (f32x4){f[4 * j] * rs * gg[0], f[4 * j + 1] * rs * gg[1], f[4 * j + 2] * rs * gg[2], f[4 * j + 3] * rs * gg[3]}; }
    }
}
__device__ __forceinline__ void unpack16(const v4u a, const v4u b, float (&f)[16]) {
    f[0] = bflo(a.x); f[1] = bfhi(a.x); f[2] = bflo(a.y); f[3] = bfhi(a.y); f[4] = bflo(a.z); f[5] = bfhi(a.z); f[6] = bflo(a.w); f[7] = bfhi(a.w);
    f[8] = bflo(b.x); f[9] = bfhi(b.x); f[10] = bflo(b.y); f[11] = bfhi(b.y); f[12] = bflo(b.z); f[13] = bfhi(b.z); f[14] = bflo(b.w); f[15] = bfhi(b.w);
}
__device__ __forceinline__ void mixnorm_pass(bf16* mix, unsigned char* mix8, const bf16* pa, const float* lse, int gw, int NGW, int lane) {
    for (int m = gw; m < M; m += NGW) {
        GAS v4u* p = (GAS v4u*)(mix + (size_t)m * DM) + 2 * lane;
        float f[16];
        if ((ATT_MFMA_MASK & 1) && lane < 16) {
            const int hd = lane >> 2;
            const float l0 = lse[(size_t)m * 4 + hd], l1 = lse[((size_t)M + m) * 4 + hd], l2 = lse[((size_t)2 * M + m) * 4 + hd];
            const float mx = fmaxf(l0, fmaxf(l1, l2)); float w0 = EX2(l0 - mx), w1 = EX2(l1 - mx), w2 = EX2(l2 - mx); const float inv = 1.0f / (w0 + w1 + w2); w0 *= inv; w1 *= inv; w2 *= inv;
            float t[16];
            { const GAS v4u* q = (const GAS v4u*)(pa + (size_t)m * 256) + 2 * lane; unpack16(q[0], q[1], t);
#pragma unroll
              for (int i = 0; i < 16; ++i) f[i] = w0 * t[i]; }
            { const GAS v4u* q = (const GAS v4u*)(pa + ((size_t)M + m) * 256) + 2 * lane; unpack16(q[0], q[1], t);
#pragma unroll
              for (int i = 0; i < 16; ++i) f[i] += w1 * t[i]; }
            { const GAS v4u* q = (const GAS v4u*)(pa + ((size_t)2 * M + m) * 256) + 2 * lane; unpack16(q[0], q[1], t);
#pragma unroll
              for (int i = 0; i < 16; ++i) f[i] += w2 * t[i]; }
        } else { const v4u a = p[0], b = p[1]; unpack16(a, b, f); }
        {
        }
        float s = 0.f;
#pragma unroll
        for (int i = 0; i < 16; ++i) s += f[i] * f[i];
        s += __shfl_xor(s, 1); s += __shfl_xor(s, 2); s += __shfl_xor(s, 4); s += __shfl_xor(s, 8);
        const float rs = 1.0f / sqrtf(s * (1.0f / 256.0f) + EPS);
        v4u oa, ob;
        oa.x = pk2(f[0] * rs, f[1] * rs); oa.y = pk2(f[2] * rs, f[3] * rs); oa.z = pk2(f[4] * rs, f[5] * rs); oa.w = pk2(f[6] * rs, f[7] * rs);
        ob.x = pk2(f[8] * rs, f[9] * rs); ob.y = pk2(f[10] * rs, f[11] * rs); ob.z = pk2(f[12] * rs, f[13] * rs); ob.w = pk2(f[14] * rs, f[15] * rs);
        if (G2_FP8) { v4u q; q.x = pg8::pk4_fp8(f[0] * rs, f[1] * rs, f[2] * rs, f[3] * rs); q.y = pg8::pk4_fp8(f[4] * rs, f[5] * rs, f[6] * rs, f[7] * rs); q.z = pg8::pk4_fp8(f[8] * rs, f[9] * rs, f[10] * rs, f[11] * rs); q.w = pg8::pk4_fp8(f[12] * rs, f[13] * rs, f[14] * rs, f[15] * rs);
            *((GAS v4u*)(mix8 + (size_t)m * DM) + lane) = q; }
        else { p[0] = oa; p[1] = ob; }
    }
}
__device__ __forceinline__ void scan_job(int b, int h, const float* lf_in, const float* ss, const float* fdp, float fbias_h, float* c2, LAS float* scr, int tid, int lane, int wave) {
    const size_t row0 = (size_t)b * S + 8 * tid;
    float v[8];
    if (lf_in) { const f32x4 a = *(const f32x4*)(lf_in + (size_t)h * M + row0), c = *(const f32x4*)(lf_in + (size_t)h * M + row0 + 4); v[0] = a[0]; v[1] = a[1]; v[2] = a[2]; v[3] = a[3]; v[4] = c[0]; v[5] = c[1]; v[6] = c[2]; v[7] = c[3]; }
    else {
#pragma unroll
        for (int i = 0; i < 8; ++i) { const f32x4* sp = (const f32x4*)(ss + (row0 + i) * 16); const f32x4* fp = (const f32x4*)(fdp + (row0 + i) * 64 + h * 16);
            const f32x4 s0 = sp[0], s1 = sp[1], s2 = sp[2], s3 = sp[3], f0 = fp[0], f1 = fp[1], f2 = fp[2], f3 = fp[3];
            const float s = ((s0[0] + s0[1]) + (s0[2] + s0[3])) + ((s1[0] + s1[1]) + (s1[2] + s1[3])) + ((s2[0] + s2[1]) + (s2[2] + s2[3])) + ((s3[0] + s3[1]) + (s3[2] + s3[3]));
            const float fd = ((f0[0] + f0[1]) + (f0[2] + f0[3])) + ((f1[0] + f1[1]) + (f1[2] + f1[3])) + ((f2[0] + f2[1]) + (f2[2] + f2[3])) + ((f3[0] + f3[1]) + (f3[2] + f3[3]));
            const float z = fd * (1.0f / sqrtf(s * (1.0f / DM) + EPS)) + fbias_h;
            v[i] = fminf(z, 0.f) - log1pf(expf(-fabsf(z))); }
    }
#pragma unroll
    for (int i = 1; i < 8; ++i) v[i] += v[i - 1];
    const float tot = v[7]; float inc = tot;
#pragma unroll
    for (int o = 1; o < 64; o <<= 1) { const float y = __shfl_up(inc, o); if (lane >= o) inc += y; }
    if (lane == 63) scr[wave] = inc;
    __syncthreads();
    float pre = inc - tot;
#pragma unroll
    for (int w = 0; w < NWAVES; ++w) pre += (w < wave) ? scr[w] : 0.f;
    f32x4* dst = (f32x4*)(c2 + (size_t)(b * 4 + h) * S + 8 * tid);
    dst[0] = (f32x4){v[0] + pre, v[1] + pre, v[2] + pre, v[3] + pre} * LOG2E; dst[1] = (f32x4){v[4] + pre, v[5] + pre, v[6] + pre, v[7] + pre} * LOG2E;
    __syncthreads();
}

__device__ __forceinline__ float dot_row(const bf16* krow, const float (&q)[64]) {
    const GAS v4u* p = (const GAS v4u*)krow; float s = 0.f;
#pragma unroll
    for (int i = 0; i < 8; ++i) { const v4u w = p[i];
        s = fmaf(q[8 * i + 0], bflo(w.x), s); s = fmaf(q[8 * i + 1], bfhi(w.x), s); s = fmaf(q[8 * i + 2], bflo(w.y), s); s = fmaf(q[8 * i + 3], bfhi(w.y), s);
        s = fmaf(q[8 * i + 4], bflo(w.z), s); s = fmaf(q[8 * i + 5], bfhi(w.z), s); s = fmaf(q[8 * i + 6], bflo(w.w), s); s = fmaf(q[8 * i + 7], bfhi(w.w), s); }
    return s;
}
__device__ __forceinline__ void axpy_row(const bf16* vrow, float a, float p, float (&o)[64]) {
    const GAS v4u* q = (const GAS v4u*)vrow;
#pragma unroll
    for (int i = 0; i < 8; ++i) { const v4u w = q[i];
        o[8 * i + 0] = fmaf(p, bflo(w.x), o[8 * i + 0] * a); o[8 * i + 1] = fmaf(p, bfhi(w.x), o[8 * i + 1] * a); o[8 * i + 2] = fmaf(p, bflo(w.y), o[8 * i + 2] * a); o[8 * i + 3] = fmaf(p, bfhi(w.y), o[8 * i + 3] * a);
        o[8 * i + 4] = fmaf(p, bflo(w.z), o[8 * i + 4] * a); o[8 * i + 5] = fmaf(p, bfhi(w.z), o[8 * i + 5] * a); o[8 * i + 6] = fmaf(p, bflo(w.w), o[8 * i + 6] * a); o[8 * i + 7] = fmaf(p, bfhi(w.w), o[8 * i + 7] * a); }
}
#define NV_STEP(KEY, BIAS2, VALID) do { if (VALID) { \
        const bf16* kr_ = qkv + (rowb + (size_t)(KEY)) * QP; \
        const float s_ = dot_row(kr_ + kcol, q) + (BIAS2); \
        const float mn_ = fmaxf(m, s_), a_ = EX2(m - mn_), p_ = EX2(s_ - mn_); l = l * a_ + p_; m = mn_; \
        axpy_row(kr_ + vcol, a_, p_, o); } } while (0)
__device__ __forceinline__ void attn_naive_item(int type, int b, int h, int chunk, const bf16* qkv, bf16* mix, const float* biasT, const float* c2, const float* kmean, const float* sinks_l, int lane) {
    const int t0 = chunk * 64, t = t0 + lane; const size_t rowb = (size_t)b * S;
    int qcol, kcol, vcol;
    if (type == 0) { qcol = C_QA + 64 * h; kcol = C_KA + 64 * h; vcol = C_VA + 64 * h; }
    else if (type == 1) { qcol = C_QB + 64 * h; kcol = C_KB + 64 * h; vcol = C_VB + 64 * h; }
    else if (type == 2) { qcol = C_QC + 64 * h; kcol = C_KC + 64 * (h >> 1); vcol = C_VC + 64 * (h >> 1); }
    else { qcol = C_QD + 64 * h; kcol = C_KD + 64 * h; vcol = C_VD + 64 * h; }
    float q[64], o[64];
    { const GAS v4u* p = (const GAS v4u*)(qkv + (rowb + t) * QP + qcol);
#pragma unroll
      for (int i = 0; i < 8; ++i) { const v4u w = p[i]; q[8 * i] = bflo(w.x); q[8 * i + 1] = bfhi(w.x); q[8 * i + 2] = bflo(w.y); q[8 * i + 3] = bfhi(w.y); q[8 * i + 4] = bflo(w.z); q[8 * i + 5] = bfhi(w.z); q[8 * i + 6] = bflo(w.w); q[8 * i + 7] = bfhi(w.w); } }
#pragma unroll
    for (int d = 0; d < 64; ++d) o[d] = 0.f;
    float m = -1e30f, l = 0.f;
    if (type == 0) {
        const float* bt = biasT + h * 4096;
        for (int g = 0; g < 3; ++g) { const int dil = g == 0 ? 1 : g == 1 ? 4 : 16;
            for (int jj = 0; jj <= 128; ++jj) { const int key = t - dil * jj; const bool valid = key >= 0; const float b2 = bt[jj * dil]; NV_STEP(valid ? key : 0, b2, valid); } }
    } else if (type == 1) {
        const float* bt = biasT + (4 + h) * 4096; const int own = t0 >> 8;
        float g[16];
#pragma unroll
        for (int n = 0; n < 16; ++n) { g[n] = -INFINITY; if (n < own) { const float* km = kmean + ((size_t)(b * 4 + h) * 16 + n) * 64; float s = 0.f;
#pragma unroll
                for (int d = 0; d < 64; ++d) s = fmaf(q[d], km[d], s);
                g[n] = s; } }
        unsigned sel = 0u;
#pragma unroll
        for (int r = 0; r < 3; ++r) { float best = -INFINITY; int bi = -1;
#pragma unroll
            for (int n = 0; n < 16; ++n) if (n < own && !((sel >> n) & 1u) && g[n] > best) { best = g[n]; bi = n; }
            if (bi >= 0) sel |= 1u << bi; }
        for (int n = 0; n < own; ++n) { const bool pick = (sel >> n) & 1u;
            if (__ballot(pick) != 0ull) for (int i = 0; i < 256; ++i) { const int key = n * 256 + i; NV_STEP(key, bt[t - key], pick); } }
        for (int key = own * 256; key <= t0 + 63; ++key) { const bool valid = key <= t; NV_STEP(key, bt[valid ? t - key : 0], valid); }
    } else if (type == 2) {
        const float* bt = biasT + (8 + h) * 4096; const int jlo = t0 - 127 > 0 ? t0 - 127 : 0;
        for (int key = jlo; key <= t0 + 63; ++key) { const int dist = t - key; const bool valid = dist >= 0 && dist <= 127; NV_STEP(key, bt[valid ? dist : 0], valid); }
        l += EX2(sinks_l[h] * LOG2E - m);
    } else {
        const float* cc = c2 + (size_t)(b * 4 + h) * S; const float ct = cc[t];
        for (int key = 0; key <= t0 + 63; ++key) { const bool valid = key <= t; NV_STEP(key, ct - cc[key], valid); }
    }
    const float inv = 1.0f / l;
    GAS v4u* op = (GAS v4u*)(mix + (rowb + t) * DM + type * 256 + h * 64);
#pragma unroll
    for (int i = 0; i < 8; ++i) { v4u w; w.x = pk2(o[8 * i] * inv, o[8 * i + 1] * inv); w.y = pk2(o[8 * i + 2] * inv, o[8 * i + 3] * inv); w.z = pk2(o[8 * i + 4] * inv, o[8 * i + 5] * inv); w.w = pk2(o[8 * i + 6] * inv, o[8 * i + 7] * inv); op[i] = w; }
}
__device__ __forceinline__ void attn_naive_phase(const bf16* qkv, bf16* mix, const float* biasT, const float* c2, const float* kmean, const float* sinks_l, int gw, int NGW, int lane) {
    for (int idx = gw; idx < 4 * NB * 4 * 64; idx += NGW) {
        const int chunk = 63 - (idx >> 7), rem = idx & 127, type = rem >> 5, bh = rem & 31;
        if ((ATT_MFMA_MASK >> type) & 1) continue;
        attn_naive_item(type, bh >> 2, bh & 3, chunk, qkv, mix, biasT, c2, kmean, sinks_l, lane);
    }
}

__device__ __forceinline__ void attn_mfma_phase(LAS unsigned char* lds, unsigned char* ws, const float* sinks_l, int l, int c, int G) {
    int cur_tab = -1, cur_tab2 = -1, cur_tab3 = -1;
#define ATT_OPAQUE() int b = b0_, h = h0_, hs = hs0_; asm volatile("" : "+s"(b), "+s"(h), "+s"(hs)); \
        const bf16* qkv = (const bf16*)(ws + WS_QKV); bf16* mix = (bf16*)(ws + WS_MIX); const float* biasT = (const float*)(ws + WS_BIAST)
    for (int v = c; v < 256; v += G) {
        const int b0_ = (v & 31) >> 2, h0_ = v & 3, hs0_ = v >> 5;
        for (int j = 0; j < 2; ++j) {
            if ((ATT_MFMA_MASK >> 1) & 1) for (int d_ = 0; d_ < ADUP(1); ++d_) { ATT_OPAQUE(); const int qb = j ? hs : 15 - hs;
                if ((ATT2_MASK >> 1) & 1) att2::attn_unit2<att2::T_B>(lds, qkv, b, h, qb, biasT + (4 + h) * 4096, 4 + h, cur_tab2, nullptr, nullptr, (const float*)(ws + WS_CTL) + CW_KMEAN + (size_t)l * 32768 + (size_t)(b * 4 + h) * 16 * 64, mix + 256 + 64 * h, DM);
                else att::attn_item<att::T_B>(lds, qkv, b, h, qb, 0, 1, 0, 0, 0, 0, biasT + (4 + h) * 4096, 4 + h, cur_tab, nullptr, nullptr, (const float*)(ws + WS_CTL) + CW_KMEAN + (size_t)l * 32768 + (size_t)(b * 4 + h) * 16 * 64, 0.f, mix + 256 + 64 * h, DM, nullptr); }
            if ((ATT_MFMA_MASK >> 3) & 1) for (int d_ = 0; d_ < ADUP(3); ++d_) { ATT_OPAQUE(); const int qb = j ? hs : 15 - hs; if (j) h = (h + 2) & 3;
                if ((ATT2_MASK >> 3) & 1) att2::attn_unit2<att2::T_D>(lds, qkv, b, h, qb, nullptr, -1, cur_tab2, (const float*)(ws + WS_C2) + (size_t)(b * 4 + h) * S, (const unsigned*)(ws + WS_CTL) + CW_NORM + 128 * l + (b * 4 + h) * 4, nullptr, mix + 768 + 64 * h, DM);
                else att::attn_item<att::T_D>(lds, qkv, b, h, qb, 0, 1, 0, 0, 0, 0, nullptr, -1, cur_tab, (const float*)(ws + WS_C2) + (size_t)(b * 4 + h) * S, (const unsigned*)(ws + WS_CTL) + CW_NORM + 128 * l + (b * 4 + h) * 4, nullptr, 0.f, mix + 768 + 64 * h, DM, nullptr); }
        }
        if ((ATT_MFMA_MASK & 5) == 5) for (int d_ = 0; d_ < ADUP(0); ++d_) {
#define A3_GEOM(J) const int cls_ = (J) >> 1, rest_ = 2 * hs + ((J) & 1); const int dil_ = cls_ <= 1 ? 1 : cls_ == 2 ? 4 : 16, qb_ = cls_ <= 1 ? rest_ : cls_ == 2 ? rest_ >> 2 : 0, res_ = cls_ <= 1 ? 0 : cls_ == 2 ? rest_ & 3 : rest_; const bool swa_ = cls_ == 0
#define A3_SRC(J, OUT) do { A3_GEOM(J); const bf16* rb_ = qkv + ((size_t)b * S + res_) * QP; OUT.k = rb_ + (swa_ ? C_KC + 64 * (h >> 1) : C_KA + 64 * h); OUT.v = rb_ + (swa_ ? C_VC + 64 * (h >> 1) : C_VA + 64 * h); OUT.rs = dil_ * QP; OUT.kw = 256 * qb_ - 128; OUT.tmin = qb_ == 0 ? 2 : 0; } while (0)
            att3::BandSrc cur_, nx_; nx_.k = nullptr; nx_.v = nullptr; nx_.rs = 0; nx_.kw = 0; nx_.tmin = 0;
            { ATT_OPAQUE(); A3_SRC(0, cur_); const int wid_ = __builtin_amdgcn_readfirstlane(threadIdx.x >> 6), lane_ = threadIdx.x & 63; const unsigned l0_ = (unsigned)(uintptr_t)lds;
              att3::band_dma(l0_ + att3::L_K, cur_.k, cur_.rs, cur_.kw, cur_.tmin, false, wid_, lane_); att3::band_dma(l0_ + att3::L_V, cur_.v, cur_.rs, cur_.kw, cur_.tmin, true, wid_, lane_); }
            for (int j8 = 0; j8 < 8; ++j8) { ATT_OPAQUE();
                A3_GEOM(j8); const size_t g = (size_t)(cls_ - 1);
                if (j8 < 7) A3_SRC(j8 + 1, nx_);
#define A3_CALL(D) att3::attn_band<D>(lds, qkv, b, h, qb_, res_, swa_ ? 127 : 128, (swa_ ? C_QC : C_QA) + 64 * h, swa_ ? C_KC + 64 * (h >> 1) : C_KA + 64 * h, swa_ ? C_VC + 64 * (h >> 1) : C_VA + 64 * h, \
                    biasT + ((swa_ ? 8 : 0) + h) * 4096, cls_ * 4 + h, cur_tab3, swa_ ? sinks_l[h] * LOG2E : -INFINITY, \
                    swa_ ? mix + 512 + 64 * h : (bf16*)(ws + WS_PA) + g * M * 256 + 64 * h, swa_ ? DM : 256, swa_ ? nullptr : (float*)(ws + WS_LSE) + g * M * 4 + h, nx_, j8 < 7)
                if (dil_ == 1) A3_CALL(1); else if (dil_ == 4) A3_CALL(4); else A3_CALL(16);
#undef A3_CALL
                cur_ = nx_;
            }
#undef A3_GEOM
#undef A3_SRC
        }
    }
#undef ATT_OPAQUE
}

struct Args { const float* in[13]; float* out; unsigned char* ws; int ph_lo, ph_hi, li, pad; };
__global__ void __launch_bounds__(NWAVES * 64, 2) hybrid_fwd(Args args) {
    extern __shared__ __attribute__((aligned(16))) unsigned char lds_raw[];
    LAS unsigned char* lds = (LAS unsigned char*)lds_raw;
    volatile LAS unsigned* MISC = (volatile LAS unsigned*)(lds + MISC_OFF);
    const int tid = threadIdx.x, lane = tid & 63, wave = __builtin_amdgcn_readfirstlane(tid >> 6);
    const int G = gridDim.x; const int bx = blockIdx.x; const int vcu = (G % 8 == 0) ? (bx % 8) * (G / 8) + bx / 8 : bx;
    const int gw = vcu * NWAVES + wave, NGW = G * NWAVES;
    Ptrs P;
    P.x = args.in[0]; P.norm1_g = args.in[1]; P.w_in = args.in[2]; P.f_bias = args.in[3]; P.sinks = args.in[4]; P.mix_g = args.in[5]; P.w_out = args.in[6];
    P.norm2_g = args.in[7]; P.w_gate = args.in[8]; P.w_up = args.in[9]; P.w_down = args.in[10]; P.rel_bias = args.in[11]; P.final_g = args.in[12];
    P.out = args.out; P.ws = args.ws;
    unsigned char* ws = args.ws;
    gu32* ctl = (gu32*)(ws + WS_CTL);
    bf16* XB = (bf16*)(ws + WS_XB); bf16* MIX = (bf16*)(ws + WS_MIX); bf16* QKV = (bf16*)(ws + WS_QKV); bf16* ACT = (bf16*)(ws + WS_QKV);
    float* SSB = (float*)(ws + WS_SS); float* FDB = (float*)(ws + WS_FD); float* LF = (float*)(ws + WS_LF); float* CC2 = (float*)(ws + WS_C2); float* KMEAN = (float*)(ws + WS_KMEAN);
    const float* BIAST = (const float*)(ws + WS_BIAST);
    for (int u = tid; u < (LDS_BYTES - LDSCTL_OFF) / 4; u += NWAVES * 64) ((LAS unsigned*)(lds + LDSCTL_OFF))[u] = 0u;
    __syncthreads();
    XcdBarrier bar; bar.bar = (unsigned*)(ctl + CW_BAR) + args.li * XCD_BAR_WORDS; bar.x = 0; bar.st = nullptr;
    if (N_LAUNCHES == 1) bar = xcd_barrier_post((unsigned*)(ctl + CW_BAR) + args.li * XCD_BAR_WORDS, MISC + 8);
    const int lo = args.ph_lo, hi = args.ph_hi;
#define IN(k) (lo <= (k) && (k) < hi)
#define SEAM(k) do { if (IN(k) && IN((k) + 1)) { if (N_LAUNCHES == 1) xcd_barrier(bar); } } while (0)

    if (IN(0)) {
        phase_prep(P, lds, 0, (G == 256) ? 1 : DEPTH, true, gw, NGW, wave, lane);
        __syncthreads();
        { LAS float* wl = (LAS float*)(lds + RING_OFF); for (int i = tid; i < DM * 4; i += NWAVES * 64) { const int k = i >> 2, h = i & 3; wl[i] = P.norm1_g[k] * P.w_in[(size_t)k * NIN + 2816 + h]; } }
        __syncthreads();
        row_pass<true>(P.x, XB, SSB, (const LAS float*)(lds + RING_OFF), P.f_bias, LF, gw, NGW, lane);
        SEAM(0);
    }

    { constexpr int l = 0;
    {
        const int pb = 1 + PH_PER_LAYER * l;
        if (IN(pb + 0)) {
            pg8::Gemm g{XB, (const bf16*)(ws + WS_WIN) + (size_t)l * QP * DM, M, QP, DM}; pg8::StaticOrder So; So.init(M, QP, G, bx);
            pg8::EpiQKV E{QKV, QP, SSB, C2, (LAS float*)(lds + LDSCTL_OFF + 1024), (float*)(ctl + CW_KMEAN) + (size_t)l * 32768, (unsigned*)(ctl + CW_NORM + 128 * l)};
            pg8::rstd_table((LAS float*)(lds + LDSCTL_OFF + 1024), SSB, So);
            pg8::gemm_phase<pg8::EpiQKV, pg8::StaticOrder, PG8_ALIGN, PG8_SP2>(lds + RING_OFF, g, So, E);
            for (int j = bx; j < 32 + 128; j += G) if (j >= 128) { const int bh = j - 128;
                scan_job(bh >> 2, bh & 3, l == 0 ? LF : nullptr, SSB, FDB, P.f_bias[l * 4 + (bh & 3)], CC2, (LAS float*)(lds + LDSCTL_OFF + 1024), tid, lane, wave); }
            if (l == 0 && G == 256 && bx >= 128) phase_prep(P, lds, 1, DEPTH, false, (bx - 128) * NWAVES + wave, 128 * NWAVES, wave, lane);
            SEAM(pb + 0);
        }
        if (IN(pb + 1)) {
            if (ATT_MFMA_MASK != 15) attn_naive_phase(QKV, MIX, BIAST, CC2, KMEAN, P.sinks + l * 4, gw, NGW, lane);
            if (ATT_MFMA_MASK != 0) { __syncthreads(); attn_mfma_phase(lds + RING_OFF, ws, P.sinks + l * 4, l, bx, G); }
            SEAM(pb + 1); }
        if (IN(pb + 2)) { mixnorm_pass(MIX, ws + WS_MIX8, (const bf16*)(ws + WS_PA), (const float*)(ws + WS_LSE), gw, NGW, lane); SEAM(pb + 2); }
        if (IN(pb + 3)) {
            pg8::Gemm g{G2_FP8 ? (const bf16*)(ws + WS_MIX8) : MIX, G2_FP8 ? (const bf16*)(ws + WS_WOUT + (size_t)l * DM * DM) : (const bf16*)(ws + WS_WOUT) + (size_t)l * DM * DM, M, DM, DM}; pg8::StaticOrder So; So.init(M, DM, G, bx);
            typedef pg8::EpiResidX<false, RESID_PF> EpiG2;
            EpiG2 E{XB, SSB, nullptr, nullptr, DM, G2_FP8 ? 1.0f / WSCALE : 1.0f, ws + WS_X8};
            if (DRY_MASK & 1) { EpiG2 Ed{(bf16*)(ws + WS_QKV), (float*)(ws + WS_QKV + 100 * MiB), nullptr, nullptr, DM, 1.0f, ws + WS_QKV + 64 * MiB};
                pg8::gemm_phase<EpiG2, pg8::StaticOrder, PG8_ALIGN, PG8_SP2, (G2_FP8 != 0)>(lds + RING_OFF, g, So, Ed); }
            pg8::gemm_phase<EpiG2, pg8::StaticOrder, PG8_ALIGN, PG8_SP2, (G2_FP8 != 0)>(lds + RING_OFF, g, So, E);
            SEAM(pb + 3);
        }
        if (IN(pb + 4)) {
            pg8::Gemm g{(const bf16*)(ws + WS_X8), (const bf16*)(ws + WS_WGU + (size_t)l * NGU * DM), M, NGU, DM}; pg8::StaticOrder So; So.init(M, NGU, G, bx);
            pg8::EpiSwiGLU E{(unsigned char*)ACT, DFF, SSB, (LAS float*)(lds + LDSCTL_OFF + 1024), 1.0f / WSCALE, ASCALE};
            pg8::rstd_table((LAS float*)(lds + LDSCTL_OFF + 1024), SSB, So);
            pg8::gemm_phase<pg8::EpiSwiGLU, pg8::StaticOrder, PG8_ALIGN, PG8_SP2, true>(lds + RING_OFF, g, So, E);
            SEAM(pb + 4);
        }
        if (IN(pb + 5)) {
            pg8::Gemm g{ACT, (const bf16*)(ws + WS_WDN + (size_t)l * DM * DFF), M, DM, DFF}; pg8::StaticOrder So; So.init(M, DM, G, bx);
            constexpr bool FD = (l + 1 < DEPTH);
            typedef pg8::EpiResidX<FD, FD ? RESID_PF_FD : RESID_PF> EpiG4;
            LAS unsigned* wl = (LAS unsigned*)(lds + LDSCTL_OFF + 1024);
            if (FD) pg8::wfd_table(wl, (const unsigned*)(ws + WS_WFD) + (size_t)(FD ? l + 1 : 0) * (DM / 2) * 4, So);
            EpiG4 E{XB, SSB, wl, FDB, DM, 1.0f / (WSCALE * ASCALE), nullptr};
            if (DRY_MASK & 2) { EpiG4 Ed{(bf16*)(ws + WS_QKV + 96 * MiB), (float*)(ws + WS_QKV + 160 * MiB), wl, (float*)(ws + WS_QKV + 164 * MiB), DM, E.ascale, nullptr};
                pg8::gemm_phase<EpiG4, pg8::StaticOrder, PG8_ALIGN, PG8_SP2, true>(lds + RING_OFF, g, So, Ed); }
            pg8::gemm_phase<EpiG4, pg8::StaticOrder, PG8_ALIGN, PG8_SP2, true>(lds + RING_OFF, g, So, E);
            SEAM(pb + 5);
        }
    }
    }
    { constexpr int l = 1;
    {
        const int pb = 1 + PH_PER_LAYER * l;
        if (IN(pb + 0)) {
            pg8::Gemm g{XB, (const bf16*)(ws + WS_WIN) + (size_t)l * QP * DM, M, QP, DM}; pg8::StaticOrder So; So.init(M, QP, G, bx);
            pg8::EpiQKV E{QKV, QP, SSB, C2, (LAS float*)(lds + LDSCTL_OFF + 1024), (float*)(ctl + CW_KMEAN) + (size_t)l * 32768, (unsigned*)(ctl + CW_NORM + 128 * l)};
            pg8::rstd_table((LAS float*)(lds + LDSCTL_OFF + 1024), SSB, So);
            pg8::gemm_phase<pg8::EpiQKV, pg8::StaticOrder, PG8_ALIGN, PG8_SP2>(lds + RING_OFF, g, So, E);
            for (int j = bx; j < 32 + 128; j += G) if (j >= 128) { const int bh = j - 128;
                scan_job(bh >> 2, bh & 3, l == 0 ? LF : nullptr, SSB, FDB, P.f_bias[l * 4 + (bh & 3)], CC2, (LAS float*)(lds + LDSCTL_OFF + 1024), tid, lane, wave); }
            if (l == 0 && G == 256 && bx >= 128) phase_prep(P, lds, 1, DEPTH, false, (bx - 128) * NWAVES + wave, 128 * NWAVES, wave, lane);
            SEAM(pb + 0);
        }
        if (IN(pb + 1)) {
            if (ATT_MFMA_MASK != 15) attn_naive_phase(QKV, MIX, BIAST, CC2, KMEAN, P.sinks + l * 4, gw, NGW, lane);
            if (ATT_MFMA_MASK != 0) { __syncthreads(); attn_mfma_phase(lds + RING_OFF, ws, P.sinks + l * 4, l, bx, G); }
            SEAM(pb + 1); }
        if (IN(pb + 2)) { mixnorm_pass(MIX, ws + WS_MIX8, (const bf16*)(ws + WS_PA), (const float*)(ws + WS_LSE), gw, NGW, lane); SEAM(pb + 2); }
        if (IN(pb + 3)) {
            pg8::Gemm g{G2_FP8 ? (const bf16*)(ws + WS_MIX8) : MIX, G2_FP8 ? (const bf16*)(ws + WS_WOUT + (size_t)l * DM * DM) : (const bf16*)(ws + WS_WOUT) + (size_t)l * DM * DM, M, DM, DM}; pg8::StaticOrder So; So.init(M, DM, G, bx);
            typedef pg8::EpiResidX<false, RESID_PF> EpiG2;
            EpiG2 E{XB, SSB, nullptr, nullptr, DM, G2_FP8 ? 1.0f / WSCALE : 1.0f, ws + WS_X8};
            if (DRY_MASK & 1) { EpiG2 Ed{(bf16*)(ws + WS_QKV), (float*)(ws + WS_QKV + 100 * MiB), nullptr, nullptr, DM, 1.0f, ws + WS_QKV + 64 * MiB};
                pg8::gemm_phase<EpiG2, pg8::StaticOrder, PG8_ALIGN, PG8_SP2, (G2_FP8 != 0)>(lds + RING_OFF, g, So, Ed); }
            pg8::gemm_phase<EpiG2, pg8::StaticOrder, PG8_ALIGN, PG8_SP2, (G2_FP8 != 0)>(lds + RING_OFF, g, So, E);
            SEAM(pb + 3);
        }
        if (IN(pb + 4)) {
            pg8::Gemm g{(const bf16*)(ws + WS_X8), (const bf16*)(ws + WS_WGU + (size_t)l * NGU * DM), M, NGU, DM}; pg8::StaticOrder So; So.init(M, NGU, G, bx);
            pg8::EpiSwiGLU E{(unsigned char*)ACT, DFF, SSB, (LAS float*)(lds + LDSCTL_OFF + 1024), 1.0f / WSCALE, ASCALE};
            pg8::rstd_table((LAS float*)(lds + LDSCTL_OFF + 1024), SSB, So);
            pg8::gemm_phase<pg8::EpiSwiGLU, pg8::StaticOrder, PG8_ALIGN, PG8_SP2, true>(lds + RING_OFF, g, So, E);
            SEAM(pb + 4);
        }
        if (IN(pb + 5)) {
            pg8::Gemm g{ACT, (const bf16*)(ws + WS_WDN + (size_t)l * DM * DFF), M, DM, DFF}; pg8::StaticOrder So; So.init(M, DM, G, bx);
            constexpr bool FD = (l + 1 < DEPTH);
            typedef pg8::EpiResidX<FD, FD ? RESID_PF_FD : RESID_PF> EpiG4;
            LAS unsigned* wl = (LAS unsigned*)(lds + LDSCTL_OFF + 1024);
            if (FD) pg8::wfd_table(wl, (const unsigned*)(ws + WS_WFD) + (size_t)(FD ? l + 1 : 0) * (DM / 2) * 4, So);
            EpiG4 E{XB, SSB, wl, FDB, DM, 1.0f / (WSCALE * ASCALE), nullptr};
            if (DRY_MASK & 2) { EpiG4 Ed{(bf16*)(ws + WS_QKV + 96 * MiB), (float*)(ws + WS_QKV + 160 * MiB), wl, (float*)(ws + WS_QKV + 164 * MiB), DM, E.ascale, nullptr};
                pg8::gemm_phase<EpiG4, pg8::StaticOrder, PG8_ALIGN, PG8_SP2, true>(lds + RING_OFF, g, So, Ed); }
            pg8::gemm_phase<EpiG4, pg8::StaticOrder, PG8_ALIGN, PG8_SP2, true>(lds + RING_OFF, g, So, E);
            SEAM(pb + 5);
        }
    }
    }
    if (IN(NPHASE - 1)) final_pass(XB, P.out, P.final_g, SSB, gw, NGW, lane);
#undef IN
#undef SEAM
}

extern "C" void kernel_launch(void* const* d_in, const int* in_sizes, int n_in, void* d_out, int out_size, void* d_ws, size_t ws_size, hipStream_t stream) {
    static int grid = 0;
    if (grid == 0) {
        if (n_in != 13 || in_sizes[0] != M * DM || out_size != M * DM || ws_size < WS_END) { fprintf(stderr, "kernel_launch: unexpected shapes (n_in %d, in0 %d, out %d, ws %zu); nothing launched\n", n_in, n_in > 0 ? in_sizes[0] : -1, out_size, ws_size); grid = -1; return; }
        int dev = 0, cus = 0, per_cu = 0;
        if (hipGetDevice(&dev) != hipSuccess || hipDeviceGetAttribute(&cus, hipDeviceAttributeMultiprocessorCount, dev) != hipSuccess) { fprintf(stderr, "kernel_launch: device query failed\n"); grid = -1; return; }
        if (hipFuncSetAttribute((const void*)hybrid_fwd, hipFuncAttributeMaxDynamicSharedMemorySize, LDS_BYTES) != hipSuccess) { fprintf(stderr, "kernel_launch: hipFuncSetAttribute failed\n"); grid = -1; return; }
        if (hipOccupancyMaxActiveBlocksPerMultiprocessor(&per_cu, (const void*)hybrid_fwd, NWAVES * 64, LDS_BYTES) != hipSuccess || per_cu < 1)
            fprintf(stderr, "kernel_launch: note: occupancy query reports %d workgroups per CU\n", per_cu);
        (void)hipGetLastError();
        grid = cus;
    }
    if (grid < 0) return;
    if (hipMemsetAsync((char*)d_ws + WS_CTL, 0, CTL_ZERO_BYTES, stream) != hipSuccess) { fprintf(stderr, "kernel_launch: hipMemsetAsync failed\n"); return; }
    Args a{};
    for (int i = 0; i < 13; ++i) a.in[i] = (const float*)d_in[i];
    a.out = (float*)d_out; a.ws = (unsigned char*)d_ws;
    const int n_l = (PROBE_PHASE >= 0) ? 3 : N_LAUNCHES;
    for (int li = 0; li < n_l; ++li) {
        if (PROBE_PHASE >= 0) { a.ph_lo = li == 0 ? 0 : li == 1 ? PROBE_PHASE : PROBE_PHASE + 1; a.ph_hi = li == 0 ? PROBE_PHASE + 1 : li == 1 ? PROBE_PHASE + 1 : NPHASE; a.li = li; if (a.ph_lo >= a.ph_hi) continue; }
        else { a.ph_lo = (N_LAUNCHES == 1) ? 0 : li; a.ph_hi = (N_LAUNCHES == 1) ? NPHASE : li + 1; a.li = (N_LAUNCHES == 1) ? 0 : li; }
        hipLaunchKernelGGL(hybrid_fwd, dim3(grid), dim3(NWAVES * 64), LDS_BYTES, stream, a);
        const hipError_t le = hipPeekAtLastError();
        if (le != hipSuccess) { fprintf(stderr, "kernel_launch: launch %d failed: %s\n", li, hipGetErrorName(le)); break; }
    }
}
```
